# Optimizing an MI355X kernel written in HIP

```python
import math
import jax, jax.numpy as jnp
from jax import lax
import numpy as np

D_MODEL = 1024
BATCH = 16
SEQ = 2048
DEPTH = 1

N_MEM = 256
HEAD_DIM = 64
A_HEADS = 8
A_WIDTH = A_HEADS * HEAD_DIM
IDX_HEADS = 4
IDX_DIM = 64
TOPK_MAX = 256
B_HEADS = 4
B_VDIM = 2 * HEAD_DIM
B_WIDTH = B_HEADS * B_VDIM
MIX_WIDTH = A_WIDTH + B_WIDTH
IN_SIZES = (A_WIDTH, HEAD_DIM, HEAD_DIM, IDX_HEADS * IDX_DIM, IDX_DIM, IDX_HEADS,
            2 * B_HEADS * HEAD_DIM, 2 * B_HEADS * HEAD_DIM, B_WIDTH)
IN_COLS = sum(IN_SIZES)
X_HEADS = 4
X_HEAD_DIM = D_MODEL // X_HEADS
D_FF = 2816
CONV_W = 3
ROPE_THETA = 10000.0
EPS = 1e-6
Q_BLOCK = 128

kernel_name = "hybrid_dsa_diffattn_memxattn_convglu"


def rms_normalize(x):
    xf = x.astype(jnp.float32)
    y = xf * lax.rsqrt(jnp.mean(xf * xf, axis=-1, keepdims=True) + EPS)
    return y.astype(x.dtype)


def rmsnorm(x, g):
    xf = x.astype(jnp.float32)
    y = xf * lax.rsqrt(jnp.mean(xf * xf, axis=-1, keepdims=True) + EPS)
    return (y * g.astype(jnp.float32)).astype(x.dtype)


def rope_tables(positions, dim):
    inv_freq = 1.0 / (ROPE_THETA ** (jnp.arange(0, dim, 2, dtype=jnp.float32) / dim))
    ang = positions.astype(jnp.float32)[..., None] * inv_freq
    return jnp.cos(ang), jnp.sin(ang)


def rope(x, cos, sin):
    shape = cos.shape[:2] + (1,) * (x.ndim - 3) + cos.shape[-1:]
    c = cos.reshape(shape).astype(x.dtype)
    s = sin.reshape(shape).astype(x.dtype)
    x1, x2 = jnp.split(x, 2, axis=-1)
    return jnp.concatenate([x1 * c - x2 * s, x2 * c + x1 * s], axis=-1)


def to_blocks(t, n_blk):
    return t.reshape((t.shape[0], n_blk, Q_BLOCK) + t.shape[2:]).swapaxes(0, 1)


def from_blocks(t):
    t = t.swapaxes(0, 1)
    return t.reshape((t.shape[0], t.shape[1] * t.shape[2]) + t.shape[3:])


def dsa_attention(q, k, v, q_idx, k_idx, w_idx):
    B, S, H, D = q.shape
    n_blk = S // Q_BLOCK
    topk = min(TOPK_MAX, S // 4)
    key_pos = jnp.arange(S)

    def block(args):
        qb, qib, wib, start = args
        qpos = start + jnp.arange(Q_BLOCK)
        causal = key_pos[None, :] <= qpos[:, None]
        logits = jnp.einsum('bqhd,bsd->bqhs', qib, k_idx)
        score = jnp.einsum('bqh,bqhs->bqs', wib, jax.nn.relu(logits)).astype(jnp.float32)
        score = jnp.where(causal[None], score, -jnp.inf)
        _, idx = lax.top_k(score, topk)
        k_sel = jax.vmap(lambda kk, ii: kk[ii])(k, idx)
        v_sel = jax.vmap(lambda vv, ii: vv[ii])(v, idx)
        valid = idx <= qpos[None, :, None]
        s = jnp.einsum('bqhd,bqkd->bqhk', qb, k_sel).astype(jnp.float32) * (D ** -0.5)
        s = jnp.where(valid[:, :, None, :], s, -jnp.inf)
        p = jax.nn.softmax(s, axis=-1).astype(v.dtype)
        return jnp.einsum('bqhk,bqkd->bqhd', p, v_sel)

    starts = jnp.arange(n_blk) * Q_BLOCK
    out = lax.map(block, (to_blocks(q, n_blk), to_blocks(q_idx, n_blk), to_blocks(w_idx, n_blk), starts))
    return from_blocks(out)


def diff_attention(q, k, v, lam):
    B, S, H, _, D = q.shape
    n_blk = S // Q_BLOCK
    key_pos = jnp.arange(S)

    def block(args):
        qb, start = args
        qpos = start + jnp.arange(Q_BLOCK)
        causal = key_pos[None, :] <= qpos[:, None]
        s = jnp.einsum('bqhcd,bshcd->bhcqs', qb, k).astype(jnp.float32) * (D ** -0.5)
        s = jnp.where(causal, s, -jnp.inf)
        p = jax.nn.softmax(s, axis=-1)
        a = (p[:, :, 0] - lam * p[:, :, 1]).astype(v.dtype)
        return jnp.einsum('bhqs,bshe->bqhe', a, v)

    starts = jnp.arange(n_blk) * Q_BLOCK
    out = lax.map(block, (to_blocks(q, n_blk), starts))
    return from_blocks(out)


def token_mixer(hn, cos, sin, w_in, g_qa, g_ka, g_qb, g_kb,
                lam_q1, lam_k1, lam_q2, lam_k2, w_out, lambda_init):
    B, S, _ = hn.shape
    proj = hn @ w_in
    offsets = np.cumsum(IN_SIZES)[:-1].tolist()
    q_a, k_a, v_a, q_i, k_i, w_i, q_b, k_b, v_b = jnp.split(proj, offsets, axis=-1)

    q_a = rope(rmsnorm(q_a.reshape(B, S, A_HEADS, HEAD_DIM), g_qa), cos, sin)
    k_a = rope(rmsnorm(k_a, g_ka), cos, sin)
    q_i = rope(q_i.reshape(B, S, IDX_HEADS, IDX_DIM), cos, sin)
    k_i = rope(k_i, cos, sin)
    w_i = w_i * (IDX_HEADS ** -0.5 * IDX_DIM ** -0.5)
    out_a = dsa_attention(q_a, k_a, v_a, q_i, k_i, w_i).reshape(B, S, A_WIDTH)

    q_b = rope(rmsnorm(q_b.reshape(B, S, B_HEADS, 2, HEAD_DIM), g_qb), cos, sin)
    k_b = rope(rmsnorm(k_b.reshape(B, S, B_HEADS, 2, HEAD_DIM), g_kb), cos, sin)
    v_b = v_b.reshape(B, S, B_HEADS, B_VDIM)
    f32 = jnp.float32
    lam = (jnp.exp(jnp.sum(lam_q1.astype(f32) * lam_k1.astype(f32)))
           - jnp.exp(jnp.sum(lam_q2.astype(f32) * lam_k2.astype(f32))) + lambda_init)
    out_b = diff_attention(q_b, k_b, v_b, lam)
    out_b = (rms_normalize(out_b) * (1.0 - lambda_init)).reshape(B, S, B_WIDTH)

    return jnp.concatenate([out_a, out_b], axis=-1) @ w_out


def cross_attention(hn, memn, w_xq, w_xk, w_xv, w_xo, g_xq, g_xk):
    B, S, _ = hn.shape
    M = memn.shape[1]
    q = rmsnorm((hn @ w_xq).reshape(B, S, X_HEADS, X_HEAD_DIM), g_xq)
    k = rmsnorm((memn @ w_xk).reshape(B, M, X_HEADS, X_HEAD_DIM), g_xk)
    v = (memn @ w_xv).reshape(B, M, X_HEADS, X_HEAD_DIM)
    s = jnp.einsum('bshd,bmhd->bhsm', q, k).astype(jnp.float32) * (X_HEAD_DIM ** -0.5)
    p = jax.nn.softmax(s, axis=-1).astype(v.dtype)
    o = jnp.einsum('bhsm,bmhd->bshd', p, v).reshape(B, S, D_MODEL)
    return o @ w_xo


def conv_glu(hn, w_ffn_in, conv_w, conv_b, w_ffn_out):
    S = hn.shape[1]
    a, gate = jnp.split(hn @ w_ffn_in, 2, axis=-1)
    a_pad = jnp.pad(a, ((0, 0), (CONV_W - 1, 0), (0, 0)))
    conv = conv_b + sum(a_pad[:, j:j + S] * conv_w[j] for j in range(CONV_W))
    return (jax.nn.gelu(conv) * gate) @ w_ffn_out


def setup_inputs(seed: int = 0) -> dict:
    key = jax.random.key(seed)
    ks = iter(jax.random.split(key, 48))
    f32 = jnp.float32

    def nrm(shape, fan_in):
        return jax.random.normal(next(ks), shape, f32) * (fan_in ** -0.5)

    def gain(shape):
        return 1.0 + 0.02 * jax.random.normal(next(ks), shape, f32)

    x = jax.random.normal(next(ks), (BATCH, SEQ, D_MODEL), f32)
    mem = jax.random.normal(next(ks), (BATCH, N_MEM, D_MODEL), f32)
    offs = jax.random.randint(next(ks), (BATCH, 1), 0, 1024)
    positions = (offs + jnp.arange(SEQ, dtype=jnp.int32)[None, :]).astype(jnp.int32)
    L = DEPTH
    return {
        "x": x,
        "mem": mem,
        "positions": positions,
        "g_mix": gain((L, D_MODEL)),
        "w_in": nrm((L, D_MODEL, IN_COLS), D_MODEL),
        "g_qa": gain((L, HEAD_DIM)),
        "g_ka": gain((L, HEAD_DIM)),
        "g_qb": gain((L, HEAD_DIM)),
        "g_kb": gain((L, HEAD_DIM)),
        "lam_q1": 0.1 * jax.random.normal(next(ks), (L, HEAD_DIM), f32),
        "lam_k1": 0.1 * jax.random.normal(next(ks), (L, HEAD_DIM), f32),
        "lam_q2": 0.1 * jax.random.normal(next(ks), (L, HEAD_DIM), f32),
        "lam_k2": 0.1 * jax.random.normal(next(ks), (L, HEAD_DIM), f32),
        "w_out": nrm((L, MIX_WIDTH, D_MODEL), MIX_WIDTH),
        "g_xattn": gain((L, D_MODEL)),
        "g_mem": gain((L, D_MODEL)),
        "w_xq": nrm((L, D_MODEL, D_MODEL), D_MODEL),
        "w_xk": nrm((L, D_MODEL, D_MODEL), D_MODEL),
        "w_xv": nrm((L, D_MODEL, D_MODEL), D_MODEL),
        "w_xo": nrm((L, D_MODEL, D_MODEL), D_MODEL),
        "g_xq": gain((L, X_HEAD_DIM)),
        "g_xk": gain((L, X_HEAD_DIM)),
        "g_ffn": gain((L, D_MODEL)),
        "w_ffn_in": nrm((L, D_MODEL, 2 * D_FF), D_MODEL),
        "conv_w": nrm((L, CONV_W, D_FF), CONV_W),
        "conv_b": 0.02 * jax.random.normal(next(ks), (L, D_FF), f32),
        "w_ffn_out": nrm((L, D_FF, D_MODEL), D_FF),
    }


def reference(x, mem, positions, g_mix, w_in, g_qa, g_ka, g_qb, g_kb,
              lam_q1, lam_k1, lam_q2, lam_k2, w_out, g_xattn, g_mem,
              w_xq, w_xk, w_xv, w_xo, g_xq, g_xk, g_ffn, w_ffn_in,
              conv_w, conv_b, w_ffn_out):
    cos, sin = rope_tables(positions, HEAD_DIM)
    h = x
    for l in range(DEPTH):
        lambda_init = 0.8 - 0.6 * math.exp(-0.3 * l)
        h = h + token_mixer(rmsnorm(h, g_mix[l]), cos, sin, w_in[l], g_qa[l], g_ka[l],
                            g_qb[l], g_kb[l], lam_q1[l], lam_k1[l], lam_q2[l], lam_k2[l],
                            w_out[l], lambda_init)
        h = h + cross_attention(rmsnorm(h, g_xattn[l]), rmsnorm(mem, g_mem[l]),
                                w_xq[l], w_xk[l], w_xv[l], w_xo[l], g_xq[l], g_xk[l])
        h = h + conv_glu(rmsnorm(h, g_ffn[l]), w_ffn_in[l], conv_w[l], conv_b[l], w_ffn_out[l])
    return h
```

```cpp
#include <hip/hip_runtime.h>
#include <cstdint>
#include <cstdio>
#include <cmath>

constexpr int BATCH = 16, SEQ = 2048, DM = 1024, NTOK = BATCH * SEQ;
constexpr int NMEM = 256, NMTOK = BATCH * NMEM;
constexpr int INC = 2500;
constexpr int OFF_QA = 0, OFF_KA = 512, OFF_VA = 576, OFF_QI = 640, OFF_KI = 896, OFF_WI = 960, OFF_QB = 964, OFF_KB = 1476, OFF_VB = 1988;
constexpr int DFF = 2816;
constexpr float EPS = 1e-6f;
constexpr float C2 = 0.125f * 1.4426950408889634f;

struct RopeF { float f[32]; };

__device__ __forceinline__ float wave_sum(float v) {
#pragma unroll
    for (int o = 1; o < 64; o <<= 1) v += __shfl_xor(v, o);
    return v;
}
__device__ __forceinline__ float wave_max(float v) {
#pragma unroll
    for (int o = 1; o < 64; o <<= 1) v = fmaxf(v, __shfl_xor(v, o));
    return v;
}

#ifndef WT_STORES
#define WT_STORES 0
#endif
typedef unsigned wt_u32x4 __attribute__((ext_vector_type(4)));
typedef unsigned wt_u32x2 __attribute__((ext_vector_type(2)));
__device__ __forceinline__ void st16_wt(void* p, wt_u32x4 v) {
#if WT_STORES
    asm volatile("global_store_dwordx4 %0, %1, off sc1\n\ts_nop 1" :: "v"(p), "v"(v) : "memory");
#else
    *(wt_u32x4*)p = v;
#endif
}
__device__ __forceinline__ void st8_wt(void* p, wt_u32x2 v) {
#if WT_STORES
    asm volatile("global_store_dwordx2 %0, %1, off sc1\n\ts_nop 1" :: "v"(p), "v"(v) : "memory");
#else
    *(wt_u32x2*)p = v;
#endif
}
namespace pg8 {
#define PG8_LAS __attribute__((address_space(3)))
typedef unsigned short bf16_t;
typedef short bf16x8 __attribute__((ext_vector_type(8)));
typedef float f32x4 __attribute__((ext_vector_type(4)));
typedef unsigned u32x4 __attribute__((ext_vector_type(4)));
typedef unsigned u32x2 __attribute__((ext_vector_type(2)));
constexpr int BM = 256, BK = 64, HALF = 128, HTB = HALF * BK * 2  , STAGE_BYTES = 8 * HTB, NXCD = 8, WGM = 8;

__host__ __device__ __forceinline__ int lds_byte(int r, int c) { const int st = (r >> 4) * 2 + (c >> 5), rr = r & 15, cc = c & 31, ob = rr * 64 + cc * 2; return st * 1024 + (ob ^ (((ob >> 9) & 1) << 5)); }
__host__ __device__ __forceinline__ void stage_rc(int b, int& R, int& C) { const int st = b / 1024, sb = b % 1024, swz = sb ^ (((sb >> 9) & 1) << 5); R = (st >> 1) * 16 + swz / 64; C = (st & 1) * 32 + (swz % 64) / 2; }
__host__ __device__ __forceinline__ int perm32(int rho) { const int n = rho >> 4, i = rho & 15; return 8 * (i >> 2) + 4 * n + (i & 3); }

struct Unit { int pm, pn; size_t ao, bo; };
struct Gemm { const bf16_t* A; const bf16_t* Bt; int lda, ldb, K; unsigned amask; };

struct TileOrder {
    int nM, nN, nwg, G, c, c0; size_t astep, bstep, apn, bbatch;
    __device__ void init(int nM_, int nN_, int G_, int c_, size_t astep_, size_t bstep_, int c0_ = 0, size_t apn_ = 0, size_t bbatch_ = 0) { nM = nM_; nN = nN_; nwg = nM * nN; G = G_; c = c_; c0 = c0_; astep = astep_; bstep = bstep_; apn = apn_; bbatch = bbatch_; }
    __device__ bool next(int i, Unit& u) const {
        if (c < c0) return false;
        const long L = (long)i * G + (c - c0); if (L >= nwg) return false;
        int wgid = (int)L; { const int q = nwg / NXCD, r = nwg % NXCD, xcd = wgid % NXCD, off = wgid / NXCD; wgid = (xcd < r ? xcd * (q + 1) : r * (q + 1) + (xcd - r) * q) + off; }
        const int nig = WGM * nN, gid = wgid / nig, fm = gid * WGM, gsz = (nM - fm) < WGM ? (nM - fm) : WGM;
        u.pm = fm + ((wgid % nig) % gsz); u.pn = (wgid % nig) / gsz; u.ao = (size_t)u.pm * astep + (size_t)u.pn * apn; u.bo = (size_t)u.pn * bstep + (size_t)(u.pm >> 3) * bbatch; return true;
    }
    __device__ __forceinline__ void a_ready(const Unit&) const {}
    __device__ __forceinline__ void done(const Unit&) const {}
};
__device__ __forceinline__ const char* uptr(const void* p) {
    const unsigned long long v = (unsigned long long)p; const unsigned lo = __builtin_amdgcn_readfirstlane((unsigned)v), hi = __builtin_amdgcn_readfirstlane((unsigned)(v >> 32));
    return (const char*)(((unsigned long long)hi << 32) | lo);
}
__device__ __forceinline__ int lane_id() { int l; asm volatile("v_mbcnt_lo_u32_b32 %0, -1, 0\n\tv_mbcnt_hi_u32_b32 %0, -1, %0" : "=v"(l)); return l; }
__device__ __forceinline__ unsigned cvt_pk_bf16(float lo, float hi) { unsigned r; asm volatile("v_cvt_pk_bf16_f32 %0, %1, %2" : "=v"(r) : "v"(lo), "v"(hi)); return r; }
typedef float f32x2 __attribute__((ext_vector_type(2)));
__device__ __forceinline__ float sq4(const f32x4 v) { return (v[0] * v[0] + v[1] * v[1]) + (v[2] * v[2] + v[3] * v[3]); }
__device__ __forceinline__ void split_pk(float a, float b, unsigned& hi, unsigned& lo) {
    hi = cvt_pk_bf16(a, b);
    const float ah = __uint_as_float(hi << 16), bh = __uint_as_float(hi & 0xffff0000u);
    lo = cvt_pk_bf16(a - ah, b - bh);
}
__device__ __forceinline__ void split8(const f32x4 a, const f32x4 b, u32x4& hi, u32x4& lo) {
    unsigned h0, h1, h2, h3, l0, l1, l2, l3;
    split_pk(a[0], a[1], h0, l0); split_pk(a[2], a[3], h1, l1); split_pk(b[0], b[1], h2, l2); split_pk(b[2], b[3], h3, l3);
    hi = (u32x4){h0, h1, h2, h3}; lo = (u32x4){l0, l1, l2, l3};
}
__device__ __forceinline__ u32x4 pack8(const f32x4 a, const f32x4 b) { u32x4 w; w.x = cvt_pk_bf16(a[0], a[1]); w.y = cvt_pk_bf16(a[2], a[3]); w.z = cvt_pk_bf16(b[0], b[1]); w.w = cvt_pk_bf16(b[2], b[3]); return w; }

struct EpiProj {
    static constexpr bool PERM = true, AFTER_DRAIN = false;
    bf16_t *QA, *QB, *KB, *VB;
    const float *rs, *ct, *st, *g_qa, *g_qb, *g_kb;
    __device__ __forceinline__ void operator()(const f32x4 (&acc)[2][2][4][2], const Unit& u, int wr, int wc, int fr, int fq) const {
        bf16_t* dst = nullptr; int pitch = 0, coff = 0, mode = 0; const float* g = nullptr; float scale = 1.f;
        const int pn = u.pn;
        if (pn < 2)       { dst = QA; pitch = 512; coff = (pn * 4 + wc) * 64; mode = 2; g = g_qa; scale = C2; }
        else if (pn < 4)  { dst = QB; pitch = 512; coff = ((pn - 2) * 4 + wc) * 64; mode = 2; g = g_qb; scale = C2; }
        else if (pn < 6)  { dst = KB; pitch = 512; coff = ((pn - 4) * 4 + wc) * 64; mode = 2; g = g_kb; }
        else              { dst = VB; pitch = 512; coff = ((pn - 6) * 4 + wc) * 64; mode = 1; }
        if (mode == 0) return;
        const int d0 = 8 * fq;
        f32x4 g0a = {1.f, 1.f, 1.f, 1.f}, g0b = g0a, g1a = g0a, g1b = g0a;
        if (mode == 2) { g0a = *(const f32x4*)(g + d0); g0b = *(const f32x4*)(g + d0 + 4); g1a = *(const f32x4*)(g + 32 + d0); g1b = *(const f32x4*)(g + 36 + d0); }
#pragma unroll
        for (int ai = 0; ai < 2; ++ai)
#pragma unroll
            for (int m = 0; m < 4; ++m) {
                const int row = u.pm * BM + ai * HALF + wr * 64 + m * 16 + fr;
                const float r = rs[row];
                f32x4 l0 = acc[ai][0][m][0] * r, l1 = acc[ai][0][m][1] * r, h0 = acc[ai][1][m][0] * r, h1 = acc[ai][1][m][1] * r;
                if (mode == 2) {
                    float ss = (sq4(l0) + sq4(l1)) + (sq4(h0) + sq4(h1));
                    ss += __shfl_xor(ss, 16); ss += __shfl_xor(ss, 32);
                    const float rn = rsqrtf(ss * (1.f / 64.f) + EPS);
                    l0 = l0 * rn * g0a; l1 = l1 * rn * g0b; h0 = h0 * rn * g1a; h1 = h1 * rn * g1b;
                    const f32x4 c0 = *(const f32x4*)(ct + (size_t)row * 32 + d0), c1 = *(const f32x4*)(ct + (size_t)row * 32 + d0 + 4);
                    const f32x4 s0 = *(const f32x4*)(st + (size_t)row * 32 + d0), s1 = *(const f32x4*)(st + (size_t)row * 32 + d0 + 4);
                    const f32x4 nl0 = l0 * c0 - h0 * s0, nh0 = h0 * c0 + l0 * s0, nl1 = l1 * c1 - h1 * s1, nh1 = h1 * c1 + l1 * s1;
                    l0 = nl0 * scale; l1 = nl1 * scale; h0 = nh0 * scale; h1 = nh1 * scale;
                }
                bf16_t* p = dst + (size_t)row * pitch + coff + d0;
                st16_wt(p, pack8(l0, l1));
                st16_wt((p + 32), pack8(h0, h1));
            }
    }
};
struct EpiIdx {
    static constexpr bool PERM = true, AFTER_DRAIN = false;
    bf16_t *QIH, *QIL, *KIH, *KIL; float* WI; bf16_t *KA, *VA;
    const float *rs, *ct, *st, *g_ka;
    __device__ __forceinline__ void operator()(const f32x4 (&acc)[2][2][4][2], const Unit& u, int wr, int wc, int fr, int fq) const {
        const int pn = u.pn;
        const int d0 = 8 * fq;
#pragma unroll
        for (int ai = 0; ai < 2; ++ai)
#pragma unroll
            for (int m = 0; m < 4; ++m) {
                const int row = u.pm * BM + ai * HALF + wr * 64 + m * 16 + fr;
                const float r = rs[row];
                f32x4 l0 = acc[ai][0][m][0] * r, l1 = acc[ai][0][m][1] * r, h0 = acc[ai][1][m][0] * r, h1 = acc[ai][1][m][1] * r;
                if (pn == 1 && wc == 1) { if (fq == 0) *(f32x4*)(WI + (size_t)row * 4) = l0 * 0.0625f; continue; }
                if (pn == 1 && wc == 3) { bf16_t* p = VA + (size_t)row * 64 + d0; st16_wt(p, pack8(l0, l1)); st16_wt((p + 32), pack8(h0, h1)); continue; }
                if (pn == 1 && wc == 2) {
                    float ss = (sq4(l0) + sq4(l1)) + (sq4(h0) + sq4(h1));
                    ss += __shfl_xor(ss, 16); ss += __shfl_xor(ss, 32);
                    const float rn = rsqrtf(ss * (1.f / 64.f) + EPS);
                    l0 = l0 * rn * *(const f32x4*)(g_ka + d0); l1 = l1 * rn * *(const f32x4*)(g_ka + d0 + 4); h0 = h0 * rn * *(const f32x4*)(g_ka + 32 + d0); h1 = h1 * rn * *(const f32x4*)(g_ka + 36 + d0);
                }
                const f32x4 c0 = *(const f32x4*)(ct + (size_t)row * 32 + d0), c1 = *(const f32x4*)(ct + (size_t)row * 32 + d0 + 4);
                const f32x4 s0 = *(const f32x4*)(st + (size_t)row * 32 + d0), s1 = *(const f32x4*)(st + (size_t)row * 32 + d0 + 4);
                const f32x4 nl0 = l0 * c0 - h0 * s0, nh0 = h0 * c0 + l0 * s0, nl1 = l1 * c1 - h1 * s1, nh1 = h1 * c1 + l1 * s1;
                if (pn == 1 && wc == 2) { bf16_t* p = KA + (size_t)row * 64 + d0; st16_wt(p, pack8(nl0, nl1)); st16_wt((p + 32), pack8(nh0, nh1)); continue; }
                bf16_t* ph = pn == 0 ? QIH + (size_t)row * 256 + wc * 64 + d0 : KIH + (size_t)row * 64 + d0;
                st16_wt(ph, pack8(nl0, nl1)); st16_wt((ph + 32), pack8(nh0, nh1));
            }
    }
};
template <bool I8> __device__ __forceinline__ f32x4 mma16(const bf16x8 b, const bf16x8 a, const f32x4 c) {
    if constexpr (I8) { typedef int i32x4_ __attribute__((ext_vector_type(4)));
        return __builtin_bit_cast(f32x4, __builtin_amdgcn_mfma_i32_16x16x64_i8(__builtin_bit_cast(i32x4_, b), __builtin_bit_cast(i32x4_, a), __builtin_bit_cast(i32x4_, c), 0, 0, 0)); }
    else return __builtin_amdgcn_mfma_f32_16x16x32_bf16(b, a, c, 0, 0, 0);
}
template <class Epi, class Sched, bool ALIGN_EPI = false, bool SP2 = false, bool I8 = false>
__device__ __forceinline__ void gemm_phase(PG8_LAS unsigned char* lds, const Gemm g, const Sched& S, const Epi& E, const int wid) {
    const int lane = lane_id(), tid = wid * 64 + lane, wr = wid >> 2, wc = wid & 3, fr = lane & 15, fq = lane >> 4;
    const int nt = g.K / BK; const unsigned amask = g.amask;
    unsigned voffA[2], voffB[2];
#pragma unroll
    for (int i = 0; i < 2; ++i) { int R, C; stage_rc(tid * 16 + i * 8192, R, C); const int Rb = Epi::PERM ? ((R & ~31) + perm32(R & 31)) : R;
        voffA[i] = (unsigned)(R * g.lda + C) * 2u; voffB[i] = (unsigned)(Rb * g.ldb + C) * 2u; }
    const size_t kstep = (size_t)(BK * 2);
    const size_t hstepA = (size_t)HALF * g.lda * 2, hstepB = (size_t)HALF * g.ldb * 2;
#define PG8_AK(tau) ((size_t)(((unsigned)(tau) * 128u) & amask))
    const unsigned ldsw = (unsigned)wid * 1024u;
    const int aoff = lds_byte(wr * 64 + fr, fq * 8), boff = lds_byte(wc * 32 + fr, fq * 8);
#define PG8_SA(b, h) (((b) * 2 + (h)) * HTB)
#define PG8_SB(b, h) ((4 + (b) * 2 + (h)) * HTB)
#define PG8_STAGE(bufoff, gbase, voff) do { const char* gb_ = uptr(gbase); _Pragma("unroll") for (int _i = 0; _i < 2; ++_i) \
        __builtin_amdgcn_global_load_lds((const unsigned*)(gb_ + (voff)[_i]), (PG8_LAS unsigned*)(lds + (bufoff) + ldsw + _i * 8192), 16, 0, 0); } while (0)
#define PG8_LDA(dst, b, h) do { _Pragma("unroll") for (int m = 0; m < 4; ++m) _Pragma("unroll") for (int k = 0; k < 2; ++k) dst[m][k] = *(const PG8_LAS bf16x8*)(lds + PG8_SA(b, h) + aoff + m * 2048 + k * 1024); } while (0)
#define PG8_LDB(dst, b, h) do { _Pragma("unroll") for (int n = 0; n < 2; ++n) _Pragma("unroll") for (int k = 0; k < 2; ++k) dst[n][k] = *(const PG8_LAS bf16x8*)(lds + PG8_SB(b, h) + boff + n * 2048 + k * 1024); } while (0)
#define PG8_MMA(ai, bj, At, Bt) do { __builtin_amdgcn_s_setprio(1); _Pragma("unroll") for (int m = 0; m < 4; ++m) _Pragma("unroll") for (int n = 0; n < 2; ++n) _Pragma("unroll") for (int k = 0; k < 2; ++k) \
        acc[ai][bj][m][n] = mma16<I8>(Bt[n][k], At[m][k], acc[ai][bj][m][n]); __builtin_amdgcn_s_setprio(0); } while (0)
#define PG8_WAIT_V(n) asm volatile("s_waitcnt vmcnt(" #n ")" ::: "memory")
#define PG8_WAIT_L(n) asm volatile("s_waitcnt lgkmcnt(" #n ")" ::: "memory")
#define PG8_BAR __builtin_amdgcn_s_barrier()
#define PG8_SCHED __builtin_amdgcn_sched_barrier(0)
    Unit cur, nxt; int ui = 0;
    if (!S.next(0, cur)) return;
    f32x4 acc[2][2][4][2];
#pragma unroll
    for (int a = 0; a < 2; ++a)
#pragma unroll
        for (int b = 0; b < 2; ++b)
#pragma unroll
            for (int m = 0; m < 4; ++m)
#pragma unroll
                for (int n = 0; n < 2; ++n) acc[a][b][m][n] = (f32x4){0.f, 0.f, 0.f, 0.f};
    bf16x8 At[4][2], B0[2][2], B1[2][2];
    const char* cA = (const char*)g.A + cur.ao; const char* cB = (const char*)g.Bt + cur.bo;
    S.a_ready(cur);
    if constexpr (SP2) {
        PG8_STAGE(PG8_SB(0, 0), cB, voffB); PG8_STAGE(PG8_SB(0, 1), cB + hstepB, voffB); PG8_STAGE(PG8_SA(0, 0), cA, voffA); PG8_STAGE(PG8_SA(0, 1), cA + hstepA, voffA);
        if (wr == 1) PG8_BAR;
        PG8_WAIT_V(2); PG8_BAR;
        PG8_STAGE(PG8_SB(1, 0), cB + kstep, voffB); PG8_STAGE(PG8_SA(1, 0), cA + PG8_AK(1), voffA); PG8_STAGE(PG8_SB(1, 1), cB + hstepB + kstep, voffB);
        PG8_WAIT_V(6); PG8_BAR;
    } else {
        PG8_STAGE(PG8_SB(0, 0), cB, voffB); PG8_STAGE(PG8_SA(0, 0), cA, voffA); PG8_STAGE(PG8_SB(0, 1), cB + hstepB, voffB); PG8_STAGE(PG8_SA(0, 1), cA + hstepA, voffA);
        if (wr == 1) PG8_BAR;
        PG8_WAIT_V(4); PG8_BAR;
        PG8_STAGE(PG8_SB(1, 0), cB + kstep, voffB); PG8_STAGE(PG8_SA(1, 0), cA + PG8_AK(1), voffA); PG8_STAGE(PG8_SB(1, 1), cB + hstepB + kstep, voffB);
        PG8_WAIT_V(6); PG8_BAR;
    }
    for (;;) {
        const bool has_next = S.next(ui + 1, nxt);
        const char* nA = has_next ? (const char*)g.A + nxt.ao : cA; const char* nB = has_next ? (const char*)g.Bt + nxt.bo : cB;
        for (int t = 0; t < nt; t += 2) {
            const bool last = (t == nt - 2);
            const char* a1 = cA + PG8_AK(t + 1);
            const char* a2 = last ? nA : cA + PG8_AK(t + 2); const char* b2 = last ? nB : cB + (size_t)(t + 2) * kstep;
            const char* a3 = last ? nA + PG8_AK(1) : cA + PG8_AK(t + 3); const char* b3 = b2 + kstep;
            if (last && has_next) S.a_ready(nxt);
            if constexpr (SP2) {
            PG8_LDB(B0, 0, 0); PG8_LDB(B1, 0, 1); PG8_SCHED; PG8_LDA(At, 0, 0); PG8_STAGE(PG8_SA(1, 1), a1 + hstepA, voffA);
            PG8_WAIT_V(8); PG8_WAIT_L(0); PG8_BAR; PG8_MMA(0, 0, At, B0); PG8_MMA(0, 1, At, B1); PG8_BAR; PG8_SCHED;
            PG8_LDA(At, 0, 1); PG8_STAGE(PG8_SB(0, 0), b2, voffB); PG8_STAGE(PG8_SB(0, 1), b2 + hstepB, voffB); PG8_STAGE(PG8_SA(0, 0), a2, voffA);
            PG8_WAIT_V(8); PG8_WAIT_L(0); PG8_BAR; PG8_MMA(1, 0, At, B0); PG8_MMA(1, 1, At, B1); PG8_BAR; PG8_SCHED;
            PG8_LDB(B0, 1, 0); PG8_LDB(B1, 1, 1); PG8_SCHED; PG8_LDA(At, 1, 0); PG8_STAGE(PG8_SA(0, 1), a2 + hstepA, voffA);
            PG8_WAIT_V(8); PG8_WAIT_L(0); PG8_BAR; PG8_MMA(0, 0, At, B0); PG8_MMA(0, 1, At, B1); PG8_BAR; PG8_SCHED;
            PG8_LDA(At, 1, 1); PG8_STAGE(PG8_SB(1, 0), b3, voffB); PG8_STAGE(PG8_SB(1, 1), b3 + hstepB, voffB); PG8_STAGE(PG8_SA(1, 0), a3, voffA);
            PG8_WAIT_V(8); PG8_WAIT_L(0); PG8_BAR; PG8_MMA(1, 0, At, B0); PG8_MMA(1, 1, At, B1); PG8_BAR; PG8_SCHED;
            } else {
            PG8_LDB(B0, 0, 0); PG8_SCHED; PG8_LDA(At, 0, 0); PG8_STAGE(PG8_SA(1, 1), a1 + hstepA, voffA);
            PG8_WAIT_L(8); PG8_BAR; PG8_WAIT_L(0); PG8_MMA(0, 0, At, B0); PG8_BAR; PG8_SCHED;
            PG8_LDB(B1, 0, 1); PG8_STAGE(PG8_SB(0, 0), b2, voffB);
            PG8_BAR; PG8_WAIT_L(0); PG8_MMA(0, 1, At, B1); PG8_BAR;
            PG8_LDA(At, 0, 1); PG8_STAGE(PG8_SA(0, 0), a2, voffA);
            PG8_BAR; PG8_WAIT_L(0); PG8_MMA(1, 0, At, B0); PG8_BAR; PG8_SCHED;
            PG8_STAGE(PG8_SB(0, 1), b2 + hstepB, voffB);
            PG8_WAIT_V(6); PG8_BAR; PG8_MMA(1, 1, At, B1); PG8_BAR;
            PG8_LDB(B0, 1, 0); PG8_SCHED; PG8_LDA(At, 1, 0); PG8_STAGE(PG8_SA(0, 1), a2 + hstepA, voffA);
            PG8_WAIT_L(8); PG8_BAR; PG8_WAIT_L(0); PG8_MMA(0, 0, At, B0); PG8_BAR; PG8_SCHED;
            PG8_LDB(B1, 1, 1); PG8_STAGE(PG8_SB(1, 0), b3, voffB);
            PG8_BAR; PG8_WAIT_L(0); PG8_MMA(0, 1, At, B1); PG8_BAR;
            PG8_LDA(At, 1, 1); PG8_STAGE(PG8_SA(1, 0), a3, voffA);
            PG8_BAR; PG8_WAIT_L(0); PG8_MMA(1, 0, At, B0); PG8_BAR; PG8_SCHED;
            PG8_STAGE(PG8_SB(1, 1), b3 + hstepB, voffB);
            PG8_WAIT_V(6); PG8_BAR; PG8_MMA(1, 1, At, B1); PG8_BAR;
            }
        }
        if constexpr (ALIGN_EPI) { if (wr == 0) PG8_BAR; }
        if constexpr (!Epi::AFTER_DRAIN) { E(acc, cur, wr, wc, fr, fq); S.done(cur); }
        if (!has_next) break;
#pragma unroll
        for (int a = 0; a < 2; ++a)
#pragma unroll
            for (int b = 0; b < 2; ++b)
#pragma unroll
                for (int m = 0; m < 4; ++m)
#pragma unroll
                    for (int n = 0; n < 2; ++n) acc[a][b][m][n] = (f32x4){0.f, 0.f, 0.f, 0.f};
        cur = nxt; cA = nA; cB = nB; ++ui;
        if constexpr (ALIGN_EPI) { if (wr == 1) PG8_BAR; }
    }
    PG8_WAIT_V(0);
    if constexpr (!ALIGN_EPI) { if (wr == 0) PG8_BAR; }
    PG8_BAR;
    if constexpr (Epi::AFTER_DRAIN) { E.fused(acc, cur, wr, wc, fr, fq, lds, wid, lane); S.done(cur); }
#undef PG8_AK
#undef PG8_SA
#undef PG8_SB
#undef PG8_STAGE
#undef PG8_LDA
#undef PG8_LDB
#undef PG8_MMA
#undef PG8_WAIT_V
#undef PG8_WAIT_L
#undef PG8_BAR
#undef PG8_SCHED
}
}
constexpr int NWAVES = 8;
constexpr size_t MiB = 1u << 20;
constexpr size_t WS_CTL = 0, CTL_ZERO_BYTES = 1 * MiB;
constexpr size_t WS_W1T = 1 * MiB;
constexpr size_t WS_WIT = 6 * MiB;
constexpr size_t WS_WOUT = 9 * MiB;
constexpr size_t WS_WXQ = 11 * MiB;
constexpr size_t WS_WXKV = 13 * MiB;
constexpr size_t WS_WXO = 17 * MiB;
constexpr size_t WS_WF1 = 19 * MiB;
constexpr size_t WS_WF2 = 30 * MiB;
constexpr size_t WS_CT = 36 * MiB, WS_ST = 40 * MiB;
constexpr size_t WS_RS0 = 44 * MiB;
constexpr size_t WS_RSM = 44 * MiB + 128 * 1024;
constexpr size_t WS_LAM = 44 * MiB + 192 * 1024;
constexpr size_t WS_SS1 = 45 * MiB, WS_SS2 = 47 * MiB;
constexpr size_t WS_MEMB = 49 * MiB;
constexpr size_t WS_KX = 57 * MiB;
constexpr size_t WS_VXT = 65 * MiB;
constexpr size_t WS_MASK = 73 * MiB;
constexpr size_t WS_WI = 81 * MiB;
constexpr size_t WS_KIH = 82 * MiB, WS_KIL = 86 * MiB, WS_KA = 90 * MiB, WS_VA = 94 * MiB;
constexpr size_t WS_QIH = 98 * MiB, WS_QIL = 114 * MiB;
constexpr size_t WS_QA = 130 * MiB, WS_QB = 162 * MiB, WS_KB = 194 * MiB, WS_VB = 226 * MiB;
constexpr size_t WS_A2 = 258 * MiB;
constexpr size_t WS_ATT = 386 * MiB;
constexpr size_t WS_END = 512 * MiB;
constexpr int CW_BAR = 4096;

constexpr int RING_OFF = 0, RING_BYTES = 131072;
constexpr int LDSCTL_OFF = RING_BYTES, MISC_OFF = LDSCTL_OFF + 320, LDSX_OFF = RING_BYTES + 1024;
constexpr int LDS_BYTES = 147456;

#define GAS __attribute__((address_space(1)))
#define LAS __attribute__((address_space(3)))
typedef unsigned short bf16;
typedef unsigned v4u __attribute__((ext_vector_type(4)));
typedef unsigned v2u __attribute__((ext_vector_type(2)));
typedef float f32x4 __attribute__((ext_vector_type(4)));
typedef short bf16x8 __attribute__((ext_vector_type(8)));
#define LDS_WAIT() asm volatile("s_waitcnt lgkmcnt(0)" ::: "memory")
#define VM_WAIT() asm volatile("s_waitcnt vmcnt(0)" ::: "memory")
__device__ __forceinline__ unsigned f2bf(float f) { unsigned u = __builtin_bit_cast(unsigned, f); return (u + 0x7fffu + ((u >> 16) & 1u)) >> 16; }
__device__ __forceinline__ unsigned pk2(float lo, float hi) { return f2bf(lo) | (f2bf(hi) << 16); }
__device__ __forceinline__ int lane_now() { int l; asm volatile("v_mbcnt_lo_u32_b32 %0, -1, 0\n\tv_mbcnt_hi_u32_b32 %0, -1, %0" : "=v"(l)); return l; }
__device__ __forceinline__ float bf2f(bf16 b) { return __uint_as_float((unsigned)b << 16); }
#define XB_TMO      128
#define XB_XCNT(j)  (256  + 64 * (j))
#define XB_XSUB(j)  (1280 + 64 * (j))
#define XB_XGEN(j)  (2304 + 64 * (j))
#define XB_TOP      3328
#define XB_TOPGEN   3392
#define XCD_BAR_WORDS 3456
#define XB_SPIN_CAP (1u << 18)

__device__ __forceinline__ unsigned xb_ld(unsigned* p)              { return __hip_atomic_load(p, __ATOMIC_RELAXED, __HIP_MEMORY_SCOPE_AGENT); }
__device__ __forceinline__ unsigned xb_add(unsigned* p, unsigned v) { return __hip_atomic_fetch_add(p, v, __ATOMIC_RELAXED, __HIP_MEMORY_SCOPE_AGENT); }
__device__ __forceinline__ unsigned xb_xcc_id() { return (unsigned)__builtin_amdgcn_s_getreg((3 << 11) | 20) & 0xFu; }
#define XB_SPIN(cond, bar) do { unsigned _sp = 0; while (cond) { __builtin_amdgcn_s_sleep(1); \
    if ((++_sp & 255u) == 0u) { if (xb_ld(&(bar)[XB_TMO])) break; if (_sp > XB_SPIN_CAP) { atomicAdd(&(bar)[XB_TMO], 1u); break; } } } } while (0)

struct XcdBarrier {
    unsigned* bar; unsigned x; int wave;
    volatile LAS unsigned* st;
};

__device__ __forceinline__ XcdBarrier xcd_barrier_post(unsigned* bar, volatile LAS unsigned* st, int wave) {
    XcdBarrier b; b.bar = bar; b.x = xb_xcc_id(); b.st = st; b.wave = wave;
    if (wave == 0 && lane_now() == 0) (void)xb_add(&bar[XB_XCNT(b.x)], 1u);
    return b;
}
__device__ __forceinline__ void xcd_barrier_complete(unsigned* bar, unsigned x, unsigned& nloc, unsigned& nx) {
    const unsigned G = gridDim.x * gridDim.y * gridDim.z;
    unsigned sum, cnt, mine, sp = 0u;
    for (;;) {
        sum = 0u; cnt = 0u; mine = 0u;
#pragma unroll
        for (unsigned j = 0; j < 16; ++j) { const unsigned c = xb_ld(&bar[XB_XCNT(j)]); sum += c; cnt += (c > 0u) ? 1u : 0u; mine = (j == x) ? c : mine; }
        if (sum == G) break;
        __builtin_amdgcn_s_sleep(1);
        if ((++sp & 255u) == 0u) { if (xb_ld(&bar[XB_TMO])) break; if (sp > XB_SPIN_CAP) { atomicAdd(&bar[XB_TMO], 1u); break; } }
    }
    nloc = mine > 0u ? mine : 1u; nx = cnt > 0u ? cnt : 1u;
}

__device__ __forceinline__ void xcd_barrier(const XcdBarrier& b) {
    asm volatile("s_waitcnt vmcnt(0)" ::: "memory");
    __syncthreads();
    if (b.wave == 0 && lane_now() == 0) {
        unsigned* bar = b.bar;
        __builtin_amdgcn_s_waitcnt(0);
        unsigned nloc = b.st[0], nx = b.st[1];
        if (nloc == 0u) { xcd_barrier_complete(bar, b.x, nloc, nx); b.st[0] = nloc; b.st[1] = nx; }
        const unsigned old = xb_add(&bar[XB_XSUB(b.x)], 1u);
        const unsigned gen = old / nloc;
        if (old + 1u == (gen + 1u) * nloc) {
            __builtin_amdgcn_fence(__ATOMIC_RELEASE, "agent");
            asm volatile("s_waitcnt vmcnt(0)" ::: "memory");
            const unsigned og = xb_add(&bar[XB_TOP], 1u);
            const unsigned tg = og / nx;
            if (og + 1u == (tg + 1u) * nx) xb_add(&bar[XB_TOPGEN], 1u);
            else XB_SPIN(xb_ld(&bar[XB_TOPGEN]) == tg, bar);
            __builtin_amdgcn_fence(__ATOMIC_ACQUIRE, "agent");
            xb_add(&bar[XB_XGEN(b.x)], 1u);
            asm volatile("s_waitcnt vmcnt(0)" ::: "memory");
        } else {
            XB_SPIN(xb_ld(&bar[XB_XGEN(b.x)]) == gen, bar);
            __builtin_amdgcn_fence(__ATOMIC_ACQUIRE, "agent");
            asm volatile("s_waitcnt vmcnt(0)" ::: "memory");
        }
    }
    __syncthreads();
}
struct Args { const void* in[27]; float* out; unsigned char* ws; RopeF rf; int ph_lo, ph_hi; };
struct Frame {
    LAS unsigned char* lds;
    int wave, vcu, G;
    unsigned char* ws; float* out;
};
#define WSP(T, off) ((T*)(F.ws + (off)))

__device__ __forceinline__ void sincos_acc(float ang, float& c, float& s) {
    const double a = (double)ang;
    const double k = rint(a * 0.63661977236758134308);
    double r = fma(-k, 1.57079632679489655800e+00, a);
    r = fma(-k, 6.12323399573676603587e-17, r);
    const double r2 = r * r;
    double sp = -1.0 / 1307674368000.0;
    sp = fma(sp, r2, 1.0 / 6227020800.0); sp = fma(sp, r2, -1.0 / 39916800.0); sp = fma(sp, r2, 1.0 / 362880.0); sp = fma(sp, r2, -1.0 / 5040.0);
    sp = fma(sp, r2, 1.0 / 120.0); sp = fma(sp, r2, -1.0 / 6.0); sp = fma(sp, r2, 1.0);
    const double sn = sp * r;
    double cp = 1.0 / 20922789888000.0;
    cp = fma(cp, r2, -1.0 / 87178291200.0); cp = fma(cp, r2, 1.0 / 479001600.0); cp = fma(cp, r2, -1.0 / 3628800.0); cp = fma(cp, r2, 1.0 / 40320.0);
    cp = fma(cp, r2, -1.0 / 720.0); cp = fma(cp, r2, 1.0 / 24.0); cp = fma(cp, r2, -0.5);
    const double cs = fma(cp, r2, 1.0);
    const int q = ((int)k) & 3;
    double cc, ss;
    if (q == 0) { cc = cs; ss = sn; } else if (q == 1) { cc = -sn; ss = cs; } else if (q == 2) { cc = -cs; ss = -sn; } else { cc = sn; ss = -cs; }
    c = (float)cc; s = (float)ss;
}

__device__ __forceinline__ int srcmap(int mat, int r) {
    if (mat == 0 || mat == 1) {
        const int tile = r >> 8, cpos = r & 255, slot = (cpos >> 5) & 3, dim = ((cpos >> 7) << 5) | (cpos & 31);
        if (mat == 0) {
            if (tile < 2) return OFF_QA + (tile * 4 + slot) * 64 + dim;
            if (tile < 4) return OFF_QB + ((tile - 2) * 4 + slot) * 64 + dim;
            if (tile < 6) return OFF_KB + ((tile - 4) * 4 + slot) * 64 + dim;
            return OFF_VB + ((tile - 6) * 4 + slot) * 64 + dim;
        }
        if (tile == 0) return OFF_QI + slot * 64 + dim;
        if (slot == 0) return OFF_KI + dim;
        if (slot == 1) return dim < 4 ? OFF_WI + dim : -1;
        return slot == 2 ? OFF_KA + dim : OFF_VA + dim;
    }
    if (mat == 7) { const int tile = r >> 8, half = (r >> 7) & 1, within = r & 127; return half * DFF + tile * 128 + within; }
    return r;
}
__device__ __forceinline__ void p0_item(const float* W, int ldw, const float* g, bf16* WT, int ldd, int row_off, int mat, bool split, LAS float* scr, int item, int nkb, int lane) {
    const int rb = item / nkb, kb = item % nkb, k0 = 64 * kb, r0 = 32 * rb;
    const int src = srcmap(mat, r0 + (lane & 31));
    float wv[32];
    const float* wp = W + (size_t)(k0 + (lane >> 5)) * ldw + (src >= 0 ? src : 0);
#pragma unroll
    for (int i = 0; i < 32; ++i) wv[i] = __builtin_nontemporal_load(wp + (size_t)(2 * i) * ldw);
    const float gz = src >= 0 ? 1.f : 0.f;
#pragma unroll
    for (int i = 0; i < 32; ++i) { const int kk = 2 * i + (lane >> 5);
        float v = wv[i] * gz; if (g) v *= g[k0 + kk];
        scr[kk * 33 + (lane & 31)] = v; }
    LDS_WAIT(); asm volatile("" ::: "memory");
    const int c = lane & 7;
#pragma unroll
    for (int j = 0; j < 4; ++j) { const int n = (lane >> 3) + 8 * j; const LAS float* s = scr + (8 * c) * 33 + n;
        const float v0 = s[0 * 33], v1 = s[1 * 33], v2 = s[2 * 33], v3 = s[3 * 33], v4 = s[4 * 33], v5 = s[5 * 33], v6 = s[6 * 33], v7 = s[7 * 33];
        v4u o; o.x = pk2(v0, v1); o.y = pk2(v2, v3); o.z = pk2(v4, v5); o.w = pk2(v6, v7);
        bf16* d = WT + (size_t)(row_off + r0 + n) * ldd + k0 + 8 * c;
        *(GAS v4u*)d = o;
        if (split) {
            *(GAS v4u*)(d + 1024) = o;
            v4u l; l.x = pk2(v0 - __uint_as_float(o.x << 16), v1 - __uint_as_float(o.x & 0xffff0000u)); l.y = pk2(v2 - __uint_as_float(o.y << 16), v3 - __uint_as_float(o.y & 0xffff0000u));
            l.z = pk2(v4 - __uint_as_float(o.z << 16), v5 - __uint_as_float(o.z & 0xffff0000u)); l.w = pk2(v6 - __uint_as_float(o.w << 16), v7 - __uint_as_float(o.w & 0xffff0000u));
            *(GAS v4u*)(d + 2048) = l;
        } }
    LDS_WAIT(); asm volatile("" ::: "memory");
}
__device__ __forceinline__ void p0_xrow_store(Frame& F, int m, const f32x4 (&v)[4], float s) {
    s = wave_sum(s);
    if (lane_now() == 0) WSP(float, WS_RS0)[m] = rsqrtf(s * (1.f / DM) + EPS);
    GAS v2u* o8 = (GAS v2u*)(WSP(bf16, WS_A2) + (size_t)m * 2048) + lane_now();
#pragma unroll
    for (int j = 0; j < 4; ++j) {
        v2u h; h.x = pk2(v[j].x, v[j].y); h.y = pk2(v[j].z, v[j].w);
        o8[64 * j] = h;
    }
}
__device__ __forceinline__ void p0_prologue(Frame& F, const Args& A) {
    const int NH = F.G * NWAVES;
    const int gw = F.vcu * NWAVES + F.wave;
    for (int pass = 0; pass < 2; ++pass) {
    if ((pass ^ (F.wave & 1)) == 0) {
        LAS float* scr = (LAS float*)(F.lds + RING_OFF + F.wave * 16384);
        const float* w_in = (const float*)A.in[4]; const float* g_mix = (const float*)A.in[3];
        constexpr int I0 = 64 * 16, I1 = 16 * 16, I2 = 512, I7 = 176 * 16, I8 = 32 * 44;
        constexpr int NITEMS = I0 + I1 + 5 * I2 + I7 + I8;
        for (int it = gw; it < NITEMS; it += NH) {
            int r = it;
            if (r < I0) { p0_item(w_in, INC, g_mix, WSP(bf16, WS_W1T), 1024, 0, 0, false, scr, r, 16, lane_now()); continue; } r -= I0;
            if (r < I1) { p0_item(w_in, INC, g_mix, WSP(bf16, WS_W1T), 1024, 2048, 1, false, scr, r, 16, lane_now()); continue; } r -= I1;
            if (r < I2) { p0_item((const float*)A.in[13], DM, nullptr, WSP(bf16, WS_WOUT), 1024, 0, 2, false, scr, r, 16, lane_now()); continue; } r -= I2;
            if (r < I2) { p0_item((const float*)A.in[16], DM, (const float*)A.in[14], WSP(bf16, WS_WXQ), 1024, 0, 3, false, scr, r, 16, lane_now()); continue; } r -= I2;
            if (r < I2) { p0_item((const float*)A.in[17], DM, (const float*)A.in[15], WSP(bf16, WS_WXKV), 1024, 0, 4, false, scr, r, 16, lane_now()); continue; } r -= I2;
            if (r < I2) { p0_item((const float*)A.in[18], DM, (const float*)A.in[15], WSP(bf16, WS_WXKV), 1024, 1024, 5, false, scr, r, 16, lane_now()); continue; } r -= I2;
            if (r < I2) { p0_item((const float*)A.in[19], DM, nullptr, WSP(bf16, WS_WXO), 1024, 0, 6, false, scr, r, 16, lane_now()); continue; } r -= I2;
            if (r < I7) { p0_item((const float*)A.in[23], 2 * DFF, (const float*)A.in[22], WSP(bf16, WS_WF1), 1024, 0, 7, false, scr, r, 16, lane_now()); continue; } r -= I7;
            p0_item((const float*)A.in[26], DM, nullptr, WSP(bf16, WS_WF2), DFF, 0, 8, false, scr, r, 44, lane_now());
        }
        const int* pos = (const int*)A.in[2];
        for (int i = gw * 64 + lane_now(); i < NTOK * 32; i += NH * 64) {
            const float ang = (float)pos[i >> 5] * A.rf.f[i & 31];
            float c, s; sincos_acc(ang, c, s);
            WSP(float, WS_CT)[i] = c; WSP(float, WS_ST)[i] = s;
        }
        if (blockIdx.x == 0 && F.wave == 0) {
            const float a = ((const float*)A.in[9])[lane_now()] * ((const float*)A.in[10])[lane_now()], b = ((const float*)A.in[11])[lane_now()] * ((const float*)A.in[12])[lane_now()];
            const float l1 = wave_sum(a), l2 = wave_sum(b);
            if (lane_now() == 0) WSP(float, WS_LAM)[0] = expf(l1) - expf(l2) + 0.2f;
        }
    } else {
        const float* x = (const float*)A.in[0];
        for (int m = gw; m < NTOK; m += 2 * NH) {
            const int m2 = m + NH;
            const GAS f32x4* xr = (const GAS f32x4*)(x + (size_t)m * DM) + lane_now();
            const GAS f32x4* xr2 = (const GAS f32x4*)(x + (size_t)(m2 < NTOK ? m2 : m) * DM) + lane_now();
            f32x4 v[4], w[4]; float s = 0.f, s2 = 0.f;
#pragma unroll
            for (int j = 0; j < 4; ++j) { v[j] = __builtin_nontemporal_load(xr + 64 * j); w[j] = __builtin_nontemporal_load(xr2 + 64 * j); }
#pragma unroll
            for (int j = 0; j < 4; ++j) { s += (v[j].x * v[j].x + v[j].y * v[j].y) + (v[j].z * v[j].z + v[j].w * v[j].w); s2 += (w[j].x * w[j].x + w[j].y * w[j].y) + (w[j].z * w[j].z + w[j].w * w[j].w); }
            p0_xrow_store(F, m, v, s);
            if (m2 < NTOK) p0_xrow_store(F, m2, w, s2);
        }
        const float* mem = (const float*)A.in[1];
        for (int m = gw; m < NMTOK; m += NH) {
            const GAS f32x4* xr = (const GAS f32x4*)(mem + (size_t)m * DM) + lane_now();
            f32x4 v[4]; float s = 0.f;
#pragma unroll
            for (int j = 0; j < 4; ++j) { v[j] = xr[64 * j]; s += (v[j].x * v[j].x + v[j].y * v[j].y) + (v[j].z * v[j].z + v[j].w * v[j].w); }
            s = wave_sum(s);
            if (lane_now() == 0) WSP(float, WS_RSM)[m] = rsqrtf(s * (1.f / DM) + EPS);
            GAS v2u* o8 = (GAS v2u*)(WSP(bf16, WS_MEMB) + (size_t)m * DM) + lane_now();
#pragma unroll
            for (int j = 0; j < 4; ++j) { v2u h; h.x = pk2(v[j].x, v[j].y); h.y = pk2(v[j].z, v[j].w); o8[64 * j] = h; }
        }
    }
    }
}

struct EpiProjIdx {
    static constexpr bool PERM = true, AFTER_DRAIN = false;
    pg8::EpiProj p; pg8::EpiIdx x;
    __device__ __forceinline__ void operator()(const pg8::f32x4 (&acc)[2][2][4][2], const pg8::Unit& u, int wr, int wc, int fr, int fq) const {
        if (u.pn < 8) p(acc, u, wr, wc, fr, fq);
        else { pg8::Unit v = u; v.pn = u.pn - 8; x(acc, v, wr, wc, fr, fq); }
    }
};
__device__ __forceinline__ void p1_proj(Frame& F, const Args& A) {
    const float* rs = WSP(float, WS_RS0); const float* ct = WSP(float, WS_CT); const float* st = WSP(float, WS_ST);
    pg8::Gemm g{WSP(bf16, WS_A2), WSP(bf16, WS_W1T), 2048, 1024, 1024, 0xffffffffu};
    pg8::TileOrder S; S.init(128, 10, F.G, (int)blockIdx.x, (size_t)256 * 2048 * 2, (size_t)256 * 1024 * 2);
    EpiProjIdx E{pg8::EpiProj{WSP(bf16, WS_QA), WSP(bf16, WS_QB), WSP(bf16, WS_KB), WSP(bf16, WS_VB), rs, ct, st, (const float*)A.in[5], (const float*)A.in[7], (const float*)A.in[8]},
                 pg8::EpiIdx{WSP(bf16, WS_QIH), WSP(bf16, WS_QIL), WSP(bf16, WS_KIH), WSP(bf16, WS_KIL), WSP(float, WS_WI), WSP(bf16, WS_KA), WSP(bf16, WS_VA), rs, ct, st, (const float*)A.in[6]}};
    pg8::gemm_phase<EpiProjIdx, pg8::TileOrder, true, true>(F.lds + RING_OFF, g, S, E, F.wave);
}
namespace attn_body {
using bf16=unsigned short;
using bf16x8=__attribute__((ext_vector_type(8)))short;
using s16x4=__attribute__((ext_vector_type(4)))short;
using f32x16=__attribute__((ext_vector_type(16)))float;
using u32x4=__attribute__((ext_vector_type(4)))unsigned;
constexpr int SEQ=2048,D=64;
constexpr int NW=8,QBLK=32,QB=QBLK*NW,KVBLK=64,NQB=SEQ/QB;
constexpr int ATTN_UNIT_ROWS=QB;
__device__ __forceinline__ constexpr int cr0(int r){return (r&3)+8*(r>>2);}
__device__ __forceinline__ int crow(int r,int hi){return (r&3)+8*(r>>2)+4*hi;}
#define SBAR() __builtin_amdgcn_sched_barrier(0)
__device__ __forceinline__ void cmask(f32x16&p0,f32x16&p1,int jb,int qrel,int hi){
  const float NEG=-INFINITY; int kb=64*jb+4*hi;
  #pragma unroll
  for(int r=0;r<16;++r){int kv=kb+(r&3)+8*(r>>2); if(kv>qrel)p0[r]=NEG; if(kv+32>qrel)p1[r]=NEG;}
}

__device__ __forceinline__ void bmask(f32x16&p0,f32x16&p1,unsigned w0,unsigned w1,int hi){
  const unsigned m0=w0>>(4*hi), m1=w1>>(4*hi);
  #pragma unroll
  for(int r=0;r<16;++r){
    const unsigned t0=(unsigned)__builtin_amdgcn_sbfe((int)m0,cr0(r),1), t1=(unsigned)__builtin_amdgcn_sbfe((int)m1,cr0(r),1);
    p0[r]=__uint_as_float((__float_as_uint(p0[r])&t0)|(0xff800000u&~t0)); p1[r]=__uint_as_float((__float_as_uint(p1[r])&t1)|(0xff800000u&~t1)); }
}
constexpr int NSLOT=3, SLOTB=8192;
constexpr int MWAVE=8192;
constexpr int LDS_K=0, LDS_V=NSLOT*SLOTB, LDS_WS=2*NSLOT*SLOTB, LDS_OST=LDS_WS+NW*64*4, LDS_BYTES=LDS_OST+NW*MWAVE;
constexpr float C2=0.125f*1.4426950408889634f;
__device__ __forceinline__ void glds16(const void*gsrc,unsigned lds_dst){unsigned keep;
  asm volatile("s_mov_b32 %0, m0\n\ts_mov_b32 m0, %2\n\ts_nop 0\n\tglobal_load_lds_dwordx4 %1, off\n\ts_mov_b32 m0, %0":"=&s"(keep):"v"(gsrc),"s"(lds_dst):"memory");}
__device__ __forceinline__ float max3f(float a,float b,float c){float r;asm("v_max3_f32 %0, %1, %2, %3":"=v"(r):"v"(a),"v"(b),"v"(c));return r;}
__device__ __forceinline__ float max2f(float a,float b){float r;asm("v_max_f32_e32 %0, %1, %2":"=v"(r):"v"(a),"v"(b));return r;}
__device__ __forceinline__ float fadd_s(float a,float b){float r;asm("v_add_f32_e32 %0, %1, %2":"=v"(r):"v"(a),"v"(b));return r;}
__device__ __forceinline__ float fsub_s(float a,float b){float r;asm("v_sub_f32_e32 %0, %1, %2":"=v"(r):"v"(a),"v"(b));return r;}
typedef float f32x2_t __attribute__((ext_vector_type(2))); typedef __bf16 bf16x2_t __attribute__((ext_vector_type(2)));
__device__ __forceinline__ unsigned cvtpk_s(float lo,float hi){f32x2_t v={lo,hi};bf16x2_t b=__builtin_convertvector(v,bf16x2_t);return __builtin_bit_cast(unsigned,b);}
#define WAIT_BAR(N) asm volatile("s_waitcnt vmcnt(" #N ") lgkmcnt(0)\n\ts_barrier":::"memory")

__device__ __forceinline__ void qkt(f32x16&p0,f32x16&p1,const char*Kslot,const bf16x8*qr,const f32x16&negm,int r32,int hi){
  const char*kb=Kslot+hi*1024+r32*16;
  #pragma unroll
  for(int d0=0;d0<4;++d0){
    const bf16x8 b0=*reinterpret_cast<const bf16x8*>(kb+d0*2048);
    const bf16x8 b1=*reinterpret_cast<const bf16x8*>(kb+d0*2048+512);
    if(d0==0){p0=__builtin_amdgcn_mfma_f32_32x32x16_bf16(b0,qr[0],negm,0,0,0);p1=__builtin_amdgcn_mfma_f32_32x32x16_bf16(b1,qr[0],negm,0,0,0);}
    else{p0=__builtin_amdgcn_mfma_f32_32x32x16_bf16(b0,qr[d0],p0,0,0,0);p1=__builtin_amdgcn_mfma_f32_32x32x16_bf16(b1,qr[d0],p1,0,0,0);}}
}
typedef __attribute__((address_space(3))) const char* lds_cptr;
typedef short v4i16_t __attribute__((ext_vector_type(4)));
__device__ __forceinline__ void kload8(bf16x8*kf,lds_cptr kp){
  kf[0]=*(const __attribute__((address_space(3))) bf16x8*)(kp);      kf[1]=*(const __attribute__((address_space(3))) bf16x8*)(kp+512);
  kf[2]=*(const __attribute__((address_space(3))) bf16x8*)(kp+2048); kf[3]=*(const __attribute__((address_space(3))) bf16x8*)(kp+2560);
  kf[4]=*(const __attribute__((address_space(3))) bf16x8*)(kp+4096); kf[5]=*(const __attribute__((address_space(3))) bf16x8*)(kp+4608);
  kf[6]=*(const __attribute__((address_space(3))) bf16x8*)(kp+6144); kf[7]=*(const __attribute__((address_space(3))) bf16x8*)(kp+6656);
}
__device__ __forceinline__ void kload2(bf16x8*kf,lds_cptr kp,int j){ kf[2*j]=*(const __attribute__((address_space(3))) bf16x8*)(kp+j*2048); kf[2*j+1]=*(const __attribute__((address_space(3))) bf16x8*)(kp+j*2048+512); }
__device__ __forceinline__ s16x4 vtr(lds_cptr p){ return __builtin_bit_cast(s16x4,__builtin_amdgcn_ds_read_tr16_b64_v4i16((__attribute__((address_space(3))) v4i16_t*)p)); }
__device__ __forceinline__ float rowmax(const f32x16&p0,const f32x16&p1){
  float a=max3f(p0[0],p0[1],p1[0]),b=max3f(p0[2],p0[3],p1[1]);a=max3f(a,p1[2],p1[3]);
  #pragma unroll
  for(int r=4;r<16;r+=4){a=max3f(a,p0[r],p0[r+1]);b=max3f(b,p0[r+2],p0[r+3]);a=max3f(a,p1[r],p1[r+1]);b=max3f(b,p1[r+2],p1[r+3]);}
  const float m=max2f(a,b);
  auto rr=__builtin_amdgcn_permlane32_swap(__float_as_uint(m),__float_as_uint(m),false,false);
  return max2f(__uint_as_float(rr[0]),__uint_as_float(rr[1]));
}
__device__ __forceinline__ void pv(f32x16*o,int vb,bf16x8 pa0,bf16x8 pa1,bf16x8 pa2,bf16x8 pa3){
  #pragma unroll
  for(int d0=0;d0<2;++d0){s16x4 lo[4],hi[4];
    #pragma unroll
    for(int ks=0;ks<4;++ks){
      asm volatile("ds_read_b64_tr_b16 %0,%1 offset:%c2":"=&v"(lo[ks]):"v"(vb),"i"(d0*4096+ks*1024):"memory");
      asm volatile("ds_read_b64_tr_b16 %0,%1 offset:%c2":"=&v"(hi[ks]):"v"(vb),"i"(d0*4096+ks*1024+512):"memory");}
    asm volatile("s_waitcnt lgkmcnt(0)":::"memory");SBAR();
    #define PK(k) (bf16x8){lo[k][0],lo[k][1],lo[k][2],lo[k][3],hi[k][0],hi[k][1],hi[k][2],hi[k][3]}
    o[d0]=__builtin_amdgcn_mfma_f32_32x32x16_bf16(pa0,PK(0),o[d0],0,0,0);
    o[d0]=__builtin_amdgcn_mfma_f32_32x32x16_bf16(pa1,PK(1),o[d0],0,0,0);
    o[d0]=__builtin_amdgcn_mfma_f32_32x32x16_bf16(pa2,PK(2),o[d0],0,0,0);
    o[d0]=__builtin_amdgcn_mfma_f32_32x32x16_bf16(pa3,PK(3),o[d0],0,0,0);
    #undef PK
  }
}

#ifndef ATTN_STORE16
#define ATTN_STORE16(p,v) st16_wt((p),(v))
#endif
template<int THRL,bool MASKED> __device__ __forceinline__ void attn_unit(int qb,const bf16*Qb,int QP,const bf16*__restrict__ Kh,int KP,const bf16*__restrict__ Vh,int VP,bf16*Ob,int OP,const unsigned*mwave,char*shm,const int wave_,const int emode=0,const int bsel=0,const float lam=0.f){
  int tidv; asm volatile("v_mbcnt_lo_u32_b32 %0, -1, 0\n\tv_mbcnt_hi_u32_b32 %0, -1, %0":"=v"(tidv)); tidv+=wave_*64;
  const int tid=tidv,lane=tid&63,r32=lane&31,hi=lane>>5; const int wid=__builtin_amdgcn_readfirstlane(tid>>6);
  const int q0=qb*QB;
  const bf16*Qw=Qb+(long)(wid*QBLK)*QP;
  const unsigned lds0=(unsigned)(uintptr_t)shm;
  float*wsf=(float*)(shm+LDS_WS)+wid*64;
  const bf16*ksrc=Kh+(long)lane*KP+wid*8;
  const bf16*vsrc=Vh+(long)(16*(wid&3)+(lane>>2))*VP+(wid>>2)*32+(lane&3)*8;
  const unsigned kdst=lds0+LDS_K+wid*1024, vdst=lds0+LDS_V+wid*1024;
  #define DMA_K(t,slot) glds16(ksrc+(long)(t)*KVBLK*KP,(unsigned)__builtin_amdgcn_readfirstlane(kdst+(slot)))
  #define DMA_V(t,slot) glds16(vsrc+(long)(t)*KVBLK*VP,(unsigned)__builtin_amdgcn_readfirstlane(vdst+(slot)))
  const int vb0=(int)(lds0+LDS_V)+((lane>>4)&1)*32+(lane&3)*8+(4*hi+((lane&15)>>2))*64;
  const char*Kbase=shm+LDS_K; bf16x8 kf[8];
  const lds_cptr shm3=(lds_cptr)shm; const lds_cptr kp0=shm3+LDS_K+hi*1024+r32*16; const lds_cptr vp0=shm3+LDS_V+((lane>>4)&1)*32+(lane&3)*8+(4*hi+((lane&15)>>2))*64;
  const int NT=(q0+QB)/KVBLK;
  const __attribute__((address_space(3))) unsigned* mimg=(const __attribute__((address_space(3))) unsigned*)(shm3+LDS_OST+wid*MWAVE)+r32;
  DMA_K(0,0);DMA_V(0,0);DMA_K(1,SLOTB);
  if constexpr(MASKED){
    __attribute__((address_space(3))) u32x4* mdst=(__attribute__((address_space(3))) u32x4*)(shm3+LDS_OST+wid*MWAVE)+lane;
    for(int i=0;i<=qb;++i){ const u32x4 v=((const u32x4*)mwave)[i*64+lane]; mdst[i*64]=v; }
  }
  bf16x8 qr[4];
  #pragma unroll
  for(int d0=0;d0<4;++d0)qr[d0]=*reinterpret_cast<const bf16x8*>(&Qw[(long)r32*QP+d0*16+hi*8]);
  float mhat=0.f,l_reg=0.f;f32x16 o[2];o[0]=f32x16{};o[1]=f32x16{};f32x16 negm=f32x16{};asm volatile("":"+v"(negm));
  const int qrel=wid*QBLK+r32;
  #define CMASK(P0,P1,t) do{int jb_=(t)-(NT-4); if(jb_>=0)cmask(P0,P1,jb_,qrel,hi);}while(0)
  #define XMASK(P0,P1,t) do{ if constexpr(MASKED){ bmask(P0,P1,mimg[(2*(t))*32],mimg[(2*(t)+1)*32],hi); } else { CMASK(P0,P1,t); } }while(0)
  bool resc=false;
  #define START(P0,P1) do{ const float rm=rowmax(P0,P1); resc=false; \
    { const float dl=MASKED?__builtin_fmaxf(rm,-30.f):rm; mhat=fadd_s(mhat,dl); \
      _Pragma("unroll") for(int r=0;r<16;++r){P0[r]=fsub_s(P0[r],dl);P1[r]=fsub_s(P1[r],dl);} \
      _Pragma("unroll") for(int r=0;r<16;++r)negm[r]=-mhat; asm volatile("":"+v"(negm)); } \
    _Pragma("unroll") for(int r=0;r<16;++r)P0[r]=__builtin_amdgcn_exp2f(P0[r]); }while(0)
  #define RESC() do{ if(resc){ asm volatile("s_waitcnt lgkmcnt(0)":::"memory"); \
      _Pragma("unroll") for(int d_=0;d_<2;++d_) _Pragma("unroll") for(int r=0;r<16;++r)o[d_][r]*=wsf[crow(r,hi)]; } }while(0)
  f32x16 pA0,pA1,pB0,pB1;
  int sl_prev=0,sl_cur=0,sl_next=SLOTB;
  #define ROT() do{sl_prev=sl_cur;sl_cur=sl_next;sl_next=(sl_next==(NSLOT-1)*SLOTB)?0:sl_next+SLOTB;}while(0)
  DMA_K(2,2*SLOTB);
  WAIT_BAR(3);
  qkt(pA0,pA1,Kbase,qr,negm,r32,hi);asm volatile("s_nop 15\n\ts_nop 7":"+v"(pA0),"+v"(pA1));XMASK(pA0,pA1,0);
  START(pA0,pA1);
  _Pragma("unroll") for(int r=0;r<16;++r)pA1[r]=__builtin_amdgcn_exp2f(pA1[r]);
  WAIT_BAR(0);
  DMA_K(3,0);DMA_V(1,SLOTB);
  ROT();
  kload8(kf,kp0+sl_cur);
  WAIT_BAR(2);
  s16x4 vlo[8],vhi[8]; u32x4 pw0,pw1,pw2,pw3;
  #define PKW(P,B) cvtpk_s(P[B],P[B+1])
  #define PAF(k) __builtin_bit_cast(bf16x8,pw##k)
  #define VFR(i) (bf16x8){vlo[i][0],vlo[i][1],vlo[i][2],vlo[i][3],vhi[i][0],vhi[i][1],vhi[i][2],vhi[i][3]}
  #define PIN(x) asm volatile("":"+v"(x))
  #define MX3(a,b,c) __builtin_fmaxf(__builtin_fmaxf((a),(b)),(c))
  #define GAPA(MF,A0,A1,A2,A3,W0,W1,PW) do{ MF; sacc+=A0; sacc+=A1; sacc+=A2; sacc+=A3; PIN(sacc); W0; W1; PIN(PW); SBAR(); }while(0)
  #define EX(v) __builtin_amdgcn_exp2f(v)
  #define GAPB(MF,X,B) do{ MF; X[B]=EX(X[B]); X[B+1]=EX(X[B+1]); X[B+2]=EX(X[B+2]); X[B+3]=EX(X[B+3]); PIN(X); SBAR(); }while(0)
  #define VRD(i) do{ vlo[i]=vtr(vp_+(((i)>>2)*4096+((i)&3)*1024)); vhi[i]=vtr(vp_+(((i)>>2)*4096+((i)&3)*1024+512)); }while(0)
  #define KRD(G,j) do{ if(G){ kload2(kf,kp0+sl_next,j); SBAR(); } }while(0)
  #define STEP(C0,C1,P0,P1,t,GK,GV,GL) do{ SBAR(); \
    const lds_cptr vp_=vp0+sl_prev; \
    VRD(0); SBAR(); float sacc=(P0[0]+P0[1]); \
    GAPA(C0=__builtin_amdgcn_mfma_f32_32x32x16_bf16(kf[0],qr[0],negm,0,0,0), P0[2],P0[3],P0[4],P0[5],     pw0[0]=PKW(P0,0), pw0[1]=PKW(P0,2), pw0); \
    VRD(4); SBAR(); GAPA(C1=__builtin_amdgcn_mfma_f32_32x32x16_bf16(kf[1],qr[0],negm,0,0,0), P0[6],P0[7],P0[8],P0[9],     pw0[2]=PKW(P0,4), pw0[3]=PKW(P0,6), pw0); \
    VRD(1); SBAR(); GAPA(C0=__builtin_amdgcn_mfma_f32_32x32x16_bf16(kf[2],qr[1],C0,0,0,0),   P0[10],P0[11],P0[12],P0[13], pw1[0]=PKW(P0,8), pw1[1]=PKW(P0,10), pw1); \
    VRD(5); SBAR(); GAPA(C1=__builtin_amdgcn_mfma_f32_32x32x16_bf16(kf[3],qr[1],C1,0,0,0),   P0[14],P0[15],P1[0],P1[1],   pw1[2]=PKW(P0,12),pw1[3]=PKW(P0,14), pw1); \
    VRD(2); SBAR(); GAPA(C0=__builtin_amdgcn_mfma_f32_32x32x16_bf16(kf[4],qr[2],C0,0,0,0),   P1[2],P1[3],P1[4],P1[5],     pw2[0]=PKW(P1,0), pw2[1]=PKW(P1,2), pw2); \
    VRD(6); SBAR(); GAPA(C1=__builtin_amdgcn_mfma_f32_32x32x16_bf16(kf[5],qr[2],C1,0,0,0),   P1[6],P1[7],P1[8],P1[9],     pw2[2]=PKW(P1,4), pw2[3]=PKW(P1,6), pw2); \
    VRD(3); SBAR(); GAPA(C0=__builtin_amdgcn_mfma_f32_32x32x16_bf16(kf[6],qr[3],C0,0,0,0),   P1[10],P1[11],P1[12],P1[13], pw3[0]=PKW(P1,8), pw3[1]=PKW(P1,10), pw3); \
    VRD(7); SBAR(); GAPA(C1=__builtin_amdgcn_mfma_f32_32x32x16_bf16(kf[7],qr[3],C1,0,0,0),   P1[14],P1[15],0.f,0.f,       pw3[2]=PKW(P1,12),pw3[3]=PKW(P1,14), pw3); \
    l_reg+=sacc; \
    if(GK){DMA_K((t)+3,sl_cur);} if(GV){DMA_V((t)+1,sl_next);} \
    XMASK(C0,C1,t); \
    { float a=MX3(C0[0],C0[1],C1[0]),b=MX3(C0[2],C0[3],C1[1]); a=MX3(a,C1[2],C1[3]); \
      _Pragma("unroll") for(int r=4;r<16;r+=4){a=MX3(a,C0[r],C0[r+1]);b=MX3(b,C0[r+2],C0[r+3]);a=MX3(a,C1[r],C1[r+1]);b=MX3(b,C1[r+2],C1[r+3]);} \
      float rm=__builtin_fmaxf(a,b); { auto rr=__builtin_amdgcn_permlane32_swap(__float_as_uint(rm),__float_as_uint(rm),false,false); rm=__builtin_fmaxf(__uint_as_float(rr[0]),__uint_as_float(rr[1])); } \
      resc=false; \
      if(__builtin_expect(__any(rm>(float)THRL),0)){ const float dl=__builtin_fmaxf(rm,0.f); mhat+=dl; \
        _Pragma("unroll") for(int r=0;r<16;++r){C0[r]-=dl;C1[r]-=dl;} \
        _Pragma("unroll") for(int r=0;r<16;++r)negm[r]=-mhat; asm volatile("":"+v"(negm)); \
        const float f=__builtin_amdgcn_exp2f(-dl); l_reg*=f; if(hi==0)wsf[r32]=f; resc=true; } } \
    SBAR(); \
    GAPB(o[0]=__builtin_amdgcn_mfma_f32_32x32x16_bf16(PAF(0),VFR(0),o[0],0,0,0), C0,0); \
    GAPB(o[1]=__builtin_amdgcn_mfma_f32_32x32x16_bf16(PAF(0),VFR(4),o[1],0,0,0), C0,4); \
    KRD(GL,0); GAPB(o[0]=__builtin_amdgcn_mfma_f32_32x32x16_bf16(PAF(1),VFR(1),o[0],0,0,0), C0,8); \
    KRD(GL,1); GAPB(o[1]=__builtin_amdgcn_mfma_f32_32x32x16_bf16(PAF(1),VFR(5),o[1],0,0,0), C0,12); \
    KRD(GL,2); GAPB(o[0]=__builtin_amdgcn_mfma_f32_32x32x16_bf16(PAF(2),VFR(2),o[0],0,0,0), C1,0); \
    KRD(GL,3); GAPB(o[1]=__builtin_amdgcn_mfma_f32_32x32x16_bf16(PAF(2),VFR(6),o[1],0,0,0), C1,4); \
    GAPB(o[0]=__builtin_amdgcn_mfma_f32_32x32x16_bf16(PAF(3),VFR(3),o[0],0,0,0), C1,8); \
    GAPB(o[1]=__builtin_amdgcn_mfma_f32_32x32x16_bf16(PAF(3),VFR(7),o[1],0,0,0), C1,12); \
    }while(0)
  int t=1;
  #undef CMASK
  #define CMASK(P0,P1,t) do{}while(0)
  for(;t+5<NT;t+=2){
    STEP(pB0,pB1,pA0,pA1,t,true,true,true);     WAIT_BAR(2); RESC(); ROT();
    STEP(pA0,pA1,pB0,pB1,t+1,true,true,true);   WAIT_BAR(2); RESC(); ROT();
  }
  #undef CMASK
  #define CMASK(P0,P1,t) do{int jb_=(t)-(NT-4); if(jb_>=0)cmask(P0,P1,jb_,qrel,hi);}while(0)
  #define ENDW(tt) do{ if((tt)+3<NT){WAIT_BAR(2);} else if((tt)+2<NT){WAIT_BAR(1);} else {WAIT_BAR(0);} }while(0)
  for(;t+1<NT;t+=2){
    STEP(pB0,pB1,pA0,pA1,t,(t+3<NT),(t+1<NT),(t+1<NT));       ENDW(t);   RESC(); ROT();
    STEP(pA0,pA1,pB0,pB1,t+1,(t+4<NT),(t+2<NT),(t+2<NT));     ENDW(t+1); RESC(); ROT();
  }
  STEP(pB0,pB1,pA0,pA1,NT-1,false,false,false); RESC();
  { float sacc=pB0[0]+pB0[1]; _Pragma("unroll") for(int r=2;r<16;++r)sacc+=pB0[r]; _Pragma("unroll") for(int r=0;r<16;++r)sacc+=pB1[r]; l_reg+=sacc;
    pw0=(u32x4){PKW(pB0,0),PKW(pB0,2),PKW(pB0,4),PKW(pB0,6)};pw1=(u32x4){PKW(pB0,8),PKW(pB0,10),PKW(pB0,12),PKW(pB0,14)};pw2=(u32x4){PKW(pB1,0),PKW(pB1,2),PKW(pB1,4),PKW(pB1,6)};pw3=(u32x4){PKW(pB1,8),PKW(pB1,10),PKW(pB1,12),PKW(pB1,14)};
    SBAR(); pv(o,vb0+sl_cur,PAF(0),PAF(1),PAF(2),PAF(3)); }
  #undef PKW
  #undef PAF
  #undef VFR
  #undef PIN
  #undef MX3
  #undef GAPA
  #undef GAPB
  #undef EX
  #undef VRD
  #undef KRD
  #undef STEP
  #undef ENDW
  {auto rr=__builtin_amdgcn_permlane32_swap(__float_as_uint(l_reg),__float_as_uint(l_reg),false,false);l_reg=__uint_as_float(rr[0])+__uint_as_float(rr[1]);}
  if(hi==0)wsf[32+r32]=l_reg;asm volatile("s_waitcnt lgkmcnt(0)":::"memory");
  float rli[16];
  #pragma unroll
  for(int r=0;r<16;++r)rli[r]=__builtin_amdgcn_rcpf(wsf[32+crow(r,hi)]);
  bf16*Ow=Ob+(long)(wid*QBLK)*OP;
  { bf16*stg=(bf16*)(shm+LDS_OST+wid*MWAVE);
    bf16*stl=stg+bsel*2048+hi*256+r32;
    if(emode>=2){
      #pragma unroll
      for(int r=0;r<16;++r){
        #pragma unroll
        for(int d0=0;d0<2;++d0){ const float old=__uint_as_float((unsigned)stl[cr0(r)*64+d0*32]<<16); stl[cr0(r)*64+d0*32]=(bf16)(cvtpk_s(old-lam*(o[d0][r]*rli[r]),0.f)&0xffffu);} }
    } else {
      #pragma unroll
      for(int r=0;r<16;++r){
        #pragma unroll
        for(int d0=0;d0<2;++d0)stl[cr0(r)*64+d0*32]=(bf16)(cvtpk_s(o[d0][r]*rli[r],0.f)&0xffffu);}
    }
    asm volatile("s_waitcnt lgkmcnt(0)":::"memory");
    if(emode==0){
      #pragma unroll
      for(int i=0;i<4;++i){const int row=i*8+(lane>>3),ch=lane&7; const u32x4 v=*(const u32x4*)(stg+row*64+ch*8); ATTN_STORE16(Ow+(long)row*OP+ch*8,v);}
    } else if(emode==3){
      #pragma unroll
      for(int i=0;i<4;++i){const int row=i*8+(lane>>3),ch=lane&7;
        const u32x4 v0=*(const u32x4*)(stg+row*64+ch*8), v1=*(const u32x4*)(stg+2048+row*64+ch*8);
        float f[16]; float ss=0.f;
        #pragma unroll
        for(int j=0;j<4;++j){ f[2*j]=__uint_as_float(v0[j]<<16); f[2*j+1]=__uint_as_float(v0[j]&0xffff0000u); f[8+2*j]=__uint_as_float(v1[j]<<16); f[8+2*j+1]=__uint_as_float(v1[j]&0xffff0000u); }
        #pragma unroll
        for(int j=0;j<16;++j)ss+=f[j]*f[j];
        ss+=__shfl_xor(ss,1); ss+=__shfl_xor(ss,2); ss+=__shfl_xor(ss,4);
        const float rn=__builtin_amdgcn_rsqf(ss*(1.f/128.f)+1e-6f)*0.8f;
        u32x4 w0,w1;
        #pragma unroll
        for(int j=0;j<4;++j){ w0[j]=cvtpk_s(f[2*j]*rn,f[2*j+1]*rn); w1[j]=cvtpk_s(f[8+2*j]*rn,f[8+2*j+1]*rn); }
        ATTN_STORE16(Ow+(long)row*OP+ch*8,w0); ATTN_STORE16(Ow+(long)row*OP+64+ch*8,w1);}
    }
  }
  asm volatile("s_waitcnt lgkmcnt(0)\n\ts_barrier":::"memory");
  #undef DMA_K
  #undef DMA_V
  #undef CMASK
  #undef XMASK
  #undef START
  #undef RESC
  #undef ROT
}
constexpr int ATTN_LDS_BYTES=LDS_BYTES;
#undef SBAR
#undef WAIT_BAR
}
namespace idx {
typedef short bf16x8 __attribute__((ext_vector_type(8)));
typedef float f32x16 __attribute__((ext_vector_type(16)));
constexpr int QROW = 528, IMG_LO = 32 * QROW, TROW = 1025, KBUF_OFF = 36864;
constexpr int CW_QUEUE = 64;
constexpr unsigned T0 = 0x80000000u;
__device__ __forceinline__ constexpr int cr0(int r) { return (r & 3) + 8 * (r >> 2); }
__device__ __forceinline__ unsigned fkey(float f) { const unsigned u = __float_as_uint(f); return (u & 0x80000000u) ? ~u : (u | 0x80000000u); }
__device__ __forceinline__ float kval(unsigned k) { return __uint_as_float((k & 0x80000000u) ? (k & 0x7fffffffu) : ~k); }
__device__ __forceinline__ unsigned dpp_shr(unsigned v, int n) {
    const int iv = (int)v; int r;
    switch (n) { case 1: r = __builtin_amdgcn_update_dpp(0, iv, 0x111, 0xf, 0xf, true); break; case 2: r = __builtin_amdgcn_update_dpp(0, iv, 0x112, 0xf, 0xf, true); break;
                 case 4: r = __builtin_amdgcn_update_dpp(0, iv, 0x114, 0xf, 0xf, true); break; default: r = __builtin_amdgcn_update_dpp(0, iv, 0x118, 0xf, 0xf, true); break; }
    return (unsigned)r;
}
__device__ __forceinline__ unsigned wsum(unsigned v) {
    v += dpp_shr(v, 1); v += dpp_shr(v, 2); v += dpp_shr(v, 4); v += dpp_shr(v, 8);
    v += (unsigned)__builtin_amdgcn_update_dpp(0, (int)v, 0x142, 0xa, 0xf, false);
    v += (unsigned)__builtin_amdgcn_update_dpp(0, (int)v, 0x143, 0xc, 0xf, false);
    return (unsigned)__builtin_amdgcn_readlane((int)v, 63);
}
__device__ __forceinline__ unsigned umax2(unsigned a, unsigned b) { return a > b ? a : b; }
__device__ __forceinline__ unsigned wmaxu(unsigned v) {
    v = umax2(v, dpp_shr(v, 1)); v = umax2(v, dpp_shr(v, 2)); v = umax2(v, dpp_shr(v, 4)); v = umax2(v, dpp_shr(v, 8));
    v = umax2(v, (unsigned)__builtin_amdgcn_update_dpp(0, (int)v, 0x142, 0xa, 0xf, false));
    v = umax2(v, (unsigned)__builtin_amdgcn_update_dpp(0, (int)v, 0x143, 0xc, 0xf, false));
    return (unsigned)__builtin_amdgcn_readlane((int)v, 63);
}
__device__ __forceinline__ unsigned wminu(unsigned v) { return ~wmaxu(~v); }
#define IDX_COUNT_GE(K, T, NR, OUT) do { unsigned w_ = 0xffffffffu; _Pragma("unroll") for (int i_ = 0; i_ < 32; ++i_) if (i_ < (NR)) w_ = __builtin_amdgcn_alignbit(w_, (K)[i_] - (T), 31); (OUT) = 32u - (unsigned)__builtin_popcount(w_); } while (0)

__device__ __forceinline__ void run(Frame& F, int qword) {
    const int wid = F.wave;
    LAS unsigned char* lds = F.lds;
    unsigned* qctr = (unsigned*)(F.ws + WS_CTL) + qword;
    volatile LAS unsigned* uw = (volatile LAS unsigned*)(F.lds + MISC_OFF) + 20;
    const bf16* QIH = WSP(bf16, WS_QIH); const bf16* KIH = WSP(bf16, WS_KIH);
    const float* WI = WSP(float, WS_WI); unsigned* MASK = WSP(unsigned, WS_MASK);
    LAS unsigned* TR = (LAS unsigned*)lds;
    for (;;) {
        __syncthreads();
        if (wid == 0 && lane_now() == 0) *uw = __hip_atomic_fetch_add(qctr, 1u, __ATOMIC_RELAXED, __HIP_MEMORY_SCOPE_AGENT);
        __syncthreads();
        const unsigned un = __builtin_amdgcn_readfirstlane(*uw);
        if (un >= 1024u) break;
        int b, qg;
        if (un < 896u) { qg = 63 - (int)(un >> 4); b = (int)(un & 15u); } else { qg = (int)((un - 896u) >> 4); b = (int)(un & 15u); }
        int lane = lane_now(); asm volatile("" : "+v"(lane));
        const int r32 = lane & 31, hi = lane >> 5;
        const int tid = wid * 64 + lane;
        int widv = wid; asm volatile("" : "+s"(widv));
        const int unit = b * 64 + qg;
        const size_t tok0 = (size_t)b * SEQ + 32 * qg;
        unsigned* mrow = MASK + (size_t)unit * 2048;
        const int ktmax = qg | 7;
        if (qg < 8) {
#pragma unroll
            for (int i = 0; i < 8; ++i) { const int kt = widv + 8 * i; if (kt <= ktmax && hi == 0) mrow[kt * 32 + r32] = kt < qg ? 0xffffffffu : (kt == qg ? ((2u << r32) - 1u) : 0u); }
            continue;
        }
#pragma unroll
        for (int it = 0; it < 2; ++it) { const int rem = tid + 512 * it, row = rem >> 5, ch = rem & 31;
            const v4u v = *(const v4u*)(QIH + (tok0 + row) * 256 + ch * 8);
            *(LAS v4u*)(lds + row * QROW + ch * 16) = v; }
        const f32x4 w4 = *(const f32x4*)(WI + (tok0 + r32) * 4);
        __syncthreads();
        unsigned sc[8][16];
        const bf16* kbh = KIH + ((size_t)b * SEQ + r32) * 64 + hi * 8;
        const LAS unsigned char* kbuf = lds + KBUF_OFF + wid * 8192 + lane * 16;
        const unsigned kdst = (unsigned)(uintptr_t)(lds + KBUF_OFF + wid * 8192);
#define IDX_DMA_K(zo) do { _Pragma("unroll") for (int d0_ = 0; d0_ < 4; ++d0_) attn_body::glds16(kbh + (zo) + d0_ * 16, (unsigned)__builtin_amdgcn_readfirstlane(kdst + d0_ * 1024)); } while (0)
        if (widv <= qg) { int zoff = widv * 2048; asm volatile("" : "+v"(zoff)); IDX_DMA_K(zoff); }
        const int cl = r32 - 4 * hi;
        const LAS unsigned char* qimg = lds + r32 * QROW + hi * 16;
#pragma unroll
        for (int i = 0; i < 8; ++i) {
            const int kt = widv + 8 * i;
            if (kt <= qg) {
                bf16x8 kh[4];
                asm volatile("s_waitcnt vmcnt(0)" ::: "memory");
#pragma unroll
                for (int d0 = 0; d0 < 4; ++d0) kh[d0] = *(const LAS bf16x8*)(kbuf + d0 * 1024);
                asm volatile("s_waitcnt lgkmcnt(0)" ::: "memory");
                if (kt + 8 <= qg) { int zoff = (kt + 8) * 2048; asm volatile("" : "+v"(zoff)); IDX_DMA_K(zoff); }
                float s[16];
#pragma unroll
                for (int h = 0; h < 4; ++h) {
                    f32x16 acc = {};
#pragma unroll
                    for (int d0 = 0; d0 < 4; ++d0) {
                        const bf16x8 qh = *(const LAS bf16x8*)(qimg + (h * 64 + d0 * 16) * 2);
                        acc = __builtin_amdgcn_mfma_f32_32x32x16_bf16(kh[d0], qh, acc, 0, 0, 0);
                    }
                    const float wh = w4[h];
#pragma unroll
                    for (int r = 0; r < 16; ++r) { const float t = wh * (acc[r] > 0.f ? acc[r] : 0.f); s[r] = (h == 0) ? t : s[r] + t; }
                    if (h == 1) { asm volatile("" ::: "memory"); __builtin_amdgcn_sched_barrier(0); }
                }
#pragma unroll
                for (int r = 0; r < 16; ++r) { unsigned k = fkey(s[r]); if (kt == qg && cr0(r) > cl) k = 0u; sc[i][r] = k; }
                asm volatile("" ::: "memory"); __builtin_amdgcn_sched_barrier(0);
            } else {
#pragma unroll
                for (int r = 0; r < 16; ++r) sc[i][r] = 0u;
            }
        }
        unsigned kq[4][32];
        LAS unsigned* twr = TR + r32 * TROW + 4 * hi;
        const LAS unsigned* trd = TR + (4 * wid) * TROW + lane;
        __syncthreads();
#pragma unroll
        for (int i = 0; i < 4; ++i) { const int kt = widv + 8 * i; LAS unsigned* p = twr + kt * 32;
#pragma unroll
            for (int r = 0; r < 16; ++r) p[cr0(r)] = sc[i][r]; }
        __syncthreads();
#pragma unroll
        for (int j = 0; j < 4; ++j)
#pragma unroll
            for (int i = 0; i < 16; ++i) kq[j][i] = trd[j * TROW + 64 * i];
        const bool upper = qg >= 32;
        if (upper) {
            __syncthreads();
#pragma unroll
            for (int i = 4; i < 8; ++i) { const int kt = widv + 8 * (i - 4); LAS unsigned* p = twr + kt * 32;
#pragma unroll
                for (int r = 0; r < 16; ++r) p[cr0(r)] = sc[i][r]; }
            __syncthreads();
#pragma unroll
            for (int j = 0; j < 4; ++j)
#pragma unroll
                for (int i = 0; i < 16; ++i) kq[j][16 + i] = trd[j * TROW + 64 * i];
        } else {
#pragma unroll
            for (int j = 0; j < 4; ++j)
#pragma unroll
                for (int i = 0; i < 16; ++i) kq[j][16 + i] = 0u;
        }
        const int nr = (((32 * qg + 31) / 64 + 1) + 7) & ~7;
        unsigned P[4], nt[4], qa[4], qb[4], qcb[4]; float fa[4], fb[4]; int side[4]; bool act[4];
        {
        {
            unsigned c0[4], c1[4];
#pragma unroll
            for (int j = 0; j < 4; ++j) {
                unsigned w0 = 0u, w1 = 0xffffffffu;
#pragma unroll
                for (int ib = 0; ib < 32; ib += 8) if (ib < nr) {
#pragma unroll
                    for (int i = ib; i < ib + 8; ++i) { w0 = __builtin_amdgcn_alignbit(w0, kq[j][i], 31); w1 = __builtin_amdgcn_alignbit(w1, umax2(kq[j][i], T0) - (T0 + 1u), 31); } }
                c0[j] = (unsigned)__builtin_popcount(w0); c1[j] = 32u - (unsigned)__builtin_popcount(w1);
            }
#pragma unroll
            for (int j = 0; j < 4; ++j) { c0[j] = wsum(c0[j]); c1[j] = wsum(c1[j]); }
#pragma unroll
            for (int j = 0; j < 4; ++j) {
                const int nk = 32 * qg + 4 * wid + j + 1;
                P[j] = 0u; nt[j] = 0u; act[j] = false; qa[j] = 0u; qb[j] = 0u; qcb[j] = 0u; fa[j] = 1.f; fb[j] = -1.f; side[j] = 0;
                if (c1[j] == 256u) { P[j] = T0; }
                else if (c0[j] == 256u) { P[j] = T0 - 1u; }
                else if (c0[j] > 256u && c1[j] < 256u) { P[j] = T0; nt[j] = 256u - c1[j]; }
                else if (c1[j] > 256u) { unsigned m = 0u;
#pragma unroll
                    for (int ib = 0; ib < 32; ib += 8) if (ib < nr) {
#pragma unroll
                        for (int i = ib; i < ib + 8; ++i) { kq[j][i] = umax2(kq[j][i], T0); m = umax2(m, kq[j][i]); } }
                    qa[j] = T0 + 1u; qb[j] = wmaxu(m) + 1u; qcb[j] = 0u; fa[j] = (float)(c1[j] - 256u); fb[j] = -256.f; act[j] = true; }
                else { unsigned m = 0u;
#pragma unroll
                    for (int ib = 0; ib < 32; ib += 8) if (ib < nr) {
#pragma unroll
                        for (int i = ib; i < ib + 8; ++i) { m = umax2(m, ~(kq[j][i] - 1u)); kq[j][i] = kq[j][i] < T0 ? kq[j][i] : T0; } }
                    qa[j] = ~wmaxu(m) + 1u; qb[j] = T0; qcb[j] = c0[j]; fa[j] = (float)((unsigned)nk - 256u); fb[j] = -(float)(256u - c0[j]); act[j] = true; }
            }
        }
        {
#define IDX_SEL4(x) (lane == 0 ? (x)[0] : lane == 1 ? (x)[1] : lane == 2 ? (x)[2] : (x)[3])
            bool actl = lane < 4 && IDX_SEL4(act);
            unsigned al = IDX_SEL4(qa), bl = IDX_SEL4(qb), cbl = IDX_SEL4(qcb), Pl = IDX_SEL4(P), ntl = IDX_SEL4(nt);
            float fal = IDX_SEL4(fa), fbl = IDX_SEL4(fb); int sidel = 0;
            for (int it = 0; it < 80; ++it) {
                if (!__any(actl)) break;
                if (actl && bl - al <= 1u) { Pl = al; ntl = 256u - cbl; actl = false; }
                unsigned tl = 0xffffffffu;
                if (actl) {
                    const float va = kval(al), vb = kval(bl - 1u);
                    unsigned tt = fkey(va + (vb - va) * (fal / (fal - fbl)));
                    if (it >= 40) tt = al + ((bl - al) >> 1);
                    tt = tt <= al ? al + 1u : tt; tt = tt >= bl ? bl - 1u : tt;
                    tl = tt;
                }
                const unsigned t0 = (unsigned)__builtin_amdgcn_readlane((int)tl, 0), t1 = (unsigned)__builtin_amdgcn_readlane((int)tl, 1), t2 = (unsigned)__builtin_amdgcn_readlane((int)tl, 2), t3 = (unsigned)__builtin_amdgcn_readlane((int)tl, 3);
                unsigned w0 = 0xffffffffu, w1 = w0, w2 = w0, w3 = w0;
#define IDX_STEP(i_) do { w0 = __builtin_amdgcn_alignbit(w0, kq[0][i_] - t0, 31); w1 = __builtin_amdgcn_alignbit(w1, kq[1][i_] - t1, 31); \
                          w2 = __builtin_amdgcn_alignbit(w2, kq[2][i_] - t2, 31); w3 = __builtin_amdgcn_alignbit(w3, kq[3][i_] - t3, 31); } while (0)
#pragma unroll
                for (int i = 0; i < 8; ++i) IDX_STEP(i);
                if (nr > 8) {
#pragma unroll
                    for (int i = 8; i < 16; ++i) IDX_STEP(i);
                    if (nr > 16) {
#pragma unroll
                        for (int i = 16; i < 24; ++i) IDX_STEP(i);
                        if (nr > 24) {
#pragma unroll
                            for (int i = 24; i < 32; ++i) IDX_STEP(i);
                        }
                    }
                }
#undef IDX_STEP
                unsigned c[4] = {32u - (unsigned)__builtin_popcount(w0), 32u - (unsigned)__builtin_popcount(w1), 32u - (unsigned)__builtin_popcount(w2), 32u - (unsigned)__builtin_popcount(w3)};
#pragma unroll
                for (int st = 1; st <= 8; st <<= 1) {
#pragma unroll
                    for (int j = 0; j < 4; ++j) c[j] += dpp_shr(c[j], st);
                }
#pragma unroll
                for (int j = 0; j < 4; ++j) c[j] += (unsigned)__builtin_amdgcn_update_dpp(0, (int)c[j], 0x142, 0xa, 0xf, false);
#pragma unroll
                for (int j = 0; j < 4; ++j) c[j] += (unsigned)__builtin_amdgcn_update_dpp(0, (int)c[j], 0x143, 0xc, 0xf, false);
#pragma unroll
                for (int j = 0; j < 4; ++j) c[j] = (unsigned)__builtin_amdgcn_readlane((int)c[j], 63);
                const unsigned cl = IDX_SEL4(c);
                if (actl) {
                    if (cl == 256u) { Pl = tl - 1u; actl = false; }
                    else if (cl > 256u) { al = tl; fal = (float)(cl - 256u); if (sidel == 1) fbl *= 0.5f; sidel = 1; }
                    else { bl = tl; cbl = cl; fbl = -(float)(256u - cl); if (sidel == -1) fal *= 0.5f; sidel = -1; }
                }
            }
#pragma unroll
            for (int j = 0; j < 4; ++j) { P[j] = (unsigned)__builtin_amdgcn_readlane((int)Pl, j); nt[j] = (unsigned)__builtin_amdgcn_readlane((int)ntl, j); }
#undef IDX_SEL4
        }
        asm volatile("" ::: "memory");
        }
#pragma unroll
        for (int j = 0; j < 4; ++j) {
            unsigned wv = 0u; unsigned rem = nt[j]; const unsigned Pj = P[j];
            const int ni = 4 * ((qg >> 3) + 1);
#define IDX_WL(i_, m_) do { const unsigned mlo = __builtin_amdgcn_readfirstlane((unsigned)(m_)), mhi = __builtin_amdgcn_readfirstlane((unsigned)((m_) >> 32)); \
                            asm volatile("s_nop 3\n\tv_writelane_b32 %0, %1, %3\n\tv_writelane_b32 %0, %2, %4" : "+v"(wv) : "s"(mlo), "s"(mhi), "n"(2 * (i_)), "n"(2 * (i_) + 1)); } while (0)
            if (nt[j] == 0u) {
#pragma unroll
                for (int ib = 0; ib < 32; ib += 4) if (ib < ni) {
#pragma unroll
                    for (int i = ib; i < ib + 4; ++i) { const unsigned long long m = __ballot(kq[j][i] > Pj); IDX_WL(i, m); } }
            } else {
#pragma unroll
                for (int ib = 0; ib < 32; ib += 4) if (ib < ni) {
#pragma unroll
                    for (int i = ib; i < ib + 4; ++i) {
                        unsigned long long m = __ballot(kq[j][i] > Pj);
                        const unsigned long long e = __ballot(kq[j][i] == Pj); const unsigned pre = __builtin_amdgcn_mbcnt_hi((unsigned)(e >> 32), __builtin_amdgcn_mbcnt_lo((unsigned)e, 0u));
                        m |= __ballot(kq[j][i] == Pj && pre < rem); const unsigned ne = (unsigned)__popcll(e); rem = rem > ne ? rem - ne : 0u;
                        IDX_WL(i, m); } }
            }
#undef IDX_WL
            if (lane <= ktmax) mrow[lane * 32 + 4 * wid + j] = wv;
        }
    }
}
#undef IDX_COUNT_GE
#undef IDX_DMA_K
}
constexpr size_t WS_OD = WS_A2 + 2048;
namespace p3 {
constexpr int CW_QUEUE = 128;
constexpr int NUNITS = 1024 + 512;
__device__ __forceinline__ void decode(unsigned un, bool& dsa, int& b, int& h, int& qb) {
    if (un < 384u) { dsa = false; qb = 7 - (int)(un >> 6); const unsigned r = un & 63u; b = (int)(r >> 2); h = (int)(r & 3u); return; }
    un -= 384u;
    if (un < 192u) { if (un < 64u) { dsa = false; qb = 1; b = (int)(un >> 2); h = (int)(un & 3u); } else { un -= 64u; dsa = true; qb = 7; b = (int)(un >> 3); h = (int)(un & 7u); } return; }
    un -= 192u;
    if (un < 384u) { dsa = true; qb = 6 - (int)(un >> 7); const unsigned r = un & 127u; b = (int)(r >> 3); h = (int)(r & 7u); return; }
    un -= 384u;
    if (un < 192u) { if (un < 64u) { dsa = false; qb = 0; b = (int)(un >> 2); h = (int)(un & 3u); } else { un -= 64u; dsa = true; qb = 3; b = (int)(un >> 3); h = (int)(un & 7u); } return; }
    un -= 192u;
    dsa = true; qb = 2 - (int)(un >> 7); const unsigned r = un & 127u; b = (int)(r >> 3); h = (int)(r & 7u);
}
__device__ __forceinline__ void run(Frame& F, int qword) {
    unsigned* qctr = (unsigned*)(F.ws + WS_CTL) + qword;
    volatile LAS unsigned* uw = (volatile LAS unsigned*)(F.lds + MISC_OFF) + 16;
    char* shm = (char*)F.lds;
    const bf16* QA = WSP(bf16, WS_QA); const bf16* KA = WSP(bf16, WS_KA); const bf16* VA = WSP(bf16, WS_VA);
    const bf16* QB = WSP(bf16, WS_QB); const bf16* KB = WSP(bf16, WS_KB); const bf16* VB = WSP(bf16, WS_VB);
    bf16* ATT = WSP(bf16, WS_ATT); const unsigned* MASK = WSP(unsigned, WS_MASK);
    const float lam = *WSP(float, WS_LAM);
    const unsigned nstat = (unsigned)F.G < (unsigned)NUNITS ? 1u : 0u;
    for (unsigned it = 0;; ++it) {
        unsigned un;
        if (it < nstat) un = blockIdx.x;
        else {
            __syncthreads();
            if ((F.wave * 64 + lane_now()) == 0) *uw = nstat * (unsigned)F.G + __hip_atomic_fetch_add(qctr, 1u, __ATOMIC_RELAXED, __HIP_MEMORY_SCOPE_AGENT);
            __syncthreads();
            un = __builtin_amdgcn_readfirstlane(*uw);
        }
        if (un >= (unsigned)NUNITS) break;
        bool dsa; int b, h, qb; decode(un, dsa, b, h, qb);
        const size_t r0 = (size_t)b * SEQ, rq = r0 + qb * 256;
        if (dsa) {
            attn_body::attn_unit<8, true>(qb, QA + rq * 512 + h * 64, 512, KA + r0 * 64, 64, VA + r0 * 64, 64, ATT + rq * 1024 + h * 64, 1024,
                                          MASK + (size_t)(b * 64 + qb * 8 + F.wave) * 2048, shm, F.wave);
        } else {
            for (int sp = 0; sp < 4; ++sp) {
                const int c = sp & 1, vh = sp >> 1;
                attn_body::attn_unit<8, false>(qb, QB + rq * 512 + (h * 2 + c) * 64, 512, KB + r0 * 512 + (h * 2 + c) * 64, 512, VB + r0 * 512 + h * 128 + vh * 64, 512,
                                               ATT + rq * 1024 + 512 + h * 128, 1024, nullptr, shm, F.wave, sp == 0 || sp == 2 ? 1 : (sp == 1 ? 2 : 3), vh, lam);
            }
        }
    }
}
}
namespace pg8 {
#define PG8_XBAR() do { asm volatile("s_waitcnt lgkmcnt(0)" ::: "memory"); __builtin_amdgcn_s_barrier(); asm volatile("" ::: "memory"); } while (0)
constexpr float XQ_SCALE = 0.0625f * 1.4426950408889634f;
__device__ __forceinline__ float rs16(const float* ss, int row) {
    const f32x4 a = *(const f32x4*)(ss + (size_t)row * 4);
    return rsqrtf(((a[0] + a[1]) + (a[2] + a[3])) * (1.f / 1024.f) + EPS);
}
struct EpiMemKV {
    static constexpr bool PERM = true, AFTER_DRAIN = false;
    bf16_t* KX; bf16_t* VXT; const float* rsm; const float* g_xk; PG8_LAS float* X;
    __device__ __forceinline__ void operator()(const f32x4 (&acc)[2][2][4][2], const Unit& u, int wr, int wc, int fr, int fq) const {
        PG8_LAS float* const xw = X + (wr * 64 + fr) * 4 + wc; const PG8_LAS float* const xr = X + (wr * 64 + fr) * 4;
        const int pn = u.pn, cl0 = wc * 32 + 8 * fq;
        if (pn < 4) {
#pragma unroll
            for (int ai = 0; ai < 2; ++ai)
#pragma unroll
                for (int m = 0; m < 4; ++m) {
                    const int rt = ai * HALF + wr * 64 + m * 16 + fr; const float r = rsm[u.pm * BM + rt];
                    float ss = ((sq4(acc[ai][0][m][0]) + sq4(acc[ai][0][m][1])) + (sq4(acc[ai][1][m][0]) + sq4(acc[ai][1][m][1]))) * (r * r);
                    ss += __shfl_xor(ss, 16); ss += __shfl_xor(ss, 32);
                    if (fq == 0) xw[(ai * HALF + m * 16) * 4] = ss;
                }
            PG8_XBAR();
            const f32x4 g00 = *(const f32x4*)(g_xk + cl0), g01 = *(const f32x4*)(g_xk + cl0 + 4), g10 = *(const f32x4*)(g_xk + 128 + cl0), g11 = *(const f32x4*)(g_xk + 128 + cl0 + 4);
#pragma unroll
            for (int ai = 0; ai < 2; ++ai)
#pragma unroll
                for (int m = 0; m < 4; ++m) {
                    const int rt = ai * HALF + wr * 64 + m * 16 + fr, row = u.pm * BM + rt; const float r = rsm[row];
                    const f32x4 p = *(const PG8_LAS f32x4*)(xr + (ai * HALF + m * 16) * 4);
                    const float sc = r * rsqrtf(((p[0] + p[1]) + (p[2] + p[3])) * (1.f / 256.f) + EPS);
                    bf16_t* d = KX + (size_t)row * 1024 + pn * 256 + cl0;
                    st16_wt(d, pack8(acc[ai][0][m][0] * sc * g00, acc[ai][0][m][1] * sc * g01));
                    st16_wt((d + 128), pack8(acc[ai][1][m][0] * sc * g10, acc[ai][1][m][1] * sc * g11));
                }
        } else {
#pragma unroll
            for (int ai = 0; ai < 2; ++ai)
#pragma unroll
                for (int m = 0; m < 4; ++m) {
                    const int rt = ai * HALF + wr * 64 + m * 16 + fr, row = u.pm * BM + rt; const float r = rsm[row];
                    bf16_t* d = VXT + (size_t)row * 1024 + (pn - 4) * 256 + cl0;
                    st16_wt(d, pack8(acc[ai][0][m][0] * r, acc[ai][0][m][1] * r));
                    st16_wt((d + 128), pack8(acc[ai][1][m][0] * r, acc[ai][1][m][1] * r));
                }
        }
    }
};
__device__ __forceinline__ void unpack8(const u32x4 w, f32x4& a, f32x4& b) {
    a = (f32x4){__uint_as_float(w.x << 16), __uint_as_float(w.x & 0xffff0000u), __uint_as_float(w.y << 16), __uint_as_float(w.y & 0xffff0000u)};
    b = (f32x4){__uint_as_float(w.z << 16), __uint_as_float(w.z & 0xffff0000u), __uint_as_float(w.w << 16), __uint_as_float(w.w & 0xffff0000u)};
}
template <bool BASE_BF16> struct EpiRes {
    static constexpr bool PERM = true, AFTER_DRAIN = false;
    const void* base; int base_ld; bf16_t* hb; int hb_ld; float* ss; PG8_LAS float* X;
    __device__ __forceinline__ void operator()(const f32x4 (&acc)[2][2][4][2], const Unit& u, int wr, int wc, int fr, int fq) const {
        const int col0 = u.pn * BM + wc * 32 + 8 * fq;
        PG8_LAS float* const xw = X + (wr * 64 + fr) * 4 + wc; const PG8_LAS float* const xr = X + (wr * 64 + fr) * 4;
#pragma unroll
        for (int ai = 0; ai < 2; ++ai)
#pragma unroll
            for (int m = 0; m < 4; ++m) {
                const int row = u.pm * BM + ai * HALF + wr * 64 + m * 16 + fr; const size_t off = (size_t)row * 1024 + col0;
                float s = 0.f;
#pragma unroll
                for (int bj = 0; bj < 2; ++bj) {
                    f32x4 b0, b1;
                    const size_t boff = (size_t)row * base_ld + col0 + bj * HALF;
                    if (BASE_BF16) unpack8(*(const u32x4*)((const bf16_t*)base + boff), b0, b1);
                    else { b0 = *(const f32x4*)((const float*)base + boff); b1 = *(const f32x4*)((const float*)base + boff + 4); }
                    const f32x4 h0 = b0 + acc[ai][bj][m][0], h1 = b1 + acc[ai][bj][m][1];
                    st16_wt((hb + (size_t)row * hb_ld + col0 + bj * HALF), pack8(h0, h1));
                    s += sq4(h0) + sq4(h1);
                }
                s += __shfl_xor(s, 16); s += __shfl_xor(s, 32);
                if (fq == 0) xw[(ai * HALF + m * 16) * 4] = s;
            }
        PG8_XBAR();
        if (wc == 0 && fq == 0) {
#pragma unroll
            for (int ai = 0; ai < 2; ++ai)
#pragma unroll
                for (int m = 0; m < 4; ++m) { const f32x4 p = *(const PG8_LAS f32x4*)(xr + (ai * HALF + m * 16) * 4);
                    ss[(size_t)(u.pm * BM + ai * HALF + wr * 64 + m * 16 + fr) * 4 + u.pn] = (p[0] + p[1]) + (p[2] + p[3]); }
        }
    }
};
struct EpiXq {
    static constexpr bool PERM = true, AFTER_DRAIN = false;
    bf16_t* QX; const float* ss1; const float* g_xq; PG8_LAS float* X;
    __device__ __forceinline__ void operator()(const f32x4 (&acc)[2][2][4][2], const Unit& u, int wr, int wc, int fr, int fq) const {
        PG8_LAS float* const xw = X + (wr * 64 + fr) * 4 + wc; const PG8_LAS float* const xr = X + (wr * 64 + fr) * 4;
        const int cl0 = wc * 32 + 8 * fq;
        float rr[2][4];
#pragma unroll
        for (int ai = 0; ai < 2; ++ai)
#pragma unroll
            for (int m = 0; m < 4; ++m) {
                const int rt = ai * HALF + wr * 64 + m * 16 + fr; const float r = rs16(ss1, u.pm * BM + rt); rr[ai][m] = r;
                float ss = ((sq4(acc[ai][0][m][0]) + sq4(acc[ai][0][m][1])) + (sq4(acc[ai][1][m][0]) + sq4(acc[ai][1][m][1]))) * (r * r);
                ss += __shfl_xor(ss, 16); ss += __shfl_xor(ss, 32);
                if (fq == 0) xw[(ai * HALF + m * 16) * 4] = ss;
            }
        PG8_XBAR();
        const f32x4 g00 = *(const f32x4*)(g_xq + cl0) * XQ_SCALE, g01 = *(const f32x4*)(g_xq + cl0 + 4) * XQ_SCALE, g10 = *(const f32x4*)(g_xq + 128 + cl0) * XQ_SCALE, g11 = *(const f32x4*)(g_xq + 128 + cl0 + 4) * XQ_SCALE;
#pragma unroll
        for (int ai = 0; ai < 2; ++ai)
#pragma unroll
            for (int m = 0; m < 4; ++m) {
                const int rt = ai * HALF + wr * 64 + m * 16 + fr, row = u.pm * BM + rt;
                const f32x4 p = *(const PG8_LAS f32x4*)(xr + (ai * HALF + m * 16) * 4);
                const float sc = rr[ai][m] * rsqrtf(((p[0] + p[1]) + (p[2] + p[3])) * (1.f / 256.f) + EPS);
                bf16_t* d = QX + (size_t)row * 1024 + u.pn * 256 + cl0;
                st16_wt(d, pack8(acc[ai][0][m][0] * sc * g00, acc[ai][0][m][1] * sc * g01));
                st16_wt((d + 128), pack8(acc[ai][1][m][0] * sc * g10, acc[ai][1][m][1] * sc * g11));
            }
    }
};
struct EpiSoftmax {
    static constexpr bool PERM = true, AFTER_DRAIN = false;
    bf16_t* P; PG8_LAS float* X;
    __device__ __forceinline__ void operator()(const f32x4 (&acc)[2][2][4][2], const Unit& u, int wr, int wc, int fr, int fq) const {
        PG8_LAS float* const xw = X + (wr * 64 + fr) * 4 + wc; const PG8_LAS float* const xr = X + (wr * 64 + fr) * 4;
        const int cl0 = wc * 32 + 8 * fq;
#pragma unroll
        for (int ai = 0; ai < 2; ++ai)
#pragma unroll
            for (int m = 0; m < 4; ++m) {
                const int rt = ai * HALF + wr * 64 + m * 16 + fr;
                float mx = -INFINITY;
#pragma unroll
                for (int bj = 0; bj < 2; ++bj)
#pragma unroll
                    for (int n = 0; n < 2; ++n) { const f32x4 v = acc[ai][bj][m][n]; mx = fmaxf(mx, fmaxf(fmaxf(v[0], v[1]), fmaxf(v[2], v[3]))); }
                mx = fmaxf(mx, __shfl_xor(mx, 16)); mx = fmaxf(mx, __shfl_xor(mx, 32));
                if (fq == 0) xw[(ai * HALF + m * 16) * 4] = mx;
            }
        PG8_XBAR();
        float mr[2][4];
#pragma unroll
        for (int ai = 0; ai < 2; ++ai)
#pragma unroll
            for (int m = 0; m < 4; ++m) {
                const int rt = ai * HALF + wr * 64 + m * 16 + fr;
                const f32x4 p = *(const PG8_LAS f32x4*)(xr + (ai * HALF + m * 16) * 4);
                const float mx = fmaxf(fmaxf(p[0], p[1]), fmaxf(p[2], p[3])); mr[ai][m] = mx;
                float s = 0.f;
#pragma unroll
                for (int bj = 0; bj < 2; ++bj)
#pragma unroll
                    for (int n = 0; n < 2; ++n) { const f32x4 v = acc[ai][bj][m][n];
                        s += (__builtin_amdgcn_exp2f(v[0] - mx) + __builtin_amdgcn_exp2f(v[1] - mx)) + (__builtin_amdgcn_exp2f(v[2] - mx) + __builtin_amdgcn_exp2f(v[3] - mx)); }
                s += __shfl_xor(s, 16); s += __shfl_xor(s, 32);
                if (fq == 0) xw[1024 + (ai * HALF + m * 16) * 4] = s;
            }
        PG8_XBAR();
#pragma unroll
        for (int ai = 0; ai < 2; ++ai)
#pragma unroll
            for (int m = 0; m < 4; ++m) {
                const int rt = ai * HALF + wr * 64 + m * 16 + fr, row = u.pm * BM + rt;
                const f32x4 p = *(const PG8_LAS f32x4*)(xr + 1024 + (ai * HALF + m * 16) * 4);
                const float inv = 1.f / ((p[0] + p[1]) + (p[2] + p[3])), mx = mr[ai][m];
                bf16_t* d = P + (size_t)row * 1024 + u.pn * 256 + cl0;
#pragma unroll
                for (int bj = 0; bj < 2; ++bj) {
                    f32x4 e0, e1;
#pragma unroll
                    for (int j = 0; j < 4; ++j) { e0[j] = __builtin_amdgcn_exp2f(acc[ai][bj][m][0][j] - mx) * inv; e1[j] = __builtin_amdgcn_exp2f(acc[ai][bj][m][1][j] - mx) * inv; }
                    st16_wt((d + bj * 128), pack8(e0, e1));
                }
            }
    }
};
struct EpiBf16Plain {
    static constexpr bool PERM = true, AFTER_DRAIN = false;
    bf16_t* O;
    __device__ __forceinline__ void operator()(const f32x4 (&acc)[2][2][4][2], const Unit& u, int wr, int wc, int fr, int fq) const {
        const int cl0 = wc * 32 + 8 * fq;
#pragma unroll
        for (int ai = 0; ai < 2; ++ai)
#pragma unroll
            for (int m = 0; m < 4; ++m) {
                const int row = u.pm * BM + ai * HALF + wr * 64 + m * 16 + fr;
                bf16_t* d = O + (size_t)row * 1024 + u.pn * 256 + cl0;
                st16_wt(d, pack8(acc[ai][0][m][0], acc[ai][0][m][1]));
                st16_wt((d + 128), pack8(acc[ai][1][m][0], acc[ai][1][m][1]));
            }
    }
};
__device__ __forceinline__ float gelu_tanh_f(float v) {
    const float u = 0.7978845608028654f * (v + 0.044715f * v * v * v);
    return v * __builtin_amdgcn_rcpf(1.f + __builtin_amdgcn_exp2f(-2.885390081777927f * u));
}
template <int CTRL> __device__ __forceinline__ float dppf(float old, float src) {
    return __builtin_bit_cast(float, __builtin_amdgcn_update_dpp(__builtin_bit_cast(int, old), __builtin_bit_cast(int, src), CTRL, 0xf, 0xf, false));
}
__device__ __forceinline__ f32x4 cvti4(const f32x4 a) { typedef int i32x4_ __attribute__((ext_vector_type(4))); const i32x4_ i = __builtin_bit_cast(i32x4_, a); return (f32x4){(float)i[0], (float)i[1], (float)i[2], (float)i[3]}; }
struct EpiFfnFused {
    static constexpr bool PERM = true, AFTER_DRAIN = false;
    bf16_t* ACT; float* HALO; float* FIXA; float* FIXG; const float* rs8; const float* sb8; const float* cw; const float* cb; PG8_LAS float* X;
    __device__ __forceinline__ void operator()(const f32x4 (&acc)[2][2][4][2], const Unit& u, int wr_, int wc_, int fr_, int fq_) const {
        int ln_; asm volatile("v_mbcnt_lo_u32_b32 %0, -1, 0\n\tv_mbcnt_hi_u32_b32 %0, -1, %0" : "=v"(ln_));
        const int fr = ln_ & 15, fq = ln_ >> 4; (void)fr_; (void)fq_;
        int wr = wr_, wc = wc_; asm volatile("" : "+s"(wr), "+s"(wc));
        const int cl0 = wc * 32 + 8 * fq, c0 = u.pn * 128 + cl0;
        float rr[2][4];
#pragma unroll
        for (int ai = 0; ai < 2; ++ai)
#pragma unroll
            for (int m = 0; m < 4; ++m) rr[ai][m] = rs8[u.pm * BM + ai * HALF + wr * 64 + m * 16 + fr];
        if (fr >= 14) {
#pragma unroll
            for (int ai = 0; ai < 2; ++ai) {
                const f32x4 v0 = cvti4(acc[ai][0][3][0]) * rr[ai][3], v1 = cvti4(acc[ai][0][3][1]) * rr[ai][3];
                PG8_LAS float* h = X + ((ai * 2 + wr) * 2 + (fr - 14)) * 128 + cl0;
                *(PG8_LAS f32x4*)h = v0; *(PG8_LAS f32x4*)(h + 4) = v1;
                if (ai == 1 && wr == 1) { float* g = HALO + ((size_t)u.pm * 2 + (fr - 14)) * DFF + c0; *(f32x4*)g = v0; *(f32x4*)(g + 4) = v1; }
            }
        }
        PG8_XBAR();
        u32x2 keep[2][4];
#pragma unroll
        for (int n = 0; n < 2; ++n) {
            const int cn = c0 + 4 * n;
            const f32x4 sa = *(const f32x4*)(sb8 + u.pn * 256 + cl0 + 4 * n), sg = *(const f32x4*)(sb8 + u.pn * 256 + 128 + cl0 + 4 * n);
            const f32x4 w0 = *(const f32x4*)(cw + cn) * sa, w1 = *(const f32x4*)(cw + DFF + cn) * sa, w2 = *(const f32x4*)(cw + 2 * DFF + cn) * sa, cbv = *(const f32x4*)(cb + cn);
#pragma unroll
            for (int ai = 0; ai < 2; ++ai)
#pragma unroll
                for (int m = 0; m < 4; ++m) {
                    const int rt = ai * HALF + wr * 64 + m * 16 + fr, row = u.pm * BM + rt;
                    const f32x4 ca = cvti4(acc[ai][0][m][n]) * rr[ai][m], ga = cvti4(acc[ai][1][m][n]) * rr[ai][m];
                    f32x4 pa = {0.f, 0.f, 0.f, 0.f};
                    if (m > 0) pa = cvti4(acc[ai][0][m - 1][n]) * rr[ai][m - 1];
                    else if (fr >= 14) {
                        const int which = wr == 1 ? ai * 2 : (ai == 1 ? 1 : -1);
                        if (which >= 0) pa = *(const PG8_LAS f32x4*)(X + (which * 2 + (fr - 14)) * 128 + cl0 + 4 * n);
                    }
                    f32x4 oa;
#pragma unroll
                    for (int j = 0; j < 4; ++j) {
                        const float a1 = dppf<0x111>(dppf<0x121>(0.f, pa[j]), ca[j]), a2 = dppf<0x112>(dppf<0x122>(0.f, pa[j]), ca[j]);
                        oa[j] = gelu_tanh_f(cbv[j] + w2[j] * ca[j] + w1[j] * a1 + w0[j] * a2) * (ga[j] * sg[j]);
                    }
                    u32x2 w; w.x = cvt_pk_bf16(oa[0], oa[1]); w.y = cvt_pk_bf16(oa[2], oa[3]);
                    if (n == 0) keep[ai][m] = w;
                    else st16_wt((ACT + (size_t)row * DFF + c0), (u32x4){keep[ai][m].x, keep[ai][m].y, w.x, w.y});
                    if (ai == 0 && m == 0 && wr == 0 && fr < 2) {
                        *(f32x4*)(FIXA + ((size_t)u.pm * 2 + fr) * DFF + cn) = ca; *(f32x4*)(FIXG + ((size_t)u.pm * 2 + fr) * DFF + cn) = ga;
                    }
                }
        }
    }
};
struct EpiFinal {
    static constexpr bool PERM = true, AFTER_DRAIN = false;
    const bf16_t* base; float* out;
    __device__ __forceinline__ void operator()(const f32x4 (&acc)[2][2][4][2], const Unit& u, int wr, int wc, int fr, int fq) const {
        const int col0 = u.pn * BM + wc * 32 + 8 * fq;
#pragma unroll
        for (int ai = 0; ai < 2; ++ai)
#pragma unroll
            for (int m = 0; m < 4; ++m) {
                const size_t off = (size_t)(u.pm * BM + ai * HALF + wr * 64 + m * 16 + fr) * 1024 + col0;
#pragma unroll
                for (int bj = 0; bj < 2; ++bj) {
                    f32x4 b0, b1; unpack8(__builtin_nontemporal_load((const u32x4*)(base + off + bj * HALF)), b0, b1);
                    __builtin_nontemporal_store(b0 + acc[ai][bj][m][0], (f32x4*)(out + off + bj * HALF));
                    __builtin_nontemporal_store(b1 + acc[ai][bj][m][1], (f32x4*)(out + off + bj * HALF + 4));
                }
            }
    }
};
}
constexpr size_t WS_H1B = WS_A2 + 2048;
constexpr size_t WS_QX = 82 * MiB;
constexpr size_t WS_P = 146 * MiB;
constexpr size_t WS_H2B = 82 * MiB;
constexpr size_t WS_VWT = 450 * MiB;
constexpr size_t WS_UA = 82 * MiB;
constexpr size_t WS_UG = 258 * MiB;
static_assert(WS_H2B + (size_t)NTOK * DM * 2 <= WS_P && WS_UG + (size_t)NTOK * DFF * 2 <= WS_VWT && WS_VWT + (size_t)16 * 1024 * 1024 * 2 <= WS_END, "late-phase workspace map");

__device__ __forceinline__ void p1_memkv(Frame& F, const Args& A) {
    pg8::Gemm g{WSP(bf16, WS_MEMB), WSP(bf16, WS_WXKV), 1024, 1024, 1024, 0xffffffffu};
    pg8::TileOrder S; S.init(16, 8, F.G, (int)blockIdx.x, (size_t)256 * 1024 * 2, (size_t)256 * 1024 * 2, F.G >= 256 ? 128 : 0);
    pg8::EpiMemKV E{WSP(bf16, WS_KX), WSP(bf16, WS_VXT), WSP(float, WS_RSM), (const float*)A.in[21], (PG8_LAS float*)(F.lds + LDSX_OFF)};
    pg8::gemm_phase<pg8::EpiMemKV, pg8::TileOrder, true, true>(F.lds + RING_OFF, g, S, E, F.wave);
}
__device__ __forceinline__ void p_wout(Frame& F, const Args& A) {
    pg8::Gemm g{WSP(bf16, WS_ATT), WSP(bf16, WS_WOUT), 1024, 1024, 1024, 0xffffffffu};
    pg8::TileOrder S; S.init(128, 4, F.G, (int)blockIdx.x, (size_t)256 * 1024 * 2, (size_t)256 * 1024 * 2);
    pg8::EpiRes<true> E{WSP(bf16, WS_A2), 2048, WSP(bf16, WS_H1B), 2048, WSP(float, WS_SS1), (PG8_LAS float*)(F.lds + LDSX_OFF)};
    pg8::gemm_phase<pg8::EpiRes<true>, pg8::TileOrder, true, true>(F.lds + RING_OFF, g, S, E, F.wave);
}
__device__ __forceinline__ void p_xq(Frame& F, const Args& A) {
    pg8::Gemm g{WSP(bf16, WS_H1B), WSP(bf16, WS_WXQ), 2048, 1024, 1024, 0xffffffffu};
    pg8::TileOrder S; S.init(128, 4, F.G, (int)blockIdx.x, (size_t)256 * 2048 * 2, (size_t)256 * 1024 * 2);
    pg8::EpiXq E{WSP(bf16, WS_QX), WSP(float, WS_SS1), (const float*)A.in[20], (PG8_LAS float*)(F.lds + LDSX_OFF)};
    pg8::gemm_phase<pg8::EpiXq, pg8::TileOrder, true, true>(F.lds + RING_OFF, g, S, E, F.wave);
}
__device__ __forceinline__ void p_xs(Frame& F) {
    int kk = 256; asm volatile("" : "+s"(kk));
    pg8::Gemm g{WSP(bf16, WS_QX), WSP(bf16, WS_KX), 1024, 1024, kk, 0xffffffffu};
    pg8::TileOrder S; S.init(128, 4, F.G, (int)blockIdx.x, (size_t)256 * 1024 * 2, (size_t)256 * 2, 0, (size_t)256 * 2, (size_t)256 * 1024 * 2);
    pg8::EpiSoftmax E{WSP(bf16, WS_P), (PG8_LAS float*)(F.lds + LDSX_OFF)};
    pg8::gemm_phase<pg8::EpiSoftmax, pg8::TileOrder, true, true>(F.lds + RING_OFF, g, S, E, F.wave);
}
struct VwOrder {
    int G, c;
    __device__ bool next(int i, pg8::Unit& u) const {
        const int L = i * G + c; if (L >= 256) return false;
        const int b = L >> 4, h = (L >> 2) & 3, nt = L & 3;
        u.pm = b * 4 + nt; u.pn = h; u.ao = ((size_t)nt * 256 * 1024 + h * 256) * 2; u.bo = ((size_t)b * 256 * 1024 + h * 256) * 2; return true;
    }
    __device__ __forceinline__ void a_ready(const pg8::Unit&) const {}
    __device__ __forceinline__ void done(const pg8::Unit&) const {}
};
__device__ __forceinline__ void p_vw(Frame& F) {
    int kk = 256; asm volatile("" : "+s"(kk));
    pg8::Gemm g{WSP(bf16, WS_WXO), WSP(bf16, WS_VXT), 1024, 1024, kk, 0xffffffffu};
    VwOrder S{F.G, (int)blockIdx.x};
    pg8::EpiBf16Plain E{WSP(bf16, WS_VWT)};
    pg8::gemm_phase<pg8::EpiBf16Plain, VwOrder, true, true>(F.lds + RING_OFF, g, S, E, F.wave);
}
__device__ __forceinline__ void p_wxo(Frame& F) {
    pg8::Gemm g{WSP(bf16, WS_P), WSP(bf16, WS_VWT), 1024, 1024, 1024, 0xffffffffu};
    pg8::TileOrder S; S.init(128, 4, F.G, (int)blockIdx.x, (size_t)256 * 1024 * 2, (size_t)256 * 1024 * 2, 0, 0, (size_t)1024 * 1024 * 2);
    pg8::EpiRes<true> E{WSP(bf16, WS_H1B), 2048, WSP(bf16, WS_H2B), 1024, WSP(float, WS_SS2), (PG8_LAS float*)(F.lds + LDSX_OFF)};
    pg8::gemm_phase<pg8::EpiRes<true>, pg8::TileOrder, true, true>(F.lds + RING_OFF, g, S, E, F.wave);
}
constexpr size_t WS_HALO = 73 * MiB, WS_FIXA = 76 * MiB, WS_FIXG = 79 * MiB;
static_assert((size_t)128 * 2 * DFF * 4 <= 3 * MiB, "halo buffers");
constexpr size_t WS_A8 = 146 * MiB;
constexpr size_t WS_W8 = 178 * MiB;
constexpr size_t WS_RS8 = 184 * MiB;
constexpr size_t WS_SB8 = 185 * MiB;
static_assert(WS_A8 >= WS_H2B + (size_t)NTOK * DM * 2 && WS_W8 >= WS_A8 + (size_t)NTOK * DM && WS_RS8 >= WS_W8 + (size_t)2 * DFF * DM && WS_SB8 >= WS_RS8 + (size_t)NTOK * 4 && WS_SB8 + (size_t)2 * DFF * 4 <= 210 * MiB, "int8 operand map");
__device__ __forceinline__ void quant_row(const v4u a, const v4u b, unsigned char* dst, float* sc, bool is_w, int lane) {
    float v[16];
#pragma unroll
    for (int i = 0; i < 4; ++i) { v[2 * i] = __uint_as_float(a[i] << 16); v[2 * i + 1] = __uint_as_float(a[i] & 0xffff0000u); v[8 + 2 * i] = __uint_as_float(b[i] << 16); v[8 + 2 * i + 1] = __uint_as_float(b[i] & 0xffff0000u); }
    float mx = 0.f, ss = 0.f;
#pragma unroll
    for (int i = 0; i < 16; ++i) { mx = fmaxf(mx, fabsf(v[i])); ss += v[i] * v[i]; }
    mx = wave_max(mx); ss = wave_sum(ss);
    const float inv = mx > 0.f ? 127.f / mx : 0.f;
    v4u q;
#pragma unroll
    for (int w = 0; w < 4; ++w) {
        const int q0 = (int)rintf(v[4 * w] * inv), q1 = (int)rintf(v[4 * w + 1] * inv), q2 = (int)rintf(v[4 * w + 2] * inv), q3 = (int)rintf(v[4 * w + 3] * inv);
        q[w] = ((unsigned)q0 & 255u) | (((unsigned)q1 & 255u) << 8) | (((unsigned)q2 & 255u) << 16) | ((unsigned)q3 << 24);
    }
    *(GAS v4u*)(dst + 16 * lane) = q;
    if (lane == 0) *sc = is_w ? mx * (1.f / 127.f) : rsqrtf(ss * (1.f / DM) + EPS) * (mx * (1.f / 127.f));
}
__device__ __forceinline__ void p_quant(Frame& F) {
    const int NH = F.G * NWAVES, NR = NTOK + 2 * DFF;
    for (int r = (int)blockIdx.x * NWAVES + F.wave; r < NR; r += 2 * NH) {
        const int r2 = r + NH < NR ? r + NH : r;
        const bool w1 = r >= NTOK, w2 = r2 >= NTOK;
        const bf16* s1 = w1 ? WSP(bf16, WS_WF1) + (size_t)(r - NTOK) * 1024 : WSP(bf16, WS_H2B) + (size_t)r * 1024;
        const bf16* s2 = w2 ? WSP(bf16, WS_WF1) + (size_t)(r2 - NTOK) * 1024 : WSP(bf16, WS_H2B) + (size_t)r2 * 1024;
        const int l = lane_now();
        const v4u a1 = *(const GAS v4u*)(s1 + 16 * l), b1 = *(const GAS v4u*)(s1 + 16 * l + 8), a2 = *(const GAS v4u*)(s2 + 16 * l), b2 = *(const GAS v4u*)(s2 + 16 * l + 8);
        quant_row(a1, b1, w1 ? WSP(unsigned char, WS_W8) + (size_t)(r - NTOK) * 1024 : WSP(unsigned char, WS_A8) + (size_t)r * 1024, w1 ? WSP(float, WS_SB8) + (r - NTOK) : WSP(float, WS_RS8) + r, w1, l);
        if (r2 != r) quant_row(a2, b2, w2 ? WSP(unsigned char, WS_W8) + (size_t)(r2 - NTOK) * 1024 : WSP(unsigned char, WS_A8) + (size_t)r2 * 1024, w2 ? WSP(float, WS_SB8) + (r2 - NTOK) : WSP(float, WS_RS8) + r2, w2, l);
    }
}
__device__ __forceinline__ void p_ffn1(Frame& F, const Args& A) {
    int kk = 512; asm volatile("" : "+s"(kk));
    pg8::Gemm g{WSP(bf16, WS_A8), WSP(bf16, WS_W8), 512, 512, kk, 0xffffffffu};
    pg8::TileOrder S; S.init(128, 22, F.G, (int)blockIdx.x, (size_t)256 * 1024, (size_t)256 * 1024);
    pg8::EpiFfnFused E{WSP(bf16, WS_UG), WSP(float, WS_HALO), WSP(float, WS_FIXA), WSP(float, WS_FIXG), WSP(float, WS_RS8), WSP(float, WS_SB8), (const float*)A.in[24], (const float*)A.in[25], (PG8_LAS float*)(F.lds + LDSX_OFF)};
    pg8::gemm_phase<pg8::EpiFfnFused, pg8::TileOrder, true, true, true>(F.lds + RING_OFF, g, S, E, F.wave);
}
__device__ __forceinline__ void p_ffnfix(Frame& F, const Args& A) {
    const float* cw = (const float*)A.in[24]; const float* cb = (const float*)A.in[25]; const float* sb8 = WSP(float, WS_SB8);
    const float* HALO = WSP(float, WS_HALO); const float* FIXA = WSP(float, WS_FIXA); const float* FIXG = WSP(float, WS_FIXG); bf16* ACT = WSP(bf16, WS_UG);
    const int total = 128 * 2 * DFF;
    for (int i = (int)blockIdx.x * (NWAVES * 64) + (F.wave * 64 + lane_now()); i < total; i += F.G * NWAVES * 64) {
        const int pm = i / (2 * DFF), r = (i / DFF) & 1, c = i % DFF;
        if ((pm & 7) == 0) continue;
        const float sa = sb8[(c >> 7) * 256 + (c & 127)], sg = sb8[(c >> 7) * 256 + 128 + (c & 127)];
        const float a0 = FIXA[((size_t)pm * 2 + r) * DFF + c];
        const float a1 = r == 0 ? HALO[((size_t)(pm - 1) * 2 + 1) * DFF + c] : FIXA[((size_t)pm * 2) * DFF + c];
        const float a2 = r == 0 ? HALO[((size_t)(pm - 1) * 2) * DFF + c] : HALO[((size_t)(pm - 1) * 2 + 1) * DFF + c];
        const float v = cb[c] + sa * (cw[2 * DFF + c] * a0 + cw[DFF + c] * a1 + cw[c] * a2);
        ACT[((size_t)pm * 256 + r) * DFF + c] = (bf16)f2bf(pg8::gelu_tanh_f(v) * (FIXG[((size_t)pm * 2 + r) * DFF + c] * sg));
    }
}
__device__ __forceinline__ void p_ffn2(Frame& F) {
    pg8::Gemm g{WSP(bf16, WS_UG), WSP(bf16, WS_WF2), DFF, DFF, DFF, 0xffffffffu};
    pg8::TileOrder S; S.init(128, 4, F.G, (int)blockIdx.x, (size_t)256 * DFF * 2, (size_t)256 * DFF * 2);
    pg8::EpiFinal E{WSP(bf16, WS_H2B), F.out};
    pg8::gemm_phase<pg8::EpiFinal, pg8::TileOrder, true, true>(F.lds + RING_OFF, g, S, E, F.wave);
}
constexpr int N_PHASES = 14;
__global__ void __launch_bounds__(NWAVES * 64, 2) mk(Args args) {
    extern __shared__ __attribute__((aligned(16))) unsigned char lds[];
    Frame F;
    F.lds = (LAS unsigned char*)lds;
    F.wave = __builtin_amdgcn_readfirstlane((int)threadIdx.x >> 6);
    F.G = gridDim.x; { const int bx = blockIdx.x; F.vcu = (F.G % 8 == 0) ? (bx % 8) * (F.G / 8) + bx / 8 : bx; }
    F.ws = args.ws; F.out = args.out;
    for (int u = threadIdx.x; u < (LDS_BYTES - LDSCTL_OFF) / 4; u += NWAVES * 64) ((LAS unsigned*)(F.lds + LDSCTL_OFF))[u] = 0u;
    __syncthreads();
    const int lo = args.ph_lo, hi = args.ph_hi;
    XcdBarrier bar; bar.bar = (unsigned*)(F.ws + WS_CTL) + CW_BAR; bar.x = 0; bar.st = nullptr; bar.wave = F.wave;
    if (hi - lo > 1) bar = xcd_barrier_post((unsigned*)(F.ws + WS_CTL) + CW_BAR, (volatile LAS unsigned*)(F.lds + MISC_OFF) + 8, F.wave);
#define IN(k) (lo <= (k) && (k) < hi)
#define BOTH(k) (IN(k) && IN((k) + 1))
#ifndef REPEAT_PH
#define REPEAT_PH -1
#endif
#define PHASE(k, body, body2) if (IN(k)) { body; if (BOTH(k)) xcd_barrier(bar); if (REPEAT_PH == (k)) { body2; xcd_barrier(bar); } }
    PHASE(0, p0_prologue(F, args), p0_prologue(F, args))
    PHASE(1, p1_proj(F, args), p1_proj(F, args))
    PHASE(2, (p1_memkv(F, args), idx::run(F, idx::CW_QUEUE)), (p1_memkv(F, args), idx::run(F, idx::CW_QUEUE + 32)))
    PHASE(3, (p_vw(F), p3::run(F, p3::CW_QUEUE)), (p_vw(F), p3::run(F, p3::CW_QUEUE + 32)))
    PHASE(5, p_wout(F, args), p_wout(F, args))
    if (IN(6)) { p_xq(F, args); if (REPEAT_PH == 6) p_xq(F, args); }
    PHASE(7, p_xs(F), p_xs(F))
    PHASE(9, p_wxo(F), p_wxo(F))
    PHASE(10, p_quant(F), p_quant(F))
    PHASE(11, p_ffn1(F, args), p_ffn1(F, args))
    PHASE(12, p_ffnfix(F, args), p_ffnfix(F, args))
    if (IN(13)) { p_ffn2(F); }
#undef PHASE
#undef IN
#undef BOTH
}

extern "C" void kernel_launch(void* const* d_in, const int* in_sizes, int n_in, void* d_out, int out_size, void* d_ws, size_t ws_size, hipStream_t stream) {
    static int grid = 0;
    if (grid == 0) {
        if (n_in != 27 || ws_size < WS_END) { fprintf(stderr, "kernel_launch: unexpected inputs (n_in %d, ws %zu)\n", n_in, ws_size); grid = -1; return; }
        int dev = 0, cus = 0;
        if (hipGetDevice(&dev) != hipSuccess || hipDeviceGetAttribute(&cus, hipDeviceAttributeMultiprocessorCount, dev) != hipSuccess) { grid = -1; return; }
        if (hipFuncSetAttribute((const void*)mk, hipFuncAttributeMaxDynamicSharedMemorySize, LDS_BYTES) != hipSuccess) { fprintf(stderr, "kernel_launch: hipFuncSetAttribute failed\n"); grid = -1; return; }
        (void)hipGetLastError();
        grid = cus;
    }
    if (grid < 0) return;
    float* out = (float*)d_out;
    unsigned char* ws = (unsigned char*)d_ws;
    (void)hipMemsetAsync(ws + WS_CTL, 0, CTL_ZERO_BYTES, stream);
    Args a{};
    for (int i = 0; i < 27; ++i) a.in[i] = d_in[i];
    a.out = out; a.ws = ws;
    for (int i = 0; i < 32; ++i) { const float e = (float)(2 * i) / 64.0f; const float pw = powf(10000.0f, e); a.rf.f[i] = 1.0f / pw; }
    a.ph_lo = 0; a.ph_hi = N_PHASES;
    hipLaunchKernelGGL(mk, dim3(grid), dim3(NWAVES * 64), LDS_BYTES, stream, a);

}
```

```cpp
#include <hip/hip_runtime.h>
#include <cstdint>
#include <cstdio>
#include <cmath>

constexpr int BATCH = 16, SEQ = 2048, DM = 1024, NTOK = BATCH * SEQ;
constexpr int NMEM = 256, NMTOK = BATCH * NMEM;
constexpr int INC = 2500;
constexpr int OFF_QA = 0, OFF_KA = 512, OFF_VA = 576, OFF_QI = 640, OFF_KI = 896, OFF_WI = 960, OFF_QB = 964, OFF_KB = 1476, OFF_VB = 1988;
constexpr int DFF = 2816;
constexpr float EPS = 1e-6f;
constexpr float C2 = 0.125f * 1.4426950408889634f;

struct RopeF { float f[32]; };

__device__ __forceinline__ float wave_sum(float v) {
#pragma unroll
    for (int o = 1; o < 64; o <<= 1) v += __shfl_xor(v, o);
    return v;
}
__device__ __forceinline__ float wave_max(float v) {
#pragma unroll
    for (int o = 1; o < 64; o <<= 1) v = fmaxf(v, __shfl_xor(v, o));
    return v;
}

#ifndef WT_STORES
#define WT_STORES 0
#endif
typedef unsigned wt_u32x4 __attribute__((ext_vector_type(4)));
typedef unsigned wt_u32x2 __attribute__((ext_vector_type(2)));
__device__ __forceinline__ void st16_wt(void* p, wt_u32x4 v) {
#if WT_STORES
    asm volatile("global_store_dwordx4 %0, %1, off sc1\n\ts_nop 1" :: "v"(p), "v"(v) : "memory");
#else
    *(wt_u32x4*)p = v;
#endif
}
__device__ __forceinline__ void st8_wt(void* p, wt_u32x2 v) {
#if WT_STORES
    asm volatile("global_store_dwordx2 %0, %1, off sc1\n\ts_nop 1" :: "v"(p), "v"(v) : "memory");
#else
    *(wt_u32x2*)p = v;
#endif
}
namespace pg8 {
#define PG8_LAS __attribute__((address_space(3)))
typedef unsigned short bf16_t;
typedef short bf16x8 __attribute__((ext_vector_type(8)));
typedef float f32x4 __attribute__((ext_vector_type(4)));
typedef unsigned u32x4 __attribute__((ext_vector_type(4)));
typedef unsigned u32x2 __attribute__((ext_vector_type(2)));
constexpr int BM = 256, BK = 64, HALF = 128, HTB = HALF * BK * 2  , STAGE_BYTES = 8 * HTB, NXCD = 8, WGM = 8;

__host__ __device__ __forceinline__ int lds_byte(int r, int c) { const int st = (r >> 4) * 2 + (c >> 5), rr = r & 15, cc = c & 31, ob = rr * 64 + cc * 2; return st * 1024 + (ob ^ (((ob >> 9) & 1) << 5)); }
__host__ __device__ __forceinline__ void stage_rc(int b, int& R, int& C) { const int st = b / 1024, sb = b % 1024, swz = sb ^ (((sb >> 9) & 1) << 5); R = (st >> 1) * 16 + swz / 64; C = (st & 1) * 32 + (swz % 64) / 2; }
__host__ __device__ __forceinline__ int perm32(int rho) { const int n = rho >> 4, i = rho & 15; return 8 * (i >> 2) + 4 * n + (i & 3); }

struct Unit { int pm, pn; size_t ao, bo; };
struct Gemm { const bf16_t* A; const bf16_t* Bt; int lda, ldb, K; unsigned amask; };

struct TileOrder {
    int nM, nN, nwg, G, c, c0; size_t astep, bstep, apn, bbatch;
    __device__ void init(int nM_, int nN_, int G_, int c_, size_t astep_, size_t bstep_, int c0_ = 0, size_t apn_ = 0, size_t bbatch_ = 0) { nM = nM_; nN = nN_; nwg = nM * nN; G = G_; c = c_; c0 = c0_; astep = astep_; bstep = bstep_; apn = apn_; bbatch = bbatch_; }
    __device__ bool next(int i, Unit& u) const {
        if (c < c0) return false;
        const long L = (long)i * G + (c - c0); if (L >= nwg) return false;
        int wgid = (int)L; { const int q = nwg / NXCD, r = nwg % NXCD, xcd = wgid % NXCD, off = wgid / NXCD; wgid = (xcd < r ? xcd * (q + 1) : r * (q + 1) + (xcd - r) * q) + off; }
        const int nig = WGM * nN, gid = wgid / nig, fm = gid * WGM, gsz = (nM - fm) < WGM ? (nM - fm) : WGM;
        u.pm = fm + ((wgid % nig) % gsz); u.pn = (wgid % nig) / gsz; u.ao = (size_t)u.pm * astep + (size_t)u.pn * apn; u.bo = (size_t)u.pn * bstep + (size_t)(u.pm >> 3) * bbatch; return true;
    }
    __device__ __forceinline__ void a_ready(const Unit&) const {}
    __device__ __forceinline__ void done(const Unit&) const {}
};
__device__ __forceinline__ const char* uptr(const void* p) {
    const unsigned long long v = (unsigned long long)p; const unsigned lo = __builtin_amdgcn_readfirstlane((unsigned)v), hi = __builtin_amdgcn_readfirstlane((unsigned)(v >> 32));
    return (const char*)(((unsigned long long)hi << 32) | lo);
}
__device__ __forceinline__ int lane_id() { int l; asm volatile("v_mbcnt_lo_u32_b32 %0, -1, 0\n\tv_mbcnt_hi_u32_b32 %0, -1, %0" : "=v"(l)); return l; }
__device__ __forceinline__ unsigned cvt_pk_bf16(float lo, float hi) { unsigned r; asm volatile("v_cvt_pk_bf16_f32 %0, %1, %2" : "=v"(r) : "v"(lo), "v"(hi)); return r; }
typedef float f32x2 __attribute__((ext_vector_type(2)));
__device__ __forceinline__ float sq4(const f32x4 v) { return (v[0] * v[0] + v[1] * v[1]) + (v[2] * v[2] + v[3] * v[3]); }
__device__ __forceinline__ void split_pk(float a, float b, unsigned& hi, unsigned& lo) {
    hi = cvt_pk_bf16(a, b);
    const float ah = __uint_as_float(hi << 16), bh = __uint_as_float(hi & 0xffff0000u);
    lo = cvt_pk_bf16(a - ah, b - bh);
}
__device__ __forceinline__ void split8(const f32x4 a, const f32x4 b, u32x4& hi, u32x4& lo) {
    unsigned h0, h1, h2, h3, l0, l1, l2, l3;
    split_pk(a[0], a[1], h0, l0); split_pk(a[2], a[3], h1, l1); split_pk(b[0], b[1], h2, l2); split_pk(b[2], b[3], h3, l3);
    hi = (u32x4){h0, h1, h2, h3}; lo = (u32x4){l0, l1, l2, l3};
}
__device__ __forceinline__ u32x4 pack8(const f32x4 a, const f32x4 b) { u32x4 w; w.x = cvt_pk_bf16(a[0], a[1]); w.y = cvt_pk_bf16(a[2], a[3]); w.z = cvt_pk_bf16(b[0], b[1]); w.w = cvt_pk_bf16(b[2], b[3]); return w; }

struct EpiProj {
    static constexpr bool PERM = true, AFTER_DRAIN = false;
    bf16_t *QA, *QB, *KB, *VB;
    const float *rs, *ct, *st, *g_qa, *g_qb, *g_kb;
    __device__ __forceinline__ void operator()(const f32x4 (&acc)[2][2][4][2], const Unit& u, int wr, int wc, int fr, int fq) const {
        bf16_t* dst = nullptr; int pitch = 0, coff = 0, mode = 0; const float* g = nullptr; float scale = 1.f;
        const int pn = u.pn;
        if (pn < 2)       { dst = QA; pitch = 512; coff = (pn * 4 + wc) * 64; mode = 2; g = g_qa; scale = C2; }
        else if (pn < 4)  { dst = QB; pitch = 512; coff = ((pn - 2) * 4 + wc) * 64; mode = 2; g = g_qb; scale = C2; }
        else if (pn < 6)  { dst = KB; pitch = 512; coff = ((pn - 4) * 4 + wc) * 64; mode = 2; g = g_kb; }
        else              { dst = VB; pitch = 512; coff = ((pn - 6) * 4 + wc) * 64; mode = 1; }
        if (mode == 0) return;
        const int d0 = 8 * fq;
        f32x4 g0a = {1.f, 1.f, 1.f, 1.f}, g0b = g0a, g1a = g0a, g1b = g0a;
        if (mode == 2) { g0a = *(const f32x4*)(g + d0); g0b = *(const f32x4*)(g + d0 + 4); g1a = *(const f32x4*)(g + 32 + d0); g1b = *(const f32x4*)(g + 36 + d0); }
#pragma unroll
        for (int ai = 0; ai < 2; ++ai)
#pragma unroll
            for (int m = 0; m < 4; ++m) {
                const int row = u.pm * BM + ai * HALF + wr * 64 + m * 16 + fr;
                const float r = rs[row];
                f32x4 l0 = acc[ai][0][m][0] * r, l1 = acc[ai][0][m][1] * r, h0 = acc[ai][1][m][0] * r, h1 = acc[ai][1][m][1] * r;
                if (mode == 2) {
                    float ss = (sq4(l0) + sq4(l1)) + (sq4(h0) + sq4(h1));
                    ss += __shfl_xor(ss, 16); ss += __shfl_xor(ss, 32);
                    const float rn = rsqrtf(ss * (1.f / 64.f) + EPS);
                    l0 = l0 * rn * g0a; l1 = l1 * rn * g0b; h0 = h0 * rn * g1a; h1 = h1 * rn * g1b;
                    const f32x4 c0 = *(const f32x4*)(ct + (size_t)row * 32 + d0), c1 = *(const f32x4*)(ct + (size_t)row * 32 + d0 + 4);
                    const f32x4 s0 = *(const f32x4*)(st + (size_t)row * 32 + d0), s1 = *(const f32x4*)(st + (size_t)row * 32 + d0 + 4);
                    const f32x4 nl0 = l0 * c0 - h0 * s0, nh0 = h0 * c0 + l0 * s0, nl1 = l1 * c1 - h1 * s1, nh1 = h1 * c1 + l1 * s1;
                    l0 = nl0 * scale; l1 = nl1 * scale; h0 = nh0 * scale; h1 = nh1 * scale;
                }
                bf16_t* p = dst + (size_t)row * pitch + coff + d0;
                st16_wt(p, pack8(l0, l1));
                st16_wt((p + 32), pack8(h0, h1));
            }
    }
};
struct EpiIdx {
    static constexpr bool PERM = true, AFTER_DRAIN = false;
    bf16_t *QIH, *QIL, *KIH, *KIL; float* WI; bf16_t *KA, *VA;
    const float *rs, *ct, *st, *g_ka;
    __device__ __forceinline__ void operator()(const f32x4 (&acc)[2][2][4][2], const Unit& u, int wr, int wc, int fr, int fq) const {
        const int pn = u.pn;
        const int d0 = 8 * fq;
#pragma unroll
        for (int ai = 0; ai < 2; ++ai)
#pragma unroll
            for (int m = 0; m < 4; ++m) {
                const int row = u.pm * BM + ai * HALF + wr * 64 + m * 16 + fr;
                const float r = rs[row];
                f32x4 l0 = acc[ai][0][m][0] * r, l1 = acc[ai][0][m][1] * r, h0 = acc[ai][1][m][0] * r, h1 = acc[ai][1][m][1] * r;
                if (pn == 1 && wc == 1) { if (fq == 0) *(f32x4*)(WI + (size_t)row * 4) = l0 * 0.0625f; continue; }
                if (pn == 1 && wc == 3) { bf16_t* p = VA + (size_t)row * 64 + d0; st16_wt(p, pack8(l0, l1)); st16_wt((p + 32), pack8(h0, h1)); continue; }
                if (pn == 1 && wc == 2) {
                    float ss = (sq4(l0) + sq4(l1)) + (sq4(h0) + sq4(h1));
                    ss += __shfl_xor(ss, 16); ss += __shfl_xor(ss, 32);
                    const float rn = rsqrtf(ss * (1.f / 64.f) + EPS);
                    l0 = l0 * rn * *(const f32x4*)(g_ka + d0); l1 = l1 * rn * *(const f32x4*)(g_ka + d0 + 4); h0 = h0 * rn * *(const f32x4*)(g_ka + 32 + d0); h1 = h1 * rn * *(const f32x4*)(g_ka + 36 + d0);
                }
                const f32x4 c0 = *(const f32x4*)(ct + (size_t)row * 32 + d0), c1 = *(const f32x4*)(ct + (size_t)row * 32 + d0 + 4);
                const f32x4 s0 = *(const f32x4*)(st + (size_t)row * 32 + d0), s1 = *(const f32x4*)(st + (size_t)row * 32 + d0 + 4);
                const f32x4 nl0 = l0 * c0 - h0 * s0, nh0 = h0 * c0 + l0 * s0, nl1 = l1 * c1 - h1 * s1, nh1 = h1 * c1 + l1 * s1;
                if (pn == 1 && wc == 2) { bf16_t* p = KA + (size_t)row * 64 + d0; st16_wt(p, pack8(nl0, nl1)); st16_wt((p + 32), pack8(nh0, nh1)); continue; }
                bf16_t* ph = pn == 0 ? QIH + (size_t)row * 256 + wc * 64 + d0 : KIH + (size_t)row * 64 + d0;
                st16_wt(ph, pack8(nl0, nl1)); st16_wt((ph + 32), pack8(nh0, nh1));
            }
    }
};
template <bool I8> __device__ __forceinline__ f32x4 mma16(const bf16x8 b, const bf16x8 a, const f32x4 c) {
    if constexpr (I8) { typedef int i32x4_ __attribute__((ext_vector_type(4)));
        return __builtin_bit_cast(f32x4, __builtin_amdgcn_mfma_i32_16x16x64_i8(__builtin_bit_cast(i32x4_, b), __builtin_bit_cast(i32x4_, a), __builtin_bit_cast(i32x4_, c), 0, 0, 0)); }
    else return __builtin_amdgcn_mfma_f32_16x16x32_bf16(b, a, c, 0, 0, 0);
}
template <class Epi, class Sched, bool ALIGN_EPI = false, bool SP2 = false, bool I8 = false>
__device__ __forceinline__ void gemm_phase(PG8_LAS unsigned char* lds, const Gemm g, const Sched& S, const Epi& E, const int wid) {
    const int lane = lane_id(), tid = wid * 64 + lane, wr = wid >> 2, wc = wid & 3, fr = lane & 15, fq = lane >> 4;
    const int nt = g.K / BK; const unsigned amask = g.amask;
    unsigned voffA[2], voffB[2];
#pragma unroll
    for (int i = 0; i < 2; ++i) { int R, C; stage_rc(tid * 16 + i * 8192, R, C); const int Rb = Epi::PERM ? ((R & ~31) + perm32(R & 31)) : R;
        voffA[i] = (unsigned)(R * g.lda + C) * 2u; voffB[i] = (unsigned)(Rb * g.ldb + C) * 2u; }
    const size_t kstep = (size_t)(BK * 2);
    const size_t hstepA = (size_t)HALF * g.lda * 2, hstepB = (size_t)HALF * g.ldb * 2;
#define PG8_AK(tau) ((size_t)(((unsigned)(tau) * 128u) & amask))
    const unsigned ldsw = (unsigned)wid * 1024u;
    const int aoff = lds_byte(wr * 64 + fr, fq * 8), boff = lds_byte(wc * 32 + fr, fq * 8);
#define PG8_SA(b, h) (((b) * 2 + (h)) * HTB)
#define PG8_SB(b, h) ((4 + (b) * 2 + (h)) * HTB)
#define PG8_STAGE(bufoff, gbase, voff) do { const char* gb_ = uptr(gbase); _Pragma("unroll") for (int _i = 0; _i < 2; ++_i) \
        __builtin_amdgcn_global_load_lds((const unsigned*)(gb_ + (voff)[_i]), (PG8_LAS unsigned*)(lds + (bufoff) + ldsw + _i * 8192), 16, 0, 0); } while (0)
#define PG8_LDA(dst, b, h) do { _Pragma("unroll") for (int m = 0; m < 4; ++m) _Pragma("unroll") for (int k = 0; k < 2; ++k) dst[m][k] = *(const PG8_LAS bf16x8*)(lds + PG8_SA(b, h) + aoff + m * 2048 + k * 1024); } while (0)
#define PG8_LDB(dst, b, h) do { _Pragma("unroll") for (int n = 0; n < 2; ++n) _Pragma("unroll") for (int k = 0; k < 2; ++k) dst[n][k] = *(const PG8_LAS bf16x8*)(lds + PG8_SB(b, h) + boff + n * 2048 + k * 1024); } while (0)
#define PG8_MMA(ai, bj, At, Bt) do { __builtin_amdgcn_s_setprio(1); _Pragma("unroll") for (int m = 0; m < 4; ++m) _Pragma("unroll") for (int n = 0; n < 2; ++n) _Pragma("unroll") for (int k = 0; k < 2; ++k) \
        acc[ai][bj][m][n] = mma16<I8>(Bt[n][k], At[m][k], acc[ai][bj][m][n]); __builtin_amdgcn_s_setprio(0); } while (0)
#define PG8_WAIT_V(n) asm volatile("s_waitcnt vmcnt(" #n ")" ::: "memory")
#define PG8_WAIT_L(n) asm volatile("s_waitcnt lgkmcnt(" #n ")" ::: "memory")
#define PG8_BAR __builtin_amdgcn_s_barrier()
#define PG8_SCHED __builtin_amdgcn_sched_barrier(0)
    Unit cur, nxt; int ui = 0;
    if (!S.next(0, cur)) return;
    f32x4 acc[2][2][4][2];
#pragma unroll
    for (int a = 0; a < 2; ++a)
#pragma unroll
        for (int b = 0; b < 2; ++b)
#pragma unroll
            for (int m = 0; m < 4; ++m)
#pragma unroll
                for (int n = 0; n < 2; ++n) acc[a][b][m][n] = (f32x4){0.f, 0.f, 0.f, 0.f};
    bf16x8 At[4][2], B0[2][2], B1[2][2];
    const char* cA = (const char*)g.A + cur.ao; const char* cB = (const char*)g.Bt + cur.bo;
    S.a_ready(cur);
    if constexpr (SP2) {
        PG8_STAGE(PG8_SB(0, 0), cB, voffB); PG8_STAGE(PG8_SB(0, 1), cB + hstepB, voffB); PG8_STAGE(PG8_SA(0, 0), cA, voffA); PG8_STAGE(PG8_SA(0, 1), cA + hstepA, voffA);
        if (wr == 1) PG8_BAR;
        PG8_WAIT_V(2); PG8_BAR;
        PG8_STAGE(PG8_SB(1, 0), cB + kstep, voffB); PG8_STAGE(PG8_SA(1, 0), cA + PG8_AK(1), voffA); PG8_STAGE(PG8_SB(1, 1), cB + hstepB + kstep, voffB);
        PG8_WAIT_V(6); PG8_BAR;
    } else {
        PG8_STAGE(PG8_SB(0, 0), cB, voffB); PG8_STAGE(PG8_SA(0, 0), cA, voffA); PG8_STAGE(PG8_SB(0, 1), cB + hstepB, voffB); PG8_STAGE(PG8_SA(0, 1), cA + hstepA, voffA);
        if (wr == 1) PG8_BAR;
        PG8_WAIT_V(4); PG8_BAR;
        PG8_STAGE(PG8_SB(1, 0), cB + kstep, voffB); PG8_STAGE(PG8_SA(1, 0), cA + PG8_AK(1), voffA); PG8_STAGE(PG8_SB(1, 1), cB + hstepB + kstep, voffB);
        PG8_WAIT_V(6); PG8_BAR;
    }
    for (;;) {
        const bool has_next = S.next(ui + 1, nxt);
        const char* nA = has_next ? (const char*)g.A + nxt.ao : cA; const char* nB = has_next ? (const char*)g.Bt + nxt.bo : cB;
        for (int t = 0; t < nt; t += 2) {
            const bool last = (t == nt - 2);
            const char* a1 = cA + PG8_AK(t + 1);
            const char* a2 = last ? nA : cA + PG8_AK(t + 2); const char* b2 = last ? nB : cB + (size_t)(t + 2) * kstep;
            const char* a3 = last ? nA + PG8_AK(1) : cA + PG8_AK(t + 3); const char* b3 = b2 + kstep;
            if (last && has_next) S.a_ready(nxt);
            if constexpr (SP2) {
            PG8_LDB(B0, 0, 0); PG8_LDB(B1, 0, 1); PG8_SCHED; PG8_LDA(At, 0, 0); PG8_STAGE(PG8_SA(1, 1), a1 + hstepA, voffA);
            PG8_WAIT_V(8); PG8_WAIT_L(0); PG8_BAR; PG8_MMA(0, 0, At, B0); PG8_MMA(0, 1, At, B1); PG8_BAR; PG8_SCHED;
            PG8_LDA(At, 0, 1); PG8_STAGE(PG8_SB(0, 0), b2, voffB); PG8_STAGE(PG8_SB(0, 1), b2 + hstepB, voffB); PG8_STAGE(PG8_SA(0, 0), a2, voffA);
            PG8_WAIT_V(8); PG8_WAIT_L(0); PG8_BAR; PG8_MMA(1, 0, At, B0); PG8_MMA(1, 1, At, B1); PG8_BAR; PG8_SCHED;
            PG8_LDB(B0, 1, 0); PG8_LDB(B1, 1, 1); PG8_SCHED; PG8_LDA(At, 1, 0); PG8_STAGE(PG8_SA(0, 1), a2 + hstepA, voffA);
            PG8_WAIT_V(8); PG8_WAIT_L(0); PG8_BAR; PG8_MMA(0, 0, At, B0); PG8_MMA(0, 1, At, B1); PG8_BAR; PG8_SCHED;
            PG8_LDA(At, 1, 1); PG8_STAGE(PG8_SB(1, 0), b3, voffB); PG8_STAGE(PG8_SB(1, 1), b3 + hstepB, voffB); PG8_STAGE(PG8_SA(1, 0), a3, voffA);
            PG8_WAIT_V(8); PG8_WAIT_L(0); PG8_BAR; PG8_MMA(1, 0, At, B0); PG8_MMA(1, 1, At, B1); PG8_BAR; PG8_SCHED;
            } else {
            PG8_LDB(B0, 0, 0); PG8_SCHED; PG8_LDA(At, 0, 0); PG8_STAGE(PG8_SA(1, 1), a1 + hstepA, voffA);
            PG8_WAIT_L(8); PG8_BAR; PG8_WAIT_L(0); PG8_MMA(0, 0, At, B0); PG8_BAR; PG8_SCHED;
            PG8_LDB(B1, 0, 1); PG8_STAGE(PG8_SB(0, 0), b2, voffB);
            PG8_BAR; PG8_WAIT_L(0); PG8_MMA(0, 1, At, B1); PG8_BAR;
            PG8_LDA(At, 0, 1); PG8_STAGE(PG8_SA(0, 0), a2, voffA);
            PG8_BAR; PG8_WAIT_L(0); PG8_MMA(1, 0, At, B0); PG8_BAR; PG8_SCHED;
            PG8_STAGE(PG8_SB(0, 1), b2 + hstepB, voffB);
            PG8_WAIT_V(6); PG8_BAR; PG8_MMA(1, 1, At, B1); PG8_BAR;
            PG8_LDB(B0, 1, 0); PG8_SCHED; PG8_LDA(At, 1, 0); PG8_STAGE(PG8_SA(0, 1), a2 + hstepA, voffA);
            PG8_WAIT_L(8); PG8_BAR; PG8_WAIT_L(0); PG8_MMA(0, 0, At, B0); PG8_BAR; PG8_SCHED;
            PG8_LDB(B1, 1, 1); PG8_STAGE(PG8_SB(1, 0), b3, voffB);
            PG8_BAR; PG8_WAIT_L(0); PG8_MMA(0, 1, At, B1); PG8_BAR;
            PG8_LDA(At, 1, 1); PG8_STAGE(PG8_SA(1, 0), a3, voffA);
            PG8_BAR; PG8_WAIT_L(0); PG8_MMA(1, 0, At, B0); PG8_BAR; PG8_SCHED;
            PG8_STAGE(PG8_SB(1, 1), b3 + hstepB, voffB);
            PG8_WAIT_V(6); PG8_BAR; PG8_MMA(1, 1, At, B1); PG8_BAR;
            }
        }
        if constexpr (ALIGN_EPI) { if (wr == 0) PG8_BAR; }
        if constexpr (!Epi::AFTER_DRAIN) { E(acc, cur, wr, wc, fr, fq); S.done(cur); }
        if (!has_next) break;
#pragma unroll
        for (int a = 0; a < 2; ++a)
#pragma unroll
            for (int b = 0; b < 2; ++b)
#pragma unroll
                for (int m = 0; m < 4; ++m)
#pragma unroll
                    for (int n = 0; n < 2; ++n) acc[a][b][m][n] = (f32x4){0.f, 0.f, 0.f, 0.f};
        cur = nxt; cA = nA; cB = nB; ++ui;
        if constexpr (ALIGN_EPI) { if (wr == 1) PG8_BAR; }
    }
    PG8_WAIT_V(0);
    if constexpr (!ALIGN_EPI) { if (wr == 0) PG8_BAR; }
    PG8_BAR;
    if constexpr (Epi::AFTER_DRAIN) { E.fused(acc, cur, wr, wc, fr, fq, lds, wid, lane); S.done(cur); }
#undef PG8_AK
#undef PG8_SA
#undef PG8_SB
#undef PG8_STAGE
#undef PG8_LDA
#undef PG8_LDB
#undef PG8_MMA
#undef PG8_WAIT_V
#undef PG8_WAIT_L
#undef PG8_BAR
#undef PG8_SCHED
}
}
constexpr int NWAVES = 8;
constexpr size_t MiB = 1u << 20;
constexpr size_t WS_CTL = 0, CTL_ZERO_BYTES = 1 * MiB;
constexpr size_t WS_W1T = 1 * MiB;
constexpr size_t WS_WIT = 6 * MiB;
constexpr size_t WS_WOUT = 9 * MiB;
constexpr size_t WS_WXQ = 11 * MiB;
constexpr size_t WS_WXKV = 13 * MiB;
constexpr size_t WS_WXO = 17 * MiB;
constexpr size_t WS_WF1 = 19 * MiB;
constexpr size_t WS_WF2 = 30 * MiB;
constexpr size_t WS_CT = 36 * MiB, WS_ST = 40 * MiB;
constexpr size_t WS_RS0 = 44 * MiB;
constexpr size_t WS_RSM = 44 * MiB + 128 * 1024;
constexpr size_t WS_LAM = 44 * MiB + 192 * 1024;
constexpr size_t WS_SS1 = 45 * MiB, WS_SS2 = 47 * MiB;
constexpr size_t WS_MEMB = 49 * MiB;
constexpr size_t WS_KX = 57 * MiB;
constexpr size_t WS_VXT = 65 * MiB;
constexpr size_t WS_MASK = 73 * MiB;
constexpr size_t WS_WI = 81 * MiB;
constexpr size_t WS_KIH = 82 * MiB, WS_KIL = 86 * MiB, WS_KA = 90 * MiB, WS_VA = 94 * MiB;
constexpr size_t WS_QIH = 98 * MiB, WS_QIL = 114 * MiB;
constexpr size_t WS_QA = 130 * MiB, WS_QB = 162 * MiB, WS_KB = 194 * MiB, WS_VB = 226 * MiB;
constexpr size_t WS_A2 = 258 * MiB;
constexpr size_t WS_ATT = 386 * MiB;
constexpr size_t WS_END = 512 * MiB;
constexpr int CW_BAR = 4096;

constexpr int RING_OFF = 0, RING_BYTES = 131072;
constexpr int LDSCTL_OFF = RING_BYTES, MISC_OFF = LDSCTL_OFF + 320, LDSX_OFF = RING_BYTES + 1024;
constexpr int LDS_BYTES = 147456;

#define GAS __attribute__((address_space(1)))
#define LAS __attribute__((address_space(3)))
typedef unsigned short bf16;
typedef unsigned v4u __attribute__((ext_vector_type(4)));
typedef unsigned v2u __attribute__((ext_vector_type(2)));
typedef float f32x4 __attribute__((ext_vector_type(4)));
typedef short bf16x8 __attribute__((ext_vector_type(8)));
#define LDS_WAIT() asm volatile("s_waitcnt lgkmcnt(0)" ::: "memory")
#define VM_WAIT() asm volatile("s_waitcnt vmcnt(0)" ::: "memory")
__device__ __forceinline__ unsigned f2bf(float f) { unsigned u = __builtin_bit_cast(unsigned, f); return (u + 0x7fffu + ((u >> 16) & 1u)) >> 16; }
__device__ __forceinline__ unsigned pk2(float lo, float hi) { return f2bf(lo) | (f2bf(hi) << 16); }
__device__ __forceinline__ int lane_now() { int l; asm volatile("v_mbcnt_lo_u32_b32 %0, -1, 0\n\tv_mbcnt_hi_u32_b32 %0, -1, %0" : "=v"(l)); return l; }
__device__ __forceinline__ float bf2f(bf16 b) { return __uint_as_float((unsigned)b << 16); }
#define XB_TMO      128
#define XB_XCNT(j)  (256  + 64 * (j))
#define XB_XSUB(j)  (1280 + 64 * (j))
#define XB_XGEN(j)  (2304 + 64 * (j))
#define XB_TOP      3328
#define XB_TOPGEN   3392
#define XCD_BAR_WORDS 3456
#define XB_SPIN_CAP (1u << 18)

__device__ __forceinline__ unsigned xb_ld(unsigned* p)              { return __hip_atomic_load(p, __ATOMIC_RELAXED, __HIP_MEMORY_SCOPE_AGENT); }
__device__ __forceinline__ unsigned xb_add(unsigned* p, unsigned v) { return __hip_atomic_fetch_add(p, v, __ATOMIC_RELAXED, __HIP_MEMORY_SCOPE_AGENT); }
__device__ __forceinline__ unsigned xb_xcc_id() { return (unsigned)__builtin_amdgcn_s_getreg((3 << 11) | 20) & 0xFu; }
#define XB_SPIN(cond, bar) do { unsigned _sp = 0; while (cond) { __builtin_amdgcn_s_sleep(1); \
    if ((++_sp & 255u) == 0u) { if (xb_ld(&(bar)[XB_TMO])) break; if (_sp > XB_SPIN_CAP) { atomicAdd(&(bar)[XB_TMO], 1u); break; } } } } while (0)

struct XcdBarrier {
    unsigned* bar; unsigned x; int wave;
    volatile LAS unsigned* st;
};

__device__ __forceinline__ XcdBarrier xcd_barrier_post(unsigned* bar, volatile LAS unsigned* st, int wave) {
    XcdBarrier b; b.bar = bar; b.x = xb_xcc_id(); b.st = st; b.wave = wave;
    if (wave == 0 && lane_now() == 0) (void)xb_add(&bar[XB_XCNT(b.x)], 1u);
    return b;
}
__device__ __forceinline__ void xcd_barrier_complete(unsigned* bar, unsigned x, unsigned& nloc, unsigned& nx) {
    const unsigned G = gridDim.x * gridDim.y * gridDim.z;
    unsigned sum, cnt, mine, sp = 0u;
    for (;;) {
        sum = 0u; cnt = 0u; mine = 0u;
#pragma unroll
        for (unsigned j = 0; j < 16; ++j) { const unsigned c = xb_ld(&bar[XB_XCNT(j)]); sum += c; cnt += (c > 0u) ? 1u : 0u; mine = (j == x) ? c : mine; }
        if (sum == G) break;
        __builtin_amdgcn_s_sleep(1);
        if ((++sp & 255u) == 0u) { if (xb_ld(&bar[XB_TMO])) break; if (sp > XB_SPIN_CAP) { atomicAdd(&bar[XB_TMO], 1u); break; } }
    }
    nloc = mine > 0u ? mine : 1u; nx = cnt > 0u ? cnt : 1u;
}

__device__ __forceinline__ void xcd_barrier(const XcdBarrier& b) {
    asm volatile("s_waitcnt vmcnt(0)" ::: "memory");
    __syncthreads();
    if (b.wave == 0 && lane_now() == 0) {
        unsigned* bar = b.bar;
        __builtin_amdgcn_s_waitcnt(0);
        unsigned nloc = b.st[0], nx = b.st[1];
        if (nloc == 0u) { xcd_barrier_complete(bar, b.x, nloc, nx); b.st[0] = nloc; b.st[1] = nx; }
        const unsigned old = xb_add(&bar[XB_XSUB(b.x)], 1u);
        const unsigned gen = old / nloc;
        if (old + 1u == (gen + 1u) * nloc) {
            __builtin_amdgcn_fence(__ATOMIC_RELEASE, "agent");
            asm volatile("s_waitcnt vmcnt(0)" ::: "memory");
            const unsigned og = xb_add(&bar[XB_TOP], 1u);
            const unsigned tg = og / nx;
            if (og + 1u == (tg + 1u) * nx) xb_add(&bar[XB_TOPGEN], 1u);
            else XB_SPIN(xb_ld(&bar[XB_TOPGEN]) == tg, bar);
            __builtin_amdgcn_fence(__ATOMIC_ACQUIRE, "agent");
            xb_add(&bar[XB_XGEN(b.x)], 1u);
            asm volatile("s_waitcnt vmcnt(0)" ::: "memory");
        } else {
            XB_SPIN(xb_ld(&bar[XB_XGEN(b.x)]) == gen, bar);
            __builtin_amdgcn_fence(__ATOMIC_ACQUIRE, "agent");
            asm volatile("s_waitcnt vmcnt(0)" ::: "memory");
        }
    }
    __syncthreads();
}
struct Args { const void* in[27]; float* out; unsigned char* ws; RopeF rf; int ph_lo, ph_hi; };
struct Frame {
    LAS unsigned char* lds;
    int wave, vcu, G;
    unsigned char* ws; float* out;
};
#define WSP(T, off) ((T*)(F.ws + (off)))

__device__ __forceinline__ void sincos_acc(float ang, float& c, float& s) {
    const double a = (double)ang;
    const double k = rint(a * 0.63661977236758134308);
    double r = fma(-k, 1.57079632679489655800e+00, a);
    r = fma(-k, 6.12323399573676603587e-17, r);
    const double r2 = r * r;
    double sp = -1.0 / 1307674368000.0;
    sp = fma(sp, r2, 1.0 / 6227020800.0); sp = fma(sp, r2, -1.0 / 39916800.0); sp = fma(sp, r2, 1.0 / 362880.0); sp = fma(sp, r2, -1.0 / 5040.0);
    sp = fma(sp, r2, 1.0 / 120.0); sp = fma(sp, r2, -1.0 / 6.0); sp = fma(sp, r2, 1.0);
    const double sn = sp * r;
    double cp = 1.0 / 20922789888000.0;
    cp = fma(cp, r2, -1.0 / 87178291200.0); cp = fma(cp, r2, 1.0 / 479001600.0); cp = fma(cp, r2, -1.0 / 3628800.0); cp = fma(cp, r2, 1.0 / 40320.0);
    cp = fma(cp, r2, -1.0 / 720.0); cp = fma(cp, r2, 1.0 / 24.0); cp = fma(cp, r2, -0.5);
    const double cs = fma(cp, r2, 1.0);
    const int q = ((int)k) & 3;
    double cc, ss;
    if (q == 0) { cc = cs; ss = sn; } else if (q == 1) { cc = -sn; ss = cs; } else if (q == 2) { cc = -cs; ss = -sn; } else { cc = sn; ss = -cs; }
    c = (float)cc; s = (float)ss;
}

__device__ __forceinline__ int srcmap(int mat, int r) {
    if (mat == 0 || mat == 1) {
        const int tile = r >> 8, cpos = r & 255, slot = (cpos >> 5) & 3, dim = ((cpos >> 7) << 5) | (cpos & 31);
        if (mat == 0) {
            if (tile < 2) return OFF_QA + (tile * 4 + slot) * 64 + dim;
            if (tile < 4) return OFF_QB + ((tile - 2) * 4 + slot) * 64 + dim;
            if (tile < 6) return OFF_KB + ((tile - 4) * 4 + slot) * 64 + dim;
            return OFF_VB + ((tile - 6) * 4 + slot) * 64 + dim;
        }
        if (tile == 0) return OFF_QI + slot * 64 + dim;
        if (slot == 0) return OFF_KI + dim;
        if (slot == 1) return dim < 4 ? OFF_WI + dim : -1;
        return slot == 2 ? OFF_KA + dim : OFF_VA + dim;
    }
    if (mat == 7) { const int tile = r >> 8, half = (r >> 7) & 1, within = r & 127; return half * DFF + tile * 128 + within; }
    return r;
}
__device__ __forceinline__ void p0_item(const float* W, int ldw, const float* g, bf16* WT, int ldd, int row_off, int mat, bool split, LAS float* scr, int item, int nkb, int lane) {
    const int rb = item / nkb, kb = item % nkb, k0 = 64 * kb, r0 = 32 * rb;
    const int src = srcmap(mat, r0 + (lane & 31));
    float wv[32];
    const float* wp = W + (size_t)(k0 + (lane >> 5)) * ldw + (src >= 0 ? src : 0);
#pragma unroll
    for (int i = 0; i < 32; ++i) wv[i] = __builtin_nontemporal_load(wp + (size_t)(2 * i) * ldw);
    const float gz = src >= 0 ? 1.f : 0.f;
#pragma unroll
    for (int i = 0; i < 32; ++i) { const int kk = 2 * i + (lane >> 5);
        float v = wv[i] * gz; if (g) v *= g[k0 + kk];
        scr[kk * 33 + (lane & 31)] = v; }
    LDS_WAIT(); asm volatile("" ::: "memory");
    const int c = lane & 7;
#pragma unroll
    for (int j = 0; j < 4; ++j) { const int n = (lane >> 3) + 8 * j; const LAS float* s = scr + (8 * c) * 33 + n;
        const float v0 = s[0 * 33], v1 = s[1 * 33], v2 = s[2 * 33], v3 = s[3 * 33], v4 = s[4 * 33], v5 = s[5 * 33], v6 = s[6 * 33], v7 = s[7 * 33];
        v4u o; o.x = pk2(v0, v1); o.y = pk2(v2, v3); o.z = pk2(v4, v5); o.w = pk2(v6, v7);
        bf16* d = WT + (size_t)(row_off + r0 + n) * ldd + k0 + 8 * c;
        *(GAS v4u*)d = o;
        if (split) {
            *(GAS v4u*)(d + 1024) = o;
            v4u l; l.x = pk2(v0 - __uint_as_float(o.x << 16), v1 - __uint_as_float(o.x & 0xffff0000u)); l.y = pk2(v2 - __uint_as_float(o.y << 16), v3 - __uint_as_float(o.y & 0xffff0000u));
            l.z = pk2(v4 - __uint_as_float(o.z << 16), v5 - __uint_as_float(o.z & 0xffff0000u)); l.w = pk2(v6 - __uint_as_float(o.w << 16), v7 - __uint_as_float(o.w & 0xffff0000u));
            *(GAS v4u*)(d + 2048) = l;
        } }
    LDS_WAIT(); asm volatile("" ::: "memory");
}
__device__ __forceinline__ void p0_xrow_store(Frame& F, int m, const f32x4 (&v)[4], float s) {
    s = wave_sum(s);
    if (lane_now() == 0) WSP(float, WS_RS0)[m] = rsqrtf(s * (1.f / DM) + EPS);
    GAS v2u* o8 = (GAS v2u*)(WSP(bf16, WS_A2) + (size_t)m * 2048) + lane_now();
#pragma unroll
    for (int j = 0; j < 4; ++j) {
        v2u h; h.x = pk2(v[j].x, v[j].y); h.y = pk2(v[j].z, v[j].w);
        o8[64 * j] = h;
    }
}
__device__ __forceinline__ void p0_prologue(Frame& F, const Args& A) {
    const int NH = F.G * NWAVES;
    const int gw = F.vcu * NWAVES + F.wave;
    for (int pass = 0; pass < 2; ++pass) {
    if ((pass ^ (F.wave & 1)) == 0) {
        LAS float* scr = (LAS float*)(F.lds + RING_OFF + F.wave * 16384);
        const float* w_in = (const float*)A.in[4]; const float* g_mix = (const float*)A.in[3];
        constexpr int I0 = 64 * 16, I1 = 16 * 16, I2 = 512, I7 = 176 * 16, I8 = 32 * 44;
        constexpr int NITEMS = I0 + I1 + 5 * I2 + I7 + I8;
        for (int it = gw; it < NITEMS; it += NH) {
            int r = it;
            if (r < I0) { p0_item(w_in, INC, g_mix, WSP(bf16, WS_W1T), 1024, 0, 0, false, scr, r, 16, lane_now()); continue; } r -= I0;
            if (r < I1) { p0_item(w_in, INC, g_mix, WSP(bf16, WS_W1T), 1024, 2048, 1, false, scr, r, 16, lane_now()); continue; } r -= I1;
            if (r < I2) { p0_item((const float*)A.in[13], DM, nullptr, WSP(bf16, WS_WOUT), 1024, 0, 2, false, scr, r, 16, lane_now()); continue; } r -= I2;
            if (r < I2) { p0_item((const float*)A.in[16], DM, (const float*)A.in[14], WSP(bf16, WS_WXQ), 1024, 0, 3, false, scr, r, 16, lane_now()); continue; } r -= I2;
            if (r < I2) { p0_item((const float*)A.in[17], DM, (const float*)A.in[15], WSP(bf16, WS_WXKV), 1024, 0, 4, false, scr, r, 16, lane_now()); continue; } r -= I2;
            if (r < I2) { p0_item((const float*)A.in[18], DM, (const float*)A.in[15], WSP(bf16, WS_WXKV), 1024, 1024, 5, false, scr, r, 16, lane_now()); continue; } r -= I2;
            if (r < I2) { p0_item((const float*)A.in[19], DM, nullptr, WSP(bf16, WS_WXO), 1024, 0, 6, false, scr, r, 16, lane_now()); continue; } r -= I2;
            if (r < I7) { p0_item((const float*)A.in[23], 2 * DFF, (const float*)A.in[22], WSP(bf16, WS_WF1), 1024, 0, 7, false, scr, r, 16, lane_now()); continue; } r -= I7;
            p0_item((const float*)A.in[26], DM, nullptr, WSP(bf16, WS_WF2), DFF, 0, 8, false, scr, r, 44, lane_now());
        }
        const int* pos = (const int*)A.in[2];
        for (int i = gw * 64 + lane_now(); i < NTOK * 32; i += NH * 64) {
            const float ang = (float)pos[i >> 5] * A.rf.f[i & 31];
            float c, s; sincos_acc(ang, c, s);
            WSP(float, WS_CT)[i] = c; WSP(float, WS_ST)[i] = s;
        }
        if (blockIdx.x == 0 && F.wave == 0) {
            const float a = ((const float*)A.in[9])[lane_now()] * ((const float*)A.in[10])[lane_now()], b = ((const float*)A.in[11])[lane_now()] * ((const float*)A.in[12])[lane_now()];
            const float l1 = wave_sum(a), l2 = wave_sum(b);
            if (lane_now() == 0) WSP(float, WS_LAM)[0] = expf(l1) - expf(l2) + 0.2f;
        }
    } else {
        const float* x = (const float*)A.in[0];
        for (int m = gw; m < NTOK; m += 2 * NH) {
            const int m2 = m + NH;
            const GAS f32x4* xr = (const GAS f32x4*)(x + (size_t)m * DM) + lane_now();
            const GAS f32x4* xr2 = (const GAS f32x4*)(x + (size_t)(m2 < NTOK ? m2 : m) * DM) + lane_now();
            f32x4 v[4], w[4]; float s = 0.f, s2 = 0.f;
#pragma unroll
            for (int j = 0; j < 4; ++j) { v[j] = __builtin_nontemporal_load(xr + 64 * j); w[j] = __builtin_nontemporal_load(xr2 + 64 * j); }
#pragma unroll
            for (int j = 0; j < 4; ++j) { s += (v[j].x * v[j].x + v[j].y * v[j].y) + (v[j].z * v[j].z + v[j].w * v[j].w); s2 += (w[j].x * w[j].x + w[j].y * w[j].y) + (w[j].z * w[j].z + w[j].w * w[j].w); }
            p0_xrow_store(F, m, v, s);
            if (m2 < NTOK) p0_xrow_store(F, m2, w, s2);
        }
        const float* mem = (const float*)A.in[1];
        for (int m = gw; m < NMTOK; m += NH) {
            const GAS f32x4* xr = (const GAS f32x4*)(mem + (size_t)m * DM) + lane_now();
            f32x4 v[4]; float s = 0.f;
#pragma unroll
            for (int j = 0; j < 4; ++j) { v[j] = xr[64 * j]; s += (v[j].x * v[j].x + v[j].y * v[j].y) + (v[j].z * v[j].z + v[j].w * v[j].w); }
            s = wave_sum(s);
            if (lane_now() == 0) WSP(float, WS_RSM)[m] = rsqrtf(s * (1.f / DM) + EPS);
            GAS v2u* o8 = (GAS v2u*)(WSP(bf16, WS_MEMB) + (size_t)m * DM) + lane_now();
#pragma unroll
            for (int j = 0; j < 4; ++j) { v2u h; h.x = pk2(v[j].x, v[j].y); h.y = pk2(v[j].z, v[j].w); o8[64 * j] = h; }
        }
    }
    }
}

struct EpiProjIdx {
    static constexpr bool PERM = true, AFTER_DRAIN = false;
    pg8::EpiProj p; pg8::EpiIdx x;
    __device__ __forceinline__ void operator()(const pg8::f32x4 (&acc)[2][2][4][2], const pg8::Unit& u, int wr, int wc, int fr, int fq) const {
        if (u.pn < 8) p(acc, u, wr, wc, fr, fq);
        else { pg8::Unit v = u; v.pn = u.pn - 8; x(acc, v, wr, wc, fr, fq); }
    }
};
__device__ __forceinline__ void p1_proj(Frame& F, const Args& A) {
    const float* rs = WSP(float, WS_RS0); const float* ct = WSP(float, WS_CT); const float* st = WSP(float, WS_ST);
    pg8::Gemm g{WSP(bf16, WS_A2), WSP(bf16, WS_W1T), 2048, 1024, 1024, 0xffffffffu};
    pg8::TileOrder S; S.init(128, 10, F.G, (int)blockIdx.x, (size_t)256 * 2048 * 2, (size_t)256 * 1024 * 2);
    EpiProjIdx E{pg8::EpiProj{WSP(bf16, WS_QA), WSP(bf16, WS_QB), WSP(bf16, WS_KB), WSP(bf16, WS_VB), rs, ct, st, (const float*)A.in[5], (const float*)A.in[7], (const float*)A.in[8]},
                 pg8::EpiIdx{WSP(bf16, WS_QIH), WSP(bf16, WS_QIL), WSP(bf16, WS_KIH), WSP(bf16, WS_KIL), WSP(float, WS_WI), WSP(bf16, WS_KA), WSP(bf16, WS_VA), rs, ct, st, (const float*)A.in[6]}};
    pg8::gemm_phase<EpiProjIdx, pg8::TileOrder, true, true>(F.lds + RING_OFF, g, S, E, F.wave);
}
namespace attn_body {
using bf16=unsigned short;
using bf16x8=__attribute__((ext_vector_type(8)))short;
using s16x4=__attribute__((ext_vector_type(4)))short;
using f32x16=__attribute__((ext_vector_type(16)))float;
using u32x4=__attribute__((ext_vector_type(4)))unsigned;
constexpr int SEQ=2048,D=64;
constexpr int NW=8,QBLK=32,QB=QBLK*NW,KVBLK=64,NQB=SEQ/QB;
constexpr int ATTN_UNIT_ROWS=QB;
__device__ __forceinline__ constexpr int cr0(int r){return (r&3)+8*(r>>2);}
__device__ __forceinline__ int crow(int r,int hi){return (r&3)+8*(r>>2)+4*hi;}
#define SBAR() __builtin_amdgcn_sched_barrier(0)
__device__ __forceinline__ void cmask(f32x16&p0,f32x16&p1,int jb,int qrel,int hi){
  const float NEG=-INFINITY; int kb=64*jb+4*hi;
  #pragma unroll
  for(int r=0;r<16;++r){int kv=kb+(r&3)+8*(r>>2); if(kv>qrel)p0[r]=NEG; if(kv+32>qrel)p1[r]=NEG;}
}

__device__ __forceinline__ void bmask(f32x16&p0,f32x16&p1,unsigned w0,unsigned w1,int hi){
  const float NEG=-INFINITY; const unsigned m0=w0>>(4*hi), m1=w1>>(4*hi);
  #pragma unroll
  for(int r=0;r<16;++r){ if(!((m0>>cr0(r))&1u))p0[r]=NEG; if(!((m1>>cr0(r))&1u))p1[r]=NEG; }
}
constexpr int NSLOT=3, SLOTB=8192;
constexpr int MWAVE=8192;
constexpr int LDS_K=0, LDS_V=NSLOT*SLOTB, LDS_WS=2*NSLOT*SLOTB, LDS_OST=LDS_WS+NW*64*4, LDS_BYTES=LDS_OST+NW*MWAVE;
constexpr float C2=0.125f*1.4426950408889634f;
__device__ __forceinline__ void glds16(const void*gsrc,unsigned lds_dst){unsigned keep;
  asm volatile("s_mov_b32 %0, m0\n\ts_mov_b32 m0, %2\n\ts_nop 0\n\tglobal_load_lds_dwordx4 %1, off\n\ts_mov_b32 m0, %0":"=&s"(keep):"v"(gsrc),"s"(lds_dst):"memory");}
__device__ __forceinline__ float max3f(float a,float b,float c){float r;asm("v_max3_f32 %0, %1, %2, %3":"=v"(r):"v"(a),"v"(b),"v"(c));return r;}
__device__ __forceinline__ float max2f(float a,float b){float r;asm("v_max_f32_e32 %0, %1, %2":"=v"(r):"v"(a),"v"(b));return r;}
__device__ __forceinline__ float fadd_s(float a,float b){float r;asm("v_add_f32_e32 %0, %1, %2":"=v"(r):"v"(a),"v"(b));return r;}
__device__ __forceinline__ float fsub_s(float a,float b){float r;asm("v_sub_f32_e32 %0, %1, %2":"=v"(r):"v"(a),"v"(b));return r;}
typedef float f32x2_t __attribute__((ext_vector_type(2))); typedef __bf16 bf16x2_t __attribute__((ext_vector_type(2)));
__device__ __forceinline__ unsigned cvtpk_s(float lo,float hi){f32x2_t v={lo,hi};bf16x2_t b=__builtin_convertvector(v,bf16x2_t);return __builtin_bit_cast(unsigned,b);}
#define WAIT_BAR(N) asm volatile("s_waitcnt vmcnt(" #N ") lgkmcnt(0)\n\ts_barrier":::"memory")

__device__ __forceinline__ void qkt(f32x16&p0,f32x16&p1,const char*Kslot,const bf16x8*qr,const f32x16&negm,int r32,int hi){
  const char*kb=Kslot+hi*1024+r32*16;
  #pragma unroll
  for(int d0=0;d0<4;++d0){
    const bf16x8 b0=*reinterpret_cast<const bf16x8*>(kb+d0*2048);
    const bf16x8 b1=*reinterpret_cast<const bf16x8*>(kb+d0*2048+512);
    if(d0==0){p0=__builtin_amdgcn_mfma_f32_32x32x16_bf16(b0,qr[0],negm,0,0,0);p1=__builtin_amdgcn_mfma_f32_32x32x16_bf16(b1,qr[0],negm,0,0,0);}
    else{p0=__builtin_amdgcn_mfma_f32_32x32x16_bf16(b0,qr[d0],p0,0,0,0);p1=__builtin_amdgcn_mfma_f32_32x32x16_bf16(b1,qr[d0],p1,0,0,0);}}
}
typedef __attribute__((address_space(3))) const char* lds_cptr;
typedef short v4i16_t __attribute__((ext_vector_type(4)));
__device__ __forceinline__ void kload8(bf16x8*kf,lds_cptr kp){
  kf[0]=*(const __attribute__((address_space(3))) bf16x8*)(kp);      kf[1]=*(const __attribute__((address_space(3))) bf16x8*)(kp+512);
  kf[2]=*(const __attribute__((address_space(3))) bf16x8*)(kp+2048); kf[3]=*(const __attribute__((address_space(3))) bf16x8*)(kp+2560);
  kf[4]=*(const __attribute__((address_space(3))) bf16x8*)(kp+4096); kf[5]=*(const __attribute__((address_space(3))) bf16x8*)(kp+4608);
  kf[6]=*(const __attribute__((address_space(3))) bf16x8*)(kp+6144); kf[7]=*(const __attribute__((address_space(3))) bf16x8*)(kp+6656);
}
__device__ __forceinline__ void kload2(bf16x8*kf,lds_cptr kp,int j){ kf[2*j]=*(const __attribute__((address_space(3))) bf16x8*)(kp+j*2048); kf[2*j+1]=*(const __attribute__((address_space(3))) bf16x8*)(kp+j*2048+512); }
__device__ __forceinline__ s16x4 vtr(lds_cptr p){ return __builtin_bit_cast(s16x4,__builtin_amdgcn_ds_read_tr16_b64_v4i16((__attribute__((address_space(3))) v4i16_t*)p)); }
__device__ __forceinline__ float rowmax(const f32x16&p0,const f32x16&p1){
  float a=max3f(p0[0],p0[1],p1[0]),b=max3f(p0[2],p0[3],p1[1]);a=max3f(a,p1[2],p1[3]);
  #pragma unroll
  for(int r=4;r<16;r+=4){a=max3f(a,p0[r],p0[r+1]);b=max3f(b,p0[r+2],p0[r+3]);a=max3f(a,p1[r],p1[r+1]);b=max3f(b,p1[r+2],p1[r+3]);}
  const float m=max2f(a,b);
  auto rr=__builtin_amdgcn_permlane32_swap(__float_as_uint(m),__float_as_uint(m),false,false);
  return max2f(__uint_as_float(rr[0]),__uint_as_float(rr[1]));
}
__device__ __forceinline__ void pv(f32x16*o,int vb,bf16x8 pa0,bf16x8 pa1,bf16x8 pa2,bf16x8 pa3){
  #pragma unroll
  for(int d0=0;d0<2;++d0){s16x4 lo[4],hi[4];
    #pragma unroll
    for(int ks=0;ks<4;++ks){
      asm volatile("ds_read_b64_tr_b16 %0,%1 offset:%c2":"=&v"(lo[ks]):"v"(vb),"i"(d0*4096+ks*1024):"memory");
      asm volatile("ds_read_b64_tr_b16 %0,%1 offset:%c2":"=&v"(hi[ks]):"v"(vb),"i"(d0*4096+ks*1024+512):"memory");}
    asm volatile("s_waitcnt lgkmcnt(0)":::"memory");SBAR();
    #define PK(k) (bf16x8){lo[k][0],lo[k][1],lo[k][2],lo[k][3],hi[k][0],hi[k][1],hi[k][2],hi[k][3]}
    o[d0]=__builtin_amdgcn_mfma_f32_32x32x16_bf16(pa0,PK(0),o[d0],0,0,0);
    o[d0]=__builtin_amdgcn_mfma_f32_32x32x16_bf16(pa1,PK(1),o[d0],0,0,0);
    o[d0]=__builtin_amdgcn_mfma_f32_32x32x16_bf16(pa2,PK(2),o[d0],0,0,0);
    o[d0]=__builtin_amdgcn_mfma_f32_32x32x16_bf16(pa3,PK(3),o[d0],0,0,0);
    #undef PK
  }
}

#ifndef ATTN_STORE16
#define ATTN_STORE16(p,v) st16_wt((p),(v))
#endif
template<int THRL,bool MASKED> __device__ __forceinline__ void attn_unit(int qb,const bf16*Qb,int QP,const bf16*__restrict__ Kh,int KP,const bf16*__restrict__ Vh,int VP,bf16*Ob,int OP,const unsigned*mwave,char*shm,const int wave_,const int emode=0,const int bsel=0,const float lam=0.f){
  int tidv; asm volatile("v_mbcnt_lo_u32_b32 %0, -1, 0\n\tv_mbcnt_hi_u32_b32 %0, -1, %0":"=v"(tidv)); tidv+=wave_*64;
  const int tid=tidv,lane=tid&63,r32=lane&31,hi=lane>>5; const int wid=__builtin_amdgcn_readfirstlane(tid>>6);
  const int q0=qb*QB;
  const bf16*Qw=Qb+(long)(wid*QBLK)*QP;
  const unsigned lds0=(unsigned)(uintptr_t)shm;
  float*wsf=(float*)(shm+LDS_WS)+wid*64;
  const bf16*ksrc=Kh+(long)lane*KP+wid*8;
  const bf16*vsrc=Vh+(long)(16*(wid&3)+(lane>>2))*VP+(wid>>2)*32+(lane&3)*8;
  const unsigned kdst=lds0+LDS_K+wid*1024, vdst=lds0+LDS_V+wid*1024;
  #define DMA_K(t,slot) glds16(ksrc+(long)(t)*KVBLK*KP,(unsigned)__builtin_amdgcn_readfirstlane(kdst+(slot)))
  #define DMA_V(t,slot) glds16(vsrc+(long)(t)*KVBLK*VP,(unsigned)__builtin_amdgcn_readfirstlane(vdst+(slot)))
  const int vb0=(int)(lds0+LDS_V)+((lane>>4)&1)*32+(lane&3)*8+(4*hi+((lane&15)>>2))*64;
  const char*Kbase=shm+LDS_K; bf16x8 kf[8];
  const lds_cptr shm3=(lds_cptr)shm; const lds_cptr kp0=shm3+LDS_K+hi*1024+r32*16; const lds_cptr vp0=shm3+LDS_V+((lane>>4)&1)*32+(lane&3)*8+(4*hi+((lane&15)>>2))*64;
  const int NT=(q0+QB)/KVBLK;
  const __attribute__((address_space(3))) unsigned* mimg=(const __attribute__((address_space(3))) unsigned*)(shm3+LDS_OST+wid*MWAVE)+r32;
  DMA_K(0,0);DMA_V(0,0);DMA_K(1,SLOTB);
  if constexpr(MASKED){
    __attribute__((address_space(3))) u32x4* mdst=(__attribute__((address_space(3))) u32x4*)(shm3+LDS_OST+wid*MWAVE)+lane;
    for(int i=0;i<=qb;++i){ const u32x4 v=((const u32x4*)mwave)[i*64+lane]; mdst[i*64]=v; }
  }
  bf16x8 qr[4];
  #pragma unroll
  for(int d0=0;d0<4;++d0)qr[d0]=*reinterpret_cast<const bf16x8*>(&Qw[(long)r32*QP+d0*16+hi*8]);
  float mhat=0.f,l_reg=0.f;f32x16 o[2];o[0]=f32x16{};o[1]=f32x16{};f32x16 negm=f32x16{};asm volatile("":"+v"(negm));
  const int qrel=wid*QBLK+r32;
  #define CMASK(P0,P1,t) do{int jb_=(t)-(NT-4); if(jb_>=0)cmask(P0,P1,jb_,qrel,hi);}while(0)
  #define XMASK(P0,P1,t) do{ if constexpr(MASKED){ bmask(P0,P1,mimg[(2*(t))*32],mimg[(2*(t)+1)*32],hi); } else { CMASK(P0,P1,t); } }while(0)
  bool resc=false;
  #define START(P0,P1) do{ const float rm=rowmax(P0,P1); resc=false; \
    { const float dl=MASKED?__builtin_fmaxf(rm,-30.f):rm; mhat=fadd_s(mhat,dl); \
      _Pragma("unroll") for(int r=0;r<16;++r){P0[r]=fsub_s(P0[r],dl);P1[r]=fsub_s(P1[r],dl);} \
      _Pragma("unroll") for(int r=0;r<16;++r)negm[r]=-mhat; asm volatile("":"+v"(negm)); } \
    _Pragma("unroll") for(int r=0;r<16;++r)P0[r]=__builtin_amdgcn_exp2f(P0[r]); }while(0)
  #define RESC() do{ if(resc){ asm volatile("s_waitcnt lgkmcnt(0)":::"memory"); \
      _Pragma("unroll") for(int d_=0;d_<2;++d_) _Pragma("unroll") for(int r=0;r<16;++r)o[d_][r]*=wsf[crow(r,hi)]; } }while(0)
  f32x16 pA0,pA1,pB0,pB1;
  int sl_prev=0,sl_cur=0,sl_next=SLOTB;
  #define ROT() do{sl_prev=sl_cur;sl_cur=sl_next;sl_next=(sl_next==(NSLOT-1)*SLOTB)?0:sl_next+SLOTB;}while(0)
  DMA_K(2,2*SLOTB);
  WAIT_BAR(3);
  qkt(pA0,pA1,Kbase,qr,negm,r32,hi);asm volatile("s_nop 15\n\ts_nop 7":"+v"(pA0),"+v"(pA1));XMASK(pA0,pA1,0);
  START(pA0,pA1);
  _Pragma("unroll") for(int r=0;r<16;++r)pA1[r]=__builtin_amdgcn_exp2f(pA1[r]);
  WAIT_BAR(0);
  DMA_K(3,0);DMA_V(1,SLOTB);
  ROT();
  kload8(kf,kp0+sl_cur);
  WAIT_BAR(2);
  s16x4 vlo[8],vhi[8]; u32x4 pw0,pw1,pw2,pw3;
  #define PKW(P,B) cvtpk_s(P[B],P[B+1])
  #define PAF(k) __builtin_bit_cast(bf16x8,pw##k)
  #define VFR(i) (bf16x8){vlo[i][0],vlo[i][1],vlo[i][2],vlo[i][3],vhi[i][0],vhi[i][1],vhi[i][2],vhi[i][3]}
  #define PIN(x) asm volatile("":"+v"(x))
  #define MX3(a,b,c) __builtin_fmaxf(__builtin_fmaxf((a),(b)),(c))
  #define GAPA(MF,A0,A1,A2,A3,W0,W1,PW) do{ MF; sacc+=A0; sacc+=A1; sacc+=A2; sacc+=A3; PIN(sacc); W0; W1; PIN(PW); SBAR(); }while(0)
  #define EX(v) __builtin_amdgcn_exp2f(v)
  #define GAPB(MF,X,B) do{ MF; X[B]=EX(X[B]); X[B+1]=EX(X[B+1]); X[B+2]=EX(X[B+2]); X[B+3]=EX(X[B+3]); PIN(X); SBAR(); }while(0)
  #define VRD(i) do{ vlo[i]=vtr(vp_+(((i)>>2)*4096+((i)&3)*1024)); vhi[i]=vtr(vp_+(((i)>>2)*4096+((i)&3)*1024+512)); }while(0)
  #define KRD(G,j) do{ if(G){ kload2(kf,kp0+sl_next,j); SBAR(); } }while(0)
  #define STEP(C0,C1,P0,P1,t,GK,GV,GL) do{ SBAR(); \
    const lds_cptr vp_=vp0+sl_prev; \
    VRD(0); SBAR(); float sacc=(P0[0]+P0[1]); \
    GAPA(C0=__builtin_amdgcn_mfma_f32_32x32x16_bf16(kf[0],qr[0],negm,0,0,0), P0[2],P0[3],P0[4],P0[5],     pw0[0]=PKW(P0,0), pw0[1]=PKW(P0,2), pw0); \
    VRD(4); SBAR(); GAPA(C1=__builtin_amdgcn_mfma_f32_32x32x16_bf16(kf[1],qr[0],negm,0,0,0), P0[6],P0[7],P0[8],P0[9],     pw0[2]=PKW(P0,4), pw0[3]=PKW(P0,6), pw0); \
    VRD(1); SBAR(); GAPA(C0=__builtin_amdgcn_mfma_f32_32x32x16_bf16(kf[2],qr[1],C0,0,0,0),   P0[10],P0[11],P0[12],P0[13], pw1[0]=PKW(P0,8), pw1[1]=PKW(P0,10), pw1); \
    VRD(5); SBAR(); GAPA(C1=__builtin_amdgcn_mfma_f32_32x32x16_bf16(kf[3],qr[1],C1,0,0,0),   P0[14],P0[15],P1[0],P1[1],   pw1[2]=PKW(P0,12),pw1[3]=PKW(P0,14), pw1); \
    VRD(2); SBAR(); GAPA(C0=__builtin_amdgcn_mfma_f32_32x32x16_bf16(kf[4],qr[2],C0,0,0,0),   P1[2],P1[3],P1[4],P1[5],     pw2[0]=PKW(P1,0), pw2[1]=PKW(P1,2), pw2); \
    VRD(6); SBAR(); GAPA(C1=__builtin_amdgcn_mfma_f32_32x32x16_bf16(kf[5],qr[2],C1,0,0,0),   P1[6],P1[7],P1[8],P1[9],     pw2[2]=PKW(P1,4), pw2[3]=PKW(P1,6), pw2); \
    VRD(3); SBAR(); GAPA(C0=__builtin_amdgcn_mfma_f32_32x32x16_bf16(kf[6],qr[3],C0,0,0,0),   P1[10],P1[11],P1[12],P1[13], pw3[0]=PKW(P1,8), pw3[1]=PKW(P1,10), pw3); \
    VRD(7); SBAR(); GAPA(C1=__builtin_amdgcn_mfma_f32_32x32x16_bf16(kf[7],qr[3],C1,0,0,0),   P1[14],P1[15],0.f,0.f,       pw3[2]=PKW(P1,12),pw3[3]=PKW(P1,14), pw3); \
    l_reg+=sacc; \
    if(GK){DMA_K((t)+3,sl_cur);} if(GV){DMA_V((t)+1,sl_next);} \
    XMASK(C0,C1,t); \
    { float a=MX3(C0[0],C0[1],C1[0]),b=MX3(C0[2],C0[3],C1[1]); a=MX3(a,C1[2],C1[3]); \
      _Pragma("unroll") for(int r=4;r<16;r+=4){a=MX3(a,C0[r],C0[r+1]);b=MX3(b,C0[r+2],C0[r+3]);a=MX3(a,C1[r],C1[r+1]);b=MX3(b,C1[r+2],C1[r+3]);} \
      float rm=__builtin_fmaxf(a,b); { auto rr=__builtin_amdgcn_permlane32_swap(__float_as_uint(rm),__float_as_uint(rm),false,false); rm=__builtin_fmaxf(__uint_as_float(rr[0]),__uint_as_float(rr[1])); } \
      resc=false; \
      if(__builtin_expect(__any(rm>(float)THRL),0)){ const float dl=__builtin_fmaxf(rm,0.f); mhat+=dl; \
        _Pragma("unroll") for(int r=0;r<16;++r){C0[r]-=dl;C1[r]-=dl;} \
        _Pragma("unroll") for(int r=0;r<16;++r)negm[r]=-mhat; asm volatile("":"+v"(negm)); \
        const float f=__builtin_amdgcn_exp2f(-dl); l_reg*=f; if(hi==0)wsf[r32]=f; resc=true; } } \
    SBAR(); \
    GAPB(o[0]=__builtin_amdgcn_mfma_f32_32x32x16_bf16(PAF(0),VFR(0),o[0],0,0,0), C0,0); \
    GAPB(o[1]=__builtin_amdgcn_mfma_f32_32x32x16_bf16(PAF(0),VFR(4),o[1],0,0,0), C0,4); \
    KRD(GL,0); GAPB(o[0]=__builtin_amdgcn_mfma_f32_32x32x16_bf16(PAF(1),VFR(1),o[0],0,0,0), C0,8); \
    KRD(GL,1); GAPB(o[1]=__builtin_amdgcn_mfma_f32_32x32x16_bf16(PAF(1),VFR(5),o[1],0,0,0), C0,12); \
    KRD(GL,2); GAPB(o[0]=__builtin_amdgcn_mfma_f32_32x32x16_bf16(PAF(2),VFR(2),o[0],0,0,0), C1,0); \
    KRD(GL,3); GAPB(o[1]=__builtin_amdgcn_mfma_f32_32x32x16_bf16(PAF(2),VFR(6),o[1],0,0,0), C1,4); \
    GAPB(o[0]=__builtin_amdgcn_mfma_f32_32x32x16_bf16(PAF(3),VFR(3),o[0],0,0,0), C1,8); \
    GAPB(o[1]=__builtin_amdgcn_mfma_f32_32x32x16_bf16(PAF(3),VFR(7),o[1],0,0,0), C1,12); \
    }while(0)
  int t=1;
  #undef CMASK
  #define CMASK(P0,P1,t) do{}while(0)
  for(;t+5<NT;t+=2){
    STEP(pB0,pB1,pA0,pA1,t,true,true,true);     WAIT_BAR(2); RESC(); ROT();
    STEP(pA0,pA1,pB0,pB1,t+1,true,true,true);   WAIT_BAR(2); RESC(); ROT();
  }
  #undef CMASK
  #define CMASK(P0,P1,t) do{int jb_=(t)-(NT-4); if(jb_>=0)cmask(P0,P1,jb_,qrel,hi);}while(0)
  #define ENDW(tt) do{ if((tt)+3<NT){WAIT_BAR(2);} else if((tt)+2<NT){WAIT_BAR(1);} else {WAIT_BAR(0);} }while(0)
  for(;t+1<NT;t+=2){
    STEP(pB0,pB1,pA0,pA1,t,(t+3<NT),(t+1<NT),(t+1<NT));       ENDW(t);   RESC(); ROT();
    STEP(pA0,pA1,pB0,pB1,t+1,(t+4<NT),(t+2<NT),(t+2<NT));     ENDW(t+1); RESC(); ROT();
  }
  STEP(pB0,pB1,pA0,pA1,NT-1,false,false,false); RESC();
  { float sacc=pB0[0]+pB0[1]; _Pragma("unroll") for(int r=2;r<16;++r)sacc+=pB0[r]; _Pragma("unroll") for(int r=0;r<16;++r)sacc+=pB1[r]; l_reg+=sacc;
    pw0=(u32x4){PKW(pB0,0),PKW(pB0,2),PKW(pB0,4),PKW(pB0,6)};pw1=(u32x4){PKW(pB0,8),PKW(pB0,10),PKW(pB0,12),PKW(pB0,14)};pw2=(u32x4){PKW(pB1,0),PKW(pB1,2),PKW(pB1,4),PKW(pB1,6)};pw3=(u32x4){PKW(pB1,8),PKW(pB1,10),PKW(pB1,12),PKW(pB1,14)};
    SBAR(); pv(o,vb0+sl_cur,PAF(0),PAF(1),PAF(2),PAF(3)); }
  #undef PKW
  #undef PAF
  #undef VFR
  #undef PIN
  #undef MX3
  #undef GAPA
  #undef GAPB
  #undef EX
  #undef VRD
  #undef KRD
  #undef STEP
  #undef ENDW
  {auto rr=__builtin_amdgcn_permlane32_swap(__float_as_uint(l_reg),__float_as_uint(l_reg),false,false);l_reg=__uint_as_float(rr[0])+__uint_as_float(rr[1]);}
  if(hi==0)wsf[32+r32]=l_reg;asm volatile("s_waitcnt lgkmcnt(0)":::"memory");
  float rli[16];
  #pragma unroll
  for(int r=0;r<16;++r)rli[r]=__builtin_amdgcn_rcpf(wsf[32+crow(r,hi)]);
  bf16*Ow=Ob+(long)(wid*QBLK)*OP;
  { bf16*stg=(bf16*)(shm+LDS_OST+wid*MWAVE);
    bf16*stl=stg+bsel*2048+hi*256+r32;
    if(emode>=2){
      #pragma unroll
      for(int r=0;r<16;++r){
        #pragma unroll
        for(int d0=0;d0<2;++d0){ const float old=__uint_as_float((unsigned)stl[cr0(r)*64+d0*32]<<16); stl[cr0(r)*64+d0*32]=(bf16)(cvtpk_s(old-lam*(o[d0][r]*rli[r]),0.f)&0xffffu);} }
    } else {
      #pragma unroll
      for(int r=0;r<16;++r){
        #pragma unroll
        for(int d0=0;d0<2;++d0)stl[cr0(r)*64+d0*32]=(bf16)(cvtpk_s(o[d0][r]*rli[r],0.f)&0xffffu);}
    }
    asm volatile("s_waitcnt lgkmcnt(0)":::"memory");
    if(emode==0){
      #pragma unroll
      for(int i=0;i<4;++i){const int row=i*8+(lane>>3),ch=lane&7; const u32x4 v=*(const u32x4*)(stg+row*64+ch*8); ATTN_STORE16(Ow+(long)row*OP+ch*8,v);}
    } else if(emode==3){
      #pragma unroll
      for(int i=0;i<4;++i){const int row=i*8+(lane>>3),ch=lane&7;
        const u32x4 v0=*(const u32x4*)(stg+row*64+ch*8), v1=*(const u32x4*)(stg+2048+row*64+ch*8);
        float f[16]; float ss=0.f;
        #pragma unroll
        for(int j=0;j<4;++j){ f[2*j]=__uint_as_float(v0[j]<<16); f[2*j+1]=__uint_as_float(v0[j]&0xffff0000u); f[8+2*j]=__uint_as_float(v1[j]<<16); f[8+2*j+1]=__uint_as_float(v1[j]&0xffff0000u); }
        #pragma unroll
        for(int j=0;j<16;++j)ss+=f[j]*f[j];
        ss+=__shfl_xor(ss,1); ss+=__shfl_xor(ss,2); ss+=__shfl_xor(ss,4);
        const float rn=__builtin_amdgcn_rsqf(ss*(1.f/128.f)+1e-6f)*0.8f;
        u32x4 w0,w1;
        #pragma unroll
        for(int j=0;j<4;++j){ w0[j]=cvtpk_s(f[2*j]*rn,f[2*j+1]*rn); w1[j]=cvtpk_s(f[8+2*j]*rn,f[8+2*j+1]*rn); }
        ATTN_STORE16(Ow+(long)row*OP+ch*8,w0); ATTN_STORE16(Ow+(long)row*OP+64+ch*8,w1);}
    }
  }
  asm volatile("s_waitcnt lgkmcnt(0)\n\ts_barrier":::"memory");
  #undef DMA_K
  #undef DMA_V
  #undef CMASK
  #undef XMASK
  #undef START
  #undef RESC
  #undef ROT
}
constexpr int ATTN_LDS_BYTES=LDS_BYTES;
#undef SBAR
#undef WAIT_BAR
}
namespace idx {
typedef short bf16x8 __attribute__((ext_vector_type(8)));
typedef float f32x16 __attribute__((ext_vector_type(16)));
constexpr int QROW = 528, IMG_LO = 32 * QROW, TROW = 1025, KBUF_OFF = 36864;
constexpr int CW_QUEUE = 64;
constexpr unsigned T0 = 0x80000000u;
__device__ __forceinline__ constexpr int cr0(int r) { return (r & 3) + 8 * (r >> 2); }
__device__ __forceinline__ unsigned fkey(float f) { const unsigned u = __float_as_uint(f); return (u & 0x80000000u) ? ~u : (u | 0x80000000u); }
__device__ __forceinline__ float kval(unsigned k) { return __uint_as_float((k & 0x80000000u) ? (k & 0x7fffffffu) : ~k); }
__device__ __forceinline__ unsigned dpp_shr(unsigned v, int n) {
    const int iv = (int)v; int r;
    switch (n) { case 1: r = __builtin_amdgcn_update_dpp(0, iv, 0x111, 0xf, 0xf, true); break; case 2: r = __builtin_amdgcn_update_dpp(0, iv, 0x112, 0xf, 0xf, true); break;
                 case 4: r = __builtin_amdgcn_update_dpp(0, iv, 0x114, 0xf, 0xf, true); break; default: r = __builtin_amdgcn_update_dpp(0, iv, 0x118, 0xf, 0xf, true); break; }
    return (unsigned)r;
}
__device__ __forceinline__ unsigned wsum(unsigned v) {
    v += dpp_shr(v, 1); v += dpp_shr(v, 2); v += dpp_shr(v, 4); v += dpp_shr(v, 8);
    v += (unsigned)__builtin_amdgcn_update_dpp(0, (int)v, 0x142, 0xa, 0xf, false);
    v += (unsigned)__builtin_amdgcn_update_dpp(0, (int)v, 0x143, 0xc, 0xf, false);
    return (unsigned)__builtin_amdgcn_readlane((int)v, 63);
}
__device__ __forceinline__ unsigned umax2(unsigned a, unsigned b) { return a > b ? a : b; }
__device__ __forceinline__ unsigned wmaxu(unsigned v) {
    v = umax2(v, dpp_shr(v, 1)); v = umax2(v, dpp_shr(v, 2)); v = umax2(v, dpp_shr(v, 4)); v = umax2(v, dpp_shr(v, 8));
    v = umax2(v, (unsigned)__builtin_amdgcn_update_dpp(0, (int)v, 0x142, 0xa, 0xf, false));
    v = umax2(v, (unsigned)__builtin_amdgcn_update_dpp(0, (int)v, 0x143, 0xc, 0xf, false));
    return (unsigned)__builtin_amdgcn_readlane((int)v, 63);
}
__device__ __forceinline__ unsigned wminu(unsigned v) { return ~wmaxu(~v); }
#define IDX_COUNT_GE(K, T, NR, OUT) do { unsigned w_ = 0xffffffffu; _Pragma("unroll") for (int i_ = 0; i_ < 32; ++i_) if (i_ < (NR)) w_ = __builtin_amdgcn_alignbit(w_, (K)[i_] - (T), 31); (OUT) = 32u - (unsigned)__builtin_popcount(w_); } while (0)

__device__ __forceinline__ void run(Frame& F, int qword) {
    const int wid = F.wave;
    LAS unsigned char* lds = F.lds;
    unsigned* qctr = (unsigned*)(F.ws + WS_CTL) + qword;
    volatile LAS unsigned* uw = (volatile LAS unsigned*)(F.lds + MISC_OFF) + 20;
    const bf16* QIH = WSP(bf16, WS_QIH); const bf16* KIH = WSP(bf16, WS_KIH);
    const float* WI = WSP(float, WS_WI); unsigned* MASK = WSP(unsigned, WS_MASK);
    LAS unsigned* TR = (LAS unsigned*)lds;
    for (;;) {
        __syncthreads();
        if (wid == 0 && lane_now() == 0) *uw = __hip_atomic_fetch_add(qctr, 1u, __ATOMIC_RELAXED, __HIP_MEMORY_SCOPE_AGENT);
        __syncthreads();
        const unsigned un = __builtin_amdgcn_readfirstlane(*uw);
        if (un >= 1024u) break;
        int b, qg;
        if (un < 896u) { qg = 63 - (int)(un >> 4); b = (int)(un & 15u); } else { qg = (int)((un - 896u) >> 4); b = (int)(un & 15u); }
        int lane = lane_now(); asm volatile("" : "+v"(lane));
        const int r32 = lane & 31, hi = lane >> 5;
        const int tid = wid * 64 + lane;
        int widv = wid; asm volatile("" : "+s"(widv));
        const int unit = b * 64 + qg;
        const size_t tok0 = (size_t)b * SEQ + 32 * qg;
        unsigned* mrow = MASK + (size_t)unit * 2048;
        const int ktmax = qg | 7;
        if (qg < 8) {
#pragma unroll
            for (int i = 0; i < 8; ++i) { const int kt = widv + 8 * i; if (kt <= ktmax && hi == 0) mrow[kt * 32 + r32] = kt < qg ? 0xffffffffu : (kt == qg ? ((2u << r32) - 1u) : 0u); }
            continue;
        }
#pragma unroll
        for (int it = 0; it < 2; ++it) { const int rem = tid + 512 * it, row = rem >> 5, ch = rem & 31;
            const v4u v = *(const v4u*)(QIH + (tok0 + row) * 256 + ch * 8);
            *(LAS v4u*)(lds + row * QROW + ch * 16) = v; }
        const f32x4 w4 = *(const f32x4*)(WI + (tok0 + r32) * 4);
        __syncthreads();
        unsigned sc[8][16];
        const bf16* kbh = KIH + ((size_t)b * SEQ + r32) * 64 + hi * 8;
        const LAS unsigned char* kbuf = lds + KBUF_OFF + wid * 8192 + lane * 16;
        const unsigned kdst = (unsigned)(uintptr_t)(lds + KBUF_OFF + wid * 8192);
#define IDX_DMA_K(zo) do { _Pragma("unroll") for (int d0_ = 0; d0_ < 4; ++d0_) attn_body::glds16(kbh + (zo) + d0_ * 16, (unsigned)__builtin_amdgcn_readfirstlane(kdst + d0_ * 1024)); } while (0)
        if (widv <= qg) { int zoff = widv * 2048; asm volatile("" : "+v"(zoff)); IDX_DMA_K(zoff); }
        const int cl = r32 - 4 * hi;
        const LAS unsigned char* qimg = lds + r32 * QROW + hi * 16;
#pragma unroll
        for (int i = 0; i < 8; ++i) {
            const int kt = widv + 8 * i;
            if (kt <= qg) {
                bf16x8 kh[4];
                asm volatile("s_waitcnt vmcnt(0)" ::: "memory");
#pragma unroll
                for (int d0 = 0; d0 < 4; ++d0) kh[d0] = *(const LAS bf16x8*)(kbuf + d0 * 1024);
                asm volatile("s_waitcnt lgkmcnt(0)" ::: "memory");
                if (kt + 8 <= qg) { int zoff = (kt + 8) * 2048; asm volatile("" : "+v"(zoff)); IDX_DMA_K(zoff); }
                float s[16];
#pragma unroll
                for (int h = 0; h < 4; ++h) {
                    f32x16 acc = {};
#pragma unroll
                    for (int d0 = 0; d0 < 4; ++d0) {
                        const bf16x8 qh = *(const LAS bf16x8*)(qimg + (h * 64 + d0 * 16) * 2);
                        acc = __builtin_amdgcn_mfma_f32_32x32x16_bf16(kh[d0], qh, acc, 0, 0, 0);
                    }
                    const float wh = w4[h];
#pragma unroll
                    for (int r = 0; r < 16; ++r) { const float t = wh * (acc[r] > 0.f ? acc[r] : 0.f); s[r] = (h == 0) ? t : s[r] + t; }
                    if (h == 1) { asm volatile("" ::: "memory"); __builtin_amdgcn_sched_barrier(0); }
                }
#pragma unroll
                for (int r = 0; r < 16; ++r) { unsigned k = fkey(s[r]); if (kt == qg && cr0(r) > cl) k = 0u; sc[i][r] = k; }
                asm volatile("" ::: "memory"); __builtin_amdgcn_sched_barrier(0);
            } else {
#pragma unroll
                for (int r = 0; r < 16; ++r) sc[i][r] = 0u;
            }
        }
        unsigned kq[4][32];
        LAS unsigned* twr = TR + r32 * TROW + 4 * hi;
        const LAS unsigned* trd = TR + (4 * wid) * TROW + lane;
        __syncthreads();
#pragma unroll
        for (int i = 0; i < 4; ++i) { const int kt = widv + 8 * i; LAS unsigned* p = twr + kt * 32;
#pragma unroll
            for (int r = 0; r < 16; ++r) p[cr0(r)] = sc[i][r]; }
        __syncthreads();
#pragma unroll
        for (int j = 0; j < 4; ++j)
#pragma unroll
            for (int i = 0; i < 16; ++i) kq[j][i] = trd[j * TROW + 64 * i];
        const bool upper = qg >= 32;
        if (upper) {
            __syncthreads();
#pragma unroll
            for (int i = 4; i < 8; ++i) { const int kt = widv + 8 * (i - 4); LAS unsigned* p = twr + kt * 32;
#pragma unroll
                for (int r = 0; r < 16; ++r) p[cr0(r)] = sc[i][r]; }
            __syncthreads();
#pragma unroll
            for (int j = 0; j < 4; ++j)
#pragma unroll
                for (int i = 0; i < 16; ++i) kq[j][16 + i] = trd[j * TROW + 64 * i];
        } else {
#pragma unroll
            for (int j = 0; j < 4; ++j)
#pragma unroll
                for (int i = 0; i < 16; ++i) kq[j][16 + i] = 0u;
        }
        const int nr = (((32 * qg + 31) / 64 + 1) + 7) & ~7;
        unsigned P[4], nt[4], qa[4], qb[4], qcb[4]; float fa[4], fb[4]; int side[4]; bool act[4];
        {
        {
            unsigned c0[4], c1[4];
#pragma unroll
            for (int j = 0; j < 4; ++j) {
                unsigned w0 = 0u, w1 = 0xffffffffu;
#pragma unroll
                for (int ib = 0; ib < 32; ib += 8) if (ib < nr) {
#pragma unroll
                    for (int i = ib; i < ib + 8; ++i) { w0 = __builtin_amdgcn_alignbit(w0, kq[j][i], 31); w1 = __builtin_amdgcn_alignbit(w1, umax2(kq[j][i], T0) - (T0 + 1u), 31); } }
                c0[j] = (unsigned)__builtin_popcount(w0); c1[j] = 32u - (unsigned)__builtin_popcount(w1);
            }
#pragma unroll
            for (int j = 0; j < 4; ++j) { c0[j] = wsum(c0[j]); c1[j] = wsum(c1[j]); }
#pragma unroll
            for (int j = 0; j < 4; ++j) {
                const int nk = 32 * qg + 4 * wid + j + 1;
                P[j] = 0u; nt[j] = 0u; act[j] = false; qa[j] = 0u; qb[j] = 0u; qcb[j] = 0u; fa[j] = 1.f; fb[j] = -1.f; side[j] = 0;
                if (c1[j] == 256u) { P[j] = T0; }
                else if (c0[j] == 256u) { P[j] = T0 - 1u; }
                else if (c0[j] > 256u && c1[j] < 256u) { P[j] = T0; nt[j] = 256u - c1[j]; }
                else if (c1[j] > 256u) { unsigned m = 0u;
#pragma unroll
                    for (int ib = 0; ib < 32; ib += 8) if (ib < nr) {
#pragma unroll
                        for (int i = ib; i < ib + 8; ++i) { kq[j][i] = umax2(kq[j][i], T0); m = umax2(m, kq[j][i]); } }
                    qa[j] = T0 + 1u; qb[j] = wmaxu(m) + 1u; qcb[j] = 0u; fa[j] = (float)(c1[j] - 256u); fb[j] = -256.f; act[j] = true; }
                else { unsigned m = 0u;
#pragma unroll
                    for (int ib = 0; ib < 32; ib += 8) if (ib < nr) {
#pragma unroll
                        for (int i = ib; i < ib + 8; ++i) { m = umax2(m, ~(kq[j][i] - 1u)); kq[j][i] = kq[j][i] < T0 ? kq[j][i] : T0; } }
                    qa[j] = ~wmaxu(m) + 1u; qb[j] = T0; qcb[j] = c0[j]; fa[j] = (float)((unsigned)nk - 256u); fb[j] = -(float)(256u - c0[j]); act[j] = true; }
            }
        }
        {
#define IDX_SEL4(x) (lane == 0 ? (x)[0] : lane == 1 ? (x)[1] : lane == 2 ? (x)[2] : (x)[3])
            bool actl = lane < 4 && IDX_SEL4(act);
            unsigned al = IDX_SEL4(qa), bl = IDX_SEL4(qb), cbl = IDX_SEL4(qcb), Pl = IDX_SEL4(P), ntl = IDX_SEL4(nt);
            float fal = IDX_SEL4(fa), fbl = IDX_SEL4(fb); int sidel = 0;
            for (int it = 0; it < 80; ++it) {
                if (!__any(actl)) break;
                if (actl && bl - al <= 1u) { Pl = al; ntl = 256u - cbl; actl = false; }
                unsigned tl = 0xffffffffu;
                if (actl) {
                    const float va = kval(al), vb = kval(bl - 1u);
                    unsigned tt = fkey(va + (vb - va) * (fal / (fal - fbl)));
                    if (it >= 40) tt = al + ((bl - al) >> 1);
                    tt = tt <= al ? al + 1u : tt; tt = tt >= bl ? bl - 1u : tt;
                    tl = tt;
                }
                const unsigned t0 = (unsigned)__builtin_amdgcn_readlane((int)tl, 0), t1 = (unsigned)__builtin_amdgcn_readlane((int)tl, 1), t2 = (unsigned)__builtin_amdgcn_readlane((int)tl, 2), t3 = (unsigned)__builtin_amdgcn_readlane((int)tl, 3);
                unsigned w0 = 0xffffffffu, w1 = w0, w2 = w0, w3 = w0;
#define IDX_STEP(i_) do { w0 = __builtin_amdgcn_alignbit(w0, kq[0][i_] - t0, 31); w1 = __builtin_amdgcn_alignbit(w1, kq[1][i_] - t1, 31); \
                          w2 = __builtin_amdgcn_alignbit(w2, kq[2][i_] - t2, 31); w3 = __builtin_amdgcn_alignbit(w3, kq[3][i_] - t3, 31); } while (0)
#pragma unroll
                for (int i = 0; i < 8; ++i) IDX_STEP(i);
                if (nr > 8) {
#pragma unroll
                    for (int i = 8; i < 16; ++i) IDX_STEP(i);
                    if (nr > 16) {
#pragma unroll
                        for (int i = 16; i < 24; ++i) IDX_STEP(i);
                        if (nr > 24) {
#pragma unroll
                            for (int i = 24; i < 32; ++i) IDX_STEP(i);
                        }
                    }
                }
#undef IDX_STEP
                unsigned c[4] = {32u - (unsigned)__builtin_popcount(w0), 32u - (unsigned)__builtin_popcount(w1), 32u - (unsigned)__builtin_popcount(w2), 32u - (unsigned)__builtin_popcount(w3)};
#pragma unroll
                for (int st = 1; st <= 8; st <<= 1) {
#pragma unroll
                    for (int j = 0; j < 4; ++j) c[j] += dpp_shr(c[j], st);
                }
#pragma unroll
                for (int j = 0; j < 4; ++j) c[j] += (unsigned)__builtin_amdgcn_update_dpp(0, (int)c[j], 0x142, 0xa, 0xf, false);
#pragma unroll
                for (int j = 0; j < 4; ++j) c[j] += (unsigned)__builtin_amdgcn_update_dpp(0, (int)c[j], 0x143, 0xc, 0xf, false);
#pragma unroll
                for (int j = 0; j < 4; ++j) c[j] = (unsigned)__builtin_amdgcn_readlane((int)c[j], 63);
                const unsigned cl = IDX_SEL4(c);
                if (actl) {
                    if (cl == 256u) { Pl = tl - 1u; actl = false; }
                    else if (cl > 256u) { al = tl; fal = (float)(cl - 256u); if (sidel == 1) fbl *= 0.5f; sidel = 1; }
                    else { bl = tl; cbl = cl; fbl = -(float)(256u - cl); if (sidel == -1) fal *= 0.5f; sidel = -1; }
                }
            }
#pragma unroll
            for (int j = 0; j < 4; ++j) { P[j] = (unsigned)__builtin_amdgcn_readlane((int)Pl, j); nt[j] = (unsigned)__builtin_amdgcn_readlane((int)ntl, j); }
#undef IDX_SEL4
        }
        asm volatile("" ::: "memory");
        }
#pragma unroll
        for (int j = 0; j < 4; ++j) {
            unsigned wv = 0u; unsigned rem = nt[j]; const unsigned Pj = P[j];
            const int ni = 4 * ((qg >> 3) + 1);
#define IDX_WL(i_, m_) do { const unsigned mlo = __builtin_amdgcn_readfirstlane((unsigned)(m_)), mhi = __builtin_amdgcn_readfirstlane((unsigned)((m_) >> 32)); \
                            asm volatile("s_nop 3\n\tv_writelane_b32 %0, %1, %3\n\tv_writelane_b32 %0, %2, %4" : "+v"(wv) : "s"(mlo), "s"(mhi), "n"(2 * (i_)), "n"(2 * (i_) + 1)); } while (0)
            if (nt[j] == 0u) {
#pragma unroll
                for (int ib = 0; ib < 32; ib += 4) if (ib < ni) {
#pragma unroll
                    for (int i = ib; i < ib + 4; ++i) { const unsigned long long m = __ballot(kq[j][i] > Pj); IDX_WL(i, m); } }
            } else {
#pragma unroll
                for (int ib = 0; ib < 32; ib += 4) if (ib < ni) {
#pragma unroll
                    for (int i = ib; i < ib + 4; ++i) {
                        unsigned long long m = __ballot(kq[j][i] > Pj);
                        const unsigned long long e = __ballot(kq[j][i] == Pj); const unsigned pre = __builtin_amdgcn_mbcnt_hi((unsigned)(e >> 32), __builtin_amdgcn_mbcnt_lo((unsigned)e, 0u));
                        m |= __ballot(kq[j][i] == Pj && pre < rem); const unsigned ne = (unsigned)__popcll(e); rem = rem > ne ? rem - ne : 0u;
                        IDX_WL(i, m); } }
            }
#undef IDX_WL
            if (lane <= ktmax) mrow[lane * 32 + 4 * wid + j] = wv;
        }
    }
}
#undef IDX_COUNT_GE
#undef IDX_DMA_K
}
constexpr size_t WS_OD = WS_A2 + 2048;
namespace p3 {
constexpr int CW_QUEUE = 128;
constexpr int NUNITS = 1024 + 512;
__device__ __forceinline__ void decode(unsigned un, bool& dsa, int& b, int& h, int& qb) {
    if (un < 384u) { dsa = false; qb = 7 - (int)(un >> 6); const unsigned r = un & 63u; b = (int)(r >> 2); h = (int)(r & 3u); return; }
    un -= 384u;
    if (un < 192u) { if (un < 64u) { dsa = false; qb = 1; b = (int)(un >> 2); h = (int)(un & 3u); } else { un -= 64u; dsa = true; qb = 7; b = (int)(un >> 3); h = (int)(un & 7u); } return; }
    un -= 192u;
    if (un < 384u) { dsa = true; qb = 6 - (int)(un >> 7); const unsigned r = un & 127u; b = (int)(r >> 3); h = (int)(r & 7u); return; }
    un -= 384u;
    if (un < 192u) { if (un < 64u) { dsa = false; qb = 0; b = (int)(un >> 2); h = (int)(un & 3u); } else { un -= 64u; dsa = true; qb = 3; b = (int)(un >> 3); h = (int)(un & 7u); } return; }
    un -= 192u;
    dsa = true; qb = 2 - (int)(un >> 7); const unsigned r = un & 127u; b = (int)(r >> 3); h = (int)(r & 7u);
}
__device__ __forceinline__ void run(Frame& F, int qword) {
    unsigned* qctr = (unsigned*)(F.ws + WS_CTL) + qword;
    volatile LAS unsigned* uw = (volatile LAS unsigned*)(F.lds + MISC_OFF) + 16;
    char* shm = (char*)F.lds;
    const bf16* QA = WSP(bf16, WS_QA); const bf16* KA = WSP(bf16, WS_KA); const bf16* VA = WSP(bf16, WS_VA);
    const bf16* QB = WSP(bf16, WS_QB); const bf16* KB = WSP(bf16, WS_KB); const bf16* VB = WSP(bf16, WS_VB);
    bf16* ATT = WSP(bf16, WS_ATT); const unsigned* MASK = WSP(unsigned, WS_MASK);
    const float lam = *WSP(float, WS_LAM);
    const unsigned nstat = (unsigned)F.G < (unsigned)NUNITS ? 1u : 0u;
    for (unsigned it = 0;; ++it) {
        unsigned un;
        if (it < nstat) un = blockIdx.x;
        else {
            __syncthreads();
            if ((F.wave * 64 + lane_now()) == 0) *uw = nstat * (unsigned)F.G + __hip_atomic_fetch_add(qctr, 1u, __ATOMIC_RELAXED, __HIP_MEMORY_SCOPE_AGENT);
            __syncthreads();
            un = __builtin_amdgcn_readfirstlane(*uw);
        }
        if (un >= (unsigned)NUNITS) break;
        bool dsa; int b, h, qb; decode(un, dsa, b, h, qb);
        const size_t r0 = (size_t)b * SEQ, rq = r0 + qb * 256;
        if (dsa) {
            attn_body::attn_unit<8, true>(qb, QA + rq * 512 + h * 64, 512, KA + r0 * 64, 64, VA + r0 * 64, 64, ATT + rq * 1024 + h * 64, 1024,
                                          MASK + (size_t)(b * 64 + qb * 8 + F.wave) * 2048, shm, F.wave);
        } else {
            for (int sp = 0; sp < 4; ++sp) {
                const int c = sp & 1, vh = sp >> 1;
                attn_body::attn_unit<8, false>(qb, QB + rq * 512 + (h * 2 + c) * 64, 512, KB + r0 * 512 + (h * 2 + c) * 64, 512, VB + r0 * 512 + h * 128 + vh * 64, 512,
                                               ATT + rq * 1024 + 512 + h * 128, 1024, nullptr, shm, F.wave, sp == 0 || sp == 2 ? 1 : (sp == 1 ? 2 : 3), vh, lam);
            }
        }
    }
}
}
namespace pg8 {
#define PG8_XBAR() do { asm volatile("s_waitcnt lgkmcnt(0)" ::: "memory"); __builtin_amdgcn_s_barrier(); asm volatile("" ::: "memory"); } while (0)
constexpr float XQ_SCALE = 0.0625f * 1.4426950408889634f;
__device__ __forceinline__ float rs16(const float* ss, int row) {
    const f32x4 a = *(const f32x4*)(ss + (size_t)row * 4);
    return rsqrtf(((a[0] + a[1]) + (a[2] + a[3])) * (1.f / 1024.f) + EPS);
}
struct EpiMemKV {
    static constexpr bool PERM = true, AFTER_DRAIN = false;
    bf16_t* KX; bf16_t* VXT; const float* rsm; const float* g_xk; PG8_LAS float* X;
    __device__ __forceinline__ void operator()(const f32x4 (&acc)[2][2][4][2], const Unit& u, int wr, int wc, int fr, int fq) const {
        PG8_LAS float* const xw = X + (wr * 64 + fr) * 4 + wc; const PG8_LAS float* const xr = X + (wr * 64 + fr) * 4;
        const int pn = u.pn, cl0 = wc * 32 + 8 * fq;
        if (pn < 4) {
#pragma unroll
            for (int ai = 0; ai < 2; ++ai)
#pragma unroll
                for (int m = 0; m < 4; ++m) {
                    const int rt = ai * HALF + wr * 64 + m * 16 + fr; const float r = rsm[u.pm * BM + rt];
                    float ss = ((sq4(acc[ai][0][m][0]) + sq4(acc[ai][0][m][1])) + (sq4(acc[ai][1][m][0]) + sq4(acc[ai][1][m][1]))) * (r * r);
                    ss += __shfl_xor(ss, 16); ss += __shfl_xor(ss, 32);
                    if (fq == 0) xw[(ai * HALF + m * 16) * 4] = ss;
                }
            PG8_XBAR();
            const f32x4 g00 = *(const f32x4*)(g_xk + cl0), g01 = *(const f32x4*)(g_xk + cl0 + 4), g10 = *(const f32x4*)(g_xk + 128 + cl0), g11 = *(const f32x4*)(g_xk + 128 + cl0 + 4);
#pragma unroll
            for (int ai = 0; ai < 2; ++ai)
#pragma unroll
                for (int m = 0; m < 4; ++m) {
                    const int rt = ai * HALF + wr * 64 + m * 16 + fr, row = u.pm * BM + rt; const float r = rsm[row];
                    const f32x4 p = *(const PG8_LAS f32x4*)(xr + (ai * HALF + m * 16) * 4);
                    const float sc = r * rsqrtf(((p[0] + p[1]) + (p[2] + p[3])) * (1.f / 256.f) + EPS);
                    bf16_t* d = KX + (size_t)row * 1024 + pn * 256 + cl0;
                    st16_wt(d, pack8(acc[ai][0][m][0] * sc * g00, acc[ai][0][m][1] * sc * g01));
                    st16_wt((d + 128), pack8(acc[ai][1][m][0] * sc * g10, acc[ai][1][m][1] * sc * g11));
                }
        } else {
#pragma unroll
            for (int ai = 0; ai < 2; ++ai)
#pragma unroll
                for (int m = 0; m < 4; ++m) {
                    const int rt = ai * HALF + wr * 64 + m * 16 + fr, row = u.pm * BM + rt; const float r = rsm[row];
                    bf16_t* d = VXT + (size_t)row * 1024 + (pn - 4) * 256 + cl0;
                    st16_wt(d, pack8(acc[ai][0][m][0] * r, acc[ai][0][m][1] * r));
                    st16_wt((d + 128), pack8(acc[ai][1][m][0] * r, acc[ai][1][m][1] * r));
                }
        }
    }
};
__device__ __forceinline__ void unpack8(const u32x4 w, f32x4& a, f32x4& b) {
    a = (f32x4){__uint_as_float(w.x << 16), __uint_as_float(w.x & 0xffff0000u), __uint_as_float(w.y << 16), __uint_as_float(w.y & 0xffff0000u)};
    b = (f32x4){__uint_as_float(w.z << 16), __uint_as_float(w.z & 0xffff0000u), __uint_as_float(w.w << 16), __uint_as_float(w.w & 0xffff0000u)};
}
template <bool BASE_BF16> struct EpiRes {
    static constexpr bool PERM = true, AFTER_DRAIN = false;
    const void* base; int base_ld; bf16_t* hb; int hb_ld; float* ss; PG8_LAS float* X;
    __device__ __forceinline__ void operator()(const f32x4 (&acc)[2][2][4][2], const Unit& u, int wr, int wc, int fr, int fq) const {
        const int col0 = u.pn * BM + wc * 32 + 8 * fq;
        PG8_LAS float* const xw = X + (wr * 64 + fr) * 4 + wc; const PG8_LAS float* const xr = X + (wr * 64 + fr) * 4;
#pragma unroll
        for (int ai = 0; ai < 2; ++ai)
#pragma unroll
            for (int m = 0; m < 4; ++m) {
                const int row = u.pm * BM + ai * HALF + wr * 64 + m * 16 + fr; const size_t off = (size_t)row * 1024 + col0;
                float s = 0.f;
#pragma unroll
                for (int bj = 0; bj < 2; ++bj) {
                    f32x4 b0, b1;
                    const size_t boff = (size_t)row * base_ld + col0 + bj * HALF;
                    if (BASE_BF16) unpack8(*(const u32x4*)((const bf16_t*)base + boff), b0, b1);
                    else { b0 = *(const f32x4*)((const float*)base + boff); b1 = *(const f32x4*)((const float*)base + boff + 4); }
                    const f32x4 h0 = b0 + acc[ai][bj][m][0], h1 = b1 + acc[ai][bj][m][1];
                    st16_wt((hb + (size_t)row * hb_ld + col0 + bj * HALF), pack8(h0, h1));
                    s += sq4(h0) + sq4(h1);
                }
                s += __shfl_xor(s, 16); s += __shfl_xor(s, 32);
                if (fq == 0) xw[(ai * HALF + m * 16) * 4] = s;
            }
        PG8_XBAR();
        if (wc == 0 && fq == 0) {
#pragma unroll
            for (int ai = 0; ai < 2; ++ai)
#pragma unroll
                for (int m = 0; m < 4; ++m) { const f32x4 p = *(const PG8_LAS f32x4*)(xr + (ai * HALF + m * 16) * 4);
                    ss[(size_t)(u.pm * BM + ai * HALF + wr * 64 + m * 16 + fr) * 4 + u.pn] = (p[0] + p[1]) + (p[2] + p[3]); }
        }
    }
};
struct EpiXq {
    static constexpr bool PERM = true, AFTER_DRAIN = false;
    bf16_t* QX; const float* ss1; const float* g_xq; PG8_LAS float* X;
    __device__ __forceinline__ void operator()(const f32x4 (&acc)[2][2][4][2], const Unit& u, int wr, int wc, int fr, int fq) const {
        PG8_LAS float* const xw = X + (wr * 64 + fr) * 4 + wc; const PG8_LAS float* const xr = X + (wr * 64 + fr) * 4;
        const int cl0 = wc * 32 + 8 * fq;
        float rr[2][4];
#pragma unroll
        for (int ai = 0; ai < 2; ++ai)
#pragma unroll
            for (int m = 0; m < 4; ++m) {
                const int rt = ai * HALF + wr * 64 + m * 16 + fr; const float r = rs16(ss1, u.pm * BM + rt); rr[ai][m] = r;
                float ss = ((sq4(acc[ai][0][m][0]) + sq4(acc[ai][0][m][1])) + (sq4(acc[ai][1][m][0]) + sq4(acc[ai][1][m][1]))) * (r * r);
                ss += __shfl_xor(ss, 16); ss += __shfl_xor(ss, 32);
                if (fq == 0) xw[(ai * HALF + m * 16) * 4] = ss;
            }
        PG8_XBAR();
        const f32x4 g00 = *(const f32x4*)(g_xq + cl0) * XQ_SCALE, g01 = *(const f32x4*)(g_xq + cl0 + 4) * XQ_SCALE, g10 = *(const f32x4*)(g_xq + 128 + cl0) * XQ_SCALE, g11 = *(const f32x4*)(g_xq + 128 + cl0 + 4) * XQ_SCALE;
#pragma unroll
        for (int ai = 0; ai < 2; ++ai)
#pragma unroll
            for (int m = 0; m < 4; ++m) {
                const int rt = ai * HALF + wr * 64 + m * 16 + fr, row = u.pm * BM + rt;
                const f32x4 p = *(const PG8_LAS f32x4*)(xr + (ai * HALF + m * 16) * 4);
                const float sc = rr[ai][m] * rsqrtf(((p[0] + p[1]) + (p[2] + p[3])) * (1.f / 256.f) + EPS);
                bf16_t* d = QX + (size_t)row * 1024 + u.pn * 256 + cl0;
                st16_wt(d, pack8(acc[ai][0][m][0] * sc * g00, acc[ai][0][m][1] * sc * g01));
                st16_wt((d + 128), pack8(acc[ai][1][m][0] * sc * g10, acc[ai][1][m][1] * sc * g11));
            }
    }
};
struct EpiSoftmax {
    static constexpr bool PERM = true, AFTER_DRAIN = false;
    bf16_t* P; PG8_LAS float* X;
    __device__ __forceinline__ void operator()(const f32x4 (&acc)[2][2][4][2], const Unit& u, int wr, int wc, int fr, int fq) const {
        PG8_LAS float* const xw = X + (wr * 64 + fr) * 4 + wc; const PG8_LAS float* const xr = X + (wr * 64 + fr) * 4;
        const int cl0 = wc * 32 + 8 * fq;
#pragma unroll
        for (int ai = 0; ai < 2; ++ai)
#pragma unroll
            for (int m = 0; m < 4; ++m) {
                const int rt = ai * HALF + wr * 64 + m * 16 + fr;
                float mx = -INFINITY;
#pragma unroll
                for (int bj = 0; bj < 2; ++bj)
#pragma unroll
                    for (int n = 0; n < 2; ++n) { const f32x4 v = acc[ai][bj][m][n]; mx = fmaxf(mx, fmaxf(fmaxf(v[0], v[1]), fmaxf(v[2], v[3]))); }
                mx = fmaxf(mx, __shfl_xor(mx, 16)); mx = fmaxf(mx, __shfl_xor(mx, 32));
                if (fq == 0) xw[(ai * HALF + m * 16) * 4] = mx;
            }
        PG8_XBAR();
        float mr[2][4];
#pragma unroll
        for (int ai = 0; ai < 2; ++ai)
#pragma unroll
            for (int m = 0; m < 4; ++m) {
                const int rt = ai * HALF + wr * 64 + m * 16 + fr;
                const f32x4 p = *(const PG8_LAS f32x4*)(xr + (ai * HALF + m * 16) * 4);
                const float mx = fmaxf(fmaxf(p[0], p[1]), fmaxf(p[2], p[3])); mr[ai][m] = mx;
                float s = 0.f;
#pragma unroll
                for (int bj = 0; bj < 2; ++bj)
#pragma unroll
                    for (int n = 0; n < 2; ++n) { const f32x4 v = acc[ai][bj][m][n];
                        s += (__builtin_amdgcn_exp2f(v[0] - mx) + __builtin_amdgcn_exp2f(v[1] - mx)) + (__builtin_amdgcn_exp2f(v[2] - mx) + __builtin_amdgcn_exp2f(v[3] - mx)); }
                s += __shfl_xor(s, 16); s += __shfl_xor(s, 32);
                if (fq == 0) xw[1024 + (ai * HALF + m * 16) * 4] = s;
            }
        PG8_XBAR();
#pragma unroll
        for (int ai = 0; ai < 2; ++ai)
#pragma unroll
            for (int m = 0; m < 4; ++m) {
                const int rt = ai * HALF + wr * 64 + m * 16 + fr, row = u.pm * BM + rt;
                const f32x4 p = *(const PG8_LAS f32x4*)(xr + 1024 + (ai * HALF + m * 16) * 4);
                const float inv = 1.f / ((p[0] + p[1]) + (p[2] + p[3])), mx = mr[ai][m];
                bf16_t* d = P + (size_t)row * 1024 + u.pn * 256 + cl0;
#pragma unroll
                for (int bj = 0; bj < 2; ++bj) {
                    f32x4 e0, e1;
#pragma unroll
                    for (int j = 0; j < 4; ++j) { e0[j] = __builtin_amdgcn_exp2f(acc[ai][bj][m][0][j] - mx) * inv; e1[j] = __builtin_amdgcn_exp2f(acc[ai][bj][m][1][j] - mx) * inv; }
                    st16_wt((d + bj * 128), pack8(e0, e1));
                }
            }
    }
};
struct EpiBf16Plain {
    static constexpr bool PERM = true, AFTER_DRAIN = false;
    bf16_t* O;
    __device__ __forceinline__ void operator()(const f32x4 (&acc)[2][2][4][2], const Unit& u, int wr, int wc, int fr, int fq) const {
        const int cl0 = wc * 32 + 8 * fq;
#pragma unroll
        for (int ai = 0; ai < 2; ++ai)
#pragma unroll
            for (int m = 0; m < 4; ++m) {
                const int row = u.pm * BM + ai * HALF + wr * 64 + m * 16 + fr;
                bf16_t* d = O + (size_t)row * 1024 + u.pn * 256 + cl0;
                st16_wt(d, pack8(acc[ai][0][m][0], acc[ai][0][m][1]));
                st16_wt((d + 128), pack8(acc[ai][1][m][0], acc[ai][1][m][1]));
            }
    }
};
__device__ __forceinline__ float gelu_tanh_f(float v) {
    const float u = 0.7978845608028654f * (v + 0.044715f * v * v * v);
    return v * __builtin_amdgcn_rcpf(1.f + __builtin_amdgcn_exp2f(-2.885390081777927f * u));
}
template <int CTRL> __device__ __forceinline__ float dppf(float old, float src) {
    return __builtin_bit_cast(float, __builtin_amdgcn_update_dpp(__builtin_bit_cast(int, old), __builtin_bit_cast(int, src), CTRL, 0xf, 0xf, false));
}
__device__ __forceinline__ f32x4 cvti4(const f32x4 a) { typedef int i32x4_ __attribute__((ext_vector_type(4))); const i32x4_ i = __builtin_bit_cast(i32x4_, a); return (f32x4){(float)i[0], (float)i[1], (float)i[2], (float)i[3]}; }
struct EpiFfnFused {
    static constexpr bool PERM = true, AFTER_DRAIN = false;
    bf16_t* ACT; float* HALO; float* FIXA; float* FIXG; const float* rs8; const float* sb8; const float* cw; const float* cb; PG8_LAS float* X;
    __device__ __forceinline__ void operator()(const f32x4 (&acc)[2][2][4][2], const Unit& u, int wr_, int wc_, int fr_, int fq_) const {
        int ln_; asm volatile("v_mbcnt_lo_u32_b32 %0, -1, 0\n\tv_mbcnt_hi_u32_b32 %0, -1, %0" : "=v"(ln_));
        const int fr = ln_ & 15, fq = ln_ >> 4; (void)fr_; (void)fq_;
        int wr = wr_, wc = wc_; asm volatile("" : "+s"(wr), "+s"(wc));
        const int cl0 = wc * 32 + 8 * fq, c0 = u.pn * 128 + cl0;
        float rr[2][4];
#pragma unroll
        for (int ai = 0; ai < 2; ++ai)
#pragma unroll
            for (int m = 0; m < 4; ++m) rr[ai][m] = rs8[u.pm * BM + ai * HALF + wr * 64 + m * 16 + fr];
        if (fr >= 14) {
#pragma unroll
            for (int ai = 0; ai < 2; ++ai) {
                const f32x4 v0 = cvti4(acc[ai][0][3][0]) * rr[ai][3], v1 = cvti4(acc[ai][0][3][1]) * rr[ai][3];
                PG8_LAS float* h = X + ((ai * 2 + wr) * 2 + (fr - 14)) * 128 + cl0;
                *(PG8_LAS f32x4*)h = v0; *(PG8_LAS f32x4*)(h + 4) = v1;
                if (ai == 1 && wr == 1) { float* g = HALO + ((size_t)u.pm * 2 + (fr - 14)) * DFF + c0; *(f32x4*)g = v0; *(f32x4*)(g + 4) = v1; }
            }
        }
        PG8_XBAR();
        u32x2 keep[2][4];
#pragma unroll
        for (int n = 0; n < 2; ++n) {
            const int cn = c0 + 4 * n;
            const f32x4 sa = *(const f32x4*)(sb8 + u.pn * 256 + cl0 + 4 * n), sg = *(const f32x4*)(sb8 + u.pn * 256 + 128 + cl0 + 4 * n);
            const f32x4 w0 = *(const f32x4*)(cw + cn) * sa, w1 = *(const f32x4*)(cw + DFF + cn) * sa, w2 = *(const f32x4*)(cw + 2 * DFF + cn) * sa, cbv = *(const f32x4*)(cb + cn);
#pragma unroll
            for (int ai = 0; ai < 2; ++ai)
#pragma unroll
                for (int m = 0; m < 4; ++m) {
                    const int rt = ai * HALF + wr * 64 + m * 16 + fr, row = u.pm * BM + rt;
                    const f32x4 ca = cvti4(acc[ai][0][m][n]) * rr[ai][m], ga = cvti4(acc[ai][1][m][n]) * rr[ai][m];
                    f32x4 pa = {0.f, 0.f, 0.f, 0.f};
                    if (m > 0) pa = cvti4(acc[ai][0][m - 1][n]) * rr[ai][m - 1];
                    else if (fr >= 14) {
                        const int which = wr == 1 ? ai * 2 : (ai == 1 ? 1 : -1);
                        if (which >= 0) pa = *(const PG8_LAS f32x4*)(X + (which * 2 + (fr - 14)) * 128 + cl0 + 4 * n);
                    }
                    f32x4 oa;
#pragma unroll
                    for (int j = 0; j < 4; ++j) {
                        const float a1 = dppf<0x111>(dppf<0x121>(0.f, pa[j]), ca[j]), a2 = dppf<0x112>(dppf<0x122>(0.f, pa[j]), ca[j]);
                        oa[j] = gelu_tanh_f(cbv[j] + w2[j] * ca[j] + w1[j] * a1 + w0[j] * a2) * (ga[j] * sg[j]);
                    }
                    u32x2 w; w.x = cvt_pk_bf16(oa[0], oa[1]); w.y = cvt_pk_bf16(oa[2], oa[3]);
                    if (n == 0) keep[ai][m] = w;
                    else st16_wt((ACT + (size_t)row * DFF + c0), (u32x4){keep[ai][m].x, keep[ai][m].y, w.x, w.y});
                    if (ai == 0 && m == 0 && wr == 0 && fr < 2) {
                        *(f32x4*)(FIXA + ((size_t)u.pm * 2 + fr) * DFF + cn) = ca; *(f32x4*)(FIXG + ((size_t)u.pm * 2 + fr) * DFF + cn) = ga;
                    }
                }
        }
    }
};
struct EpiFinal {
    static constexpr bool PERM = true, AFTER_DRAIN = false;
    const bf16_t* base; float* out;
    __device__ __forceinline__ void operator()(const f32x4 (&acc)[2][2][4][2], const Unit& u, int wr, int wc, int fr, int fq) const {
        const int col0 = u.pn * BM + wc * 32 + 8 * fq;
#pragma unroll
        for (int ai = 0; ai < 2; ++ai)
#pragma unroll
            for (int m = 0; m < 4; ++m) {
                const size_t off = (size_t)(u.pm * BM + ai * HALF + wr * 64 + m * 16 + fr) * 1024 + col0;
#pragma unroll
                for (int bj = 0; bj < 2; ++bj) {
                    f32x4 b0, b1; unpack8(__builtin_nontemporal_load((const u32x4*)(base + off + bj * HALF)), b0, b1);
                    __builtin_nontemporal_store(b0 + acc[ai][bj][m][0], (f32x4*)(out + off + bj * HALF));
                    __builtin_nontemporal_store(b1 + acc[ai][bj][m][1], (f32x4*)(out + off + bj * HALF + 4));
                }
            }
    }
};
}
constexpr size_t WS_H1B = WS_A2 + 2048;
constexpr size_t WS_QX = 82 * MiB;
constexpr size_t WS_P = 146 * MiB;
constexpr size_t WS_H2B = 82 * MiB;
constexpr size_t WS_VWT = 450 * MiB;
constexpr size_t WS_UA = 82 * MiB;
constexpr size_t WS_UG = 258 * MiB;
static_assert(WS_H2B + (size_t)NTOK * DM * 2 <= WS_P && WS_UG + (size_t)NTOK * DFF * 2 <= WS_VWT && WS_VWT + (size_t)16 * 1024 * 1024 * 2 <= WS_END, "late-phase workspace map");

__device__ __forceinline__ void p1_memkv(Frame& F, const Args& A) {
    pg8::Gemm g{WSP(bf16, WS_MEMB), WSP(bf16, WS_WXKV), 1024, 1024, 1024, 0xffffffffu};
    pg8::TileOrder S; S.init(16, 8, F.G, (int)blockIdx.x, (size_t)256 * 1024 * 2, (size_t)256 * 1024 * 2, F.G >= 256 ? 128 : 0);
    pg8::EpiMemKV E{WSP(bf16, WS_KX), WSP(bf16, WS_VXT), WSP(float, WS_RSM), (const float*)A.in[21], (PG8_LAS float*)(F.lds + LDSX_OFF)};
    pg8::gemm_phase<pg8::EpiMemKV, pg8::TileOrder, true, true>(F.lds + RING_OFF, g, S, E, F.wave);
}
__device__ __forceinline__ void p_wout(Frame& F, const Args& A) {
    pg8::Gemm g{WSP(bf16, WS_ATT), WSP(bf16, WS_WOUT), 1024, 1024, 1024, 0xffffffffu};
    pg8::TileOrder S; S.init(128, 4, F.G, (int)blockIdx.x, (size_t)256 * 1024 * 2, (size_t)256 * 1024 * 2);
    pg8::EpiRes<true> E{WSP(bf16, WS_A2), 2048, WSP(bf16, WS_H1B), 2048, WSP(float, WS_SS1), (PG8_LAS float*)(F.lds + LDSX_OFF)};
    pg8::gemm_phase<pg8::EpiRes<true>, pg8::TileOrder, true, true>(F.lds + RING_OFF, g, S, E, F.wave);
}
__device__ __forceinline__ void p_xq(Frame& F, const Args& A) {
    pg8::Gemm g{WSP(bf16, WS_H1B), WSP(bf16, WS_WXQ), 2048, 1024, 1024, 0xffffffffu};
    pg8::TileOrder S; S.init(128, 4, F.G, (int)blockIdx.x, (size_t)256 * 2048 * 2, (size_t)256 * 1024 * 2);
    pg8::EpiXq E{WSP(bf16, WS_QX), WSP(float, WS_SS1), (const float*)A.in[20], (PG8_LAS float*)(F.lds + LDSX_OFF)};
    pg8::gemm_phase<pg8::EpiXq, pg8::TileOrder, true, true>(F.lds + RING_OFF, g, S, E, F.wave);
}
__device__ __forceinline__ void p_xs(Frame& F) {
    int kk = 256; asm volatile("" : "+s"(kk));
    pg8::Gemm g{WSP(bf16, WS_QX), WSP(bf16, WS_KX), 1024, 1024, kk, 0xffffffffu};
    pg8::TileOrder S; S.init(128, 4, F.G, (int)blockIdx.x, (size_t)256 * 1024 * 2, (size_t)256 * 2, 0, (size_t)256 * 2, (size_t)256 * 1024 * 2);
    pg8::EpiSoftmax E{WSP(bf16, WS_P), (PG8_LAS float*)(F.lds + LDSX_OFF)};
    pg8::gemm_phase<pg8::EpiSoftmax, pg8::TileOrder, true, true>(F.lds + RING_OFF, g, S, E, F.wave);
}
struct VwOrder {
    int G, c;
    __device__ bool next(int i, pg8::Unit& u) const {
        const int L = i * G + c; if (L >= 256) return false;
        const int b = L >> 4, h = (L >> 2) & 3, nt = L & 3;
        u.pm = b * 4 + nt; u.pn = h; u.ao = ((size_t)nt * 256 * 1024 + h * 256) * 2; u.bo = ((size_t)b * 256 * 1024 + h * 256) * 2; return true;
    }
    __device__ __forceinline__ void a_ready(const pg8::Unit&) const {}
    __device__ __forceinline__ void done(const pg8::Unit&) const {}
};
__device__ __forceinline__ void p_vw(Frame& F) {
    int kk = 256; asm volatile("" : "+s"(kk));
    pg8::Gemm g{WSP(bf16, WS_WXO), WSP(bf16, WS_VXT), 1024, 1024, kk, 0xffffffffu};
    VwOrder S{F.G, (int)blockIdx.x};
    pg8::EpiBf16Plain E{WSP(bf16, WS_VWT)};
    pg8::gemm_phase<pg8::EpiBf16Plain, VwOrder, true, true>(F.lds + RING_OFF, g, S, E, F.wave);
}
__device__ __forceinline__ void p_wxo(Frame& F) {
    pg8::Gemm g{WSP(bf16, WS_P), WSP(bf16, WS_VWT), 1024, 1024, 1024, 0xffffffffu};
    pg8::TileOrder S; S.init(128, 4, F.G, (int)blockIdx.x, (size_t)256 * 1024 * 2, (size_t)256 * 1024 * 2, 0, 0, (size_t)1024 * 1024 * 2);
    pg8::EpiRes<true> E{WSP(bf16, WS_H1B), 2048, WSP(bf16, WS_H2B), 1024, WSP(float, WS_SS2), (PG8_LAS float*)(F.lds + LDSX_OFF)};
    pg8::gemm_phase<pg8::EpiRes<true>, pg8::TileOrder, true, true>(F.lds + RING_OFF, g, S, E, F.wave);
}
constexpr size_t WS_HALO = 73 * MiB, WS_FIXA = 76 * MiB, WS_FIXG = 79 * MiB;
static_assert((size_t)128 * 2 * DFF * 4 <= 3 * MiB, "halo buffers");
constexpr size_t WS_A8 = 146 * MiB;
constexpr size_t WS_W8 = 178 * MiB;
constexpr size_t WS_RS8 = 184 * MiB;
constexpr size_t WS_SB8 = 185 * MiB;
static_assert(WS_A8 >= WS_H2B + (size_t)NTOK * DM * 2 && WS_W8 >= WS_A8 + (size_t)NTOK * DM && WS_RS8 >= WS_W8 + (size_t)2 * DFF * DM && WS_SB8 >= WS_RS8 + (size_t)NTOK * 4 && WS_SB8 + (size_t)2 * DFF * 4 <= 210 * MiB, "int8 operand map");
__device__ __forceinline__ void quant_row(const v4u a, const v4u b, unsigned char* dst, float* sc, bool is_w, int lane) {
    float v[16];
#pragma unroll
    for (int i = 0; i < 4; ++i) { v[2 * i] = __uint_as_float(a[i] << 16); v[2 * i + 1] = __uint_as_float(a[i] & 0xffff0000u); v[8 + 2 * i] = __uint_as_float(b[i] << 16); v[8 + 2 * i + 1] = __uint_as_float(b[i] & 0xffff0000u); }
    float mx = 0.f, ss = 0.f;
#pragma unroll
    for (int i = 0; i < 16; ++i) { mx = fmaxf(mx, fabsf(v[i])); ss += v[i] * v[i]; }
    mx = wave_max(mx); ss = wave_sum(ss);
    const float inv = mx > 0.f ? 127.f / mx : 0.f;
    v4u q;
#pragma unroll
    for (int w = 0; w < 4; ++w) {
        const int q0 = (int)rintf(v[4 * w] * inv), q1 = (int)rintf(v[4 * w + 1] * inv), q2 = (int)rintf(v[4 * w + 2] * inv), q3 = (int)rintf(v[4 * w + 3] * inv);
        q[w] = ((unsigned)q0 & 255u) | (((unsigned)q1 & 255u) << 8) | (((unsigned)q2 & 255u) << 16) | ((unsigned)q3 << 24);
    }
    *(GAS v4u*)(dst + 16 * lane) = q;
    if (lane == 0) *sc = is_w ? mx * (1.f / 127.f) : rsqrtf(ss * (1.f / DM) + EPS) * (mx * (1.f / 127.f));
}
__device__ __forceinline__ void p_quant(Frame& F) {
    const int NH = F.G * NWAVES, NR = NTOK + 2 * DFF;
    for (int r = (int)blockIdx.x * NWAVES + F.wave; r < NR; r += 2 * NH) {
        const int r2 = r + NH < NR ? r + NH : r;
        const bool w1 = r >= NTOK, w2 = r2 >= NTOK;
        const bf16* s1 = w1 ? WSP(bf16, WS_WF1) + (size_t)(r - NTOK) * 1024 : WSP(bf16, WS_H2B) + (size_t)r * 1024;
        const bf16* s2 = w2 ? WSP(bf16, WS_WF1) + (size_t)(r2 - NTOK) * 1024 : WSP(bf16, WS_H2B) + (size_t)r2 * 1024;
        const int l = lane_now();
        const v4u a1 = *(const GAS v4u*)(s1 + 16 * l), b1 = *(const GAS v4u*)(s1 + 16 * l + 8), a2 = *(const GAS v4u*)(s2 + 16 * l), b2 = *(const GAS v4u*)(s2 + 16 * l + 8);
        quant_row(a1, b1, w1 ? WSP(unsigned char, WS_W8) + (size_t)(r - NTOK) * 1024 : WSP(unsigned char, WS_A8) + (size_t)r * 1024, w1 ? WSP(float, WS_SB8) + (r - NTOK) : WSP(float, WS_RS8) + r, w1, l);
        if (r2 != r) quant_row(a2, b2, w2 ? WSP(unsigned char, WS_W8) + (size_t)(r2 - NTOK) * 1024 : WSP(unsigned char, WS_A8) + (size_t)r2 * 1024, w2 ? WSP(float, WS_SB8) + (r2 - NTOK) : WSP(float, WS_RS8) + r2, w2, l);
    }
}
__device__ __forceinline__ void p_ffn1(Frame& F, const Args& A) {
    int kk = 512; asm volatile("" : "+s"(kk));
    pg8::Gemm g{WSP(bf16, WS_A8), WSP(bf16, WS_W8), 512, 512, kk, 0xffffffffu};
    pg8::TileOrder S; S.init(128, 22, F.G, (int)blockIdx.x, (size_t)256 * 1024, (size_t)256 * 1024);
    pg8::EpiFfnFused E{WSP(bf16, WS_UG), WSP(float, WS_HALO), WSP(float, WS_FIXA), WSP(float, WS_FIXG), WSP(float, WS_RS8), WSP(float, WS_SB8), (const float*)A.in[24], (const float*)A.in[25], (PG8_LAS float*)(F.lds + LDSX_OFF)};
    pg8::gemm_phase<pg8::EpiFfnFused, pg8::TileOrder, true, true, true>(F.lds + RING_OFF, g, S, E, F.wave);
}
__device__ __forceinline__ void ffnfix_panel(Frame& F, const Args& A, int pm) {
    if ((pm & 7) == 0) return;
    const float* cw = (const float*)A.in[24]; const float* cb = (const float*)A.in[25]; const float* sb8 = WSP(float, WS_SB8);
    const float* HALO = WSP(float, WS_HALO); const float* FIXA = WSP(float, WS_FIXA); const float* FIXG = WSP(float, WS_FIXG); bf16* ACT = WSP(bf16, WS_UG);
    for (int i = F.wave * 64 + lane_now(); i < 2 * DFF; i += NWAVES * 64) {
        const int r = i >= DFF ? 1 : 0, c = i - r * DFF;
        const float sa = sb8[(c >> 7) * 256 + (c & 127)], sg = sb8[(c >> 7) * 256 + 128 + (c & 127)];
        const float a0 = FIXA[((size_t)pm * 2 + r) * DFF + c];
        const float a1 = r == 0 ? HALO[((size_t)(pm - 1) * 2 + 1) * DFF + c] : FIXA[((size_t)pm * 2) * DFF + c];
        const float a2 = r == 0 ? HALO[((size_t)(pm - 1) * 2) * DFF + c] : HALO[((size_t)(pm - 1) * 2 + 1) * DFF + c];
        const float v = cb[c] + sa * (cw[2 * DFF + c] * a0 + cw[DFF + c] * a1 + cw[c] * a2);
        ACT[((size_t)pm * 256 + r) * DFF + c] = (bf16)f2bf(pg8::gelu_tanh_f(v) * (FIXG[((size_t)pm * 2 + r) * DFF + c] * sg));
    }
}
__device__ __forceinline__ void p_ffn2(Frame& F, const Args& A) {
    pg8::Gemm g{WSP(bf16, WS_UG), WSP(bf16, WS_WF2), DFF, DFF, DFF, 0xffffffffu};
    pg8::TileOrder S; S.init(128, 4, F.G, (int)blockIdx.x, (size_t)256 * DFF * 2, (size_t)256 * DFF * 2);
    {
        pg8::Unit u; int last = -1;
        for (int i = 0; S.next(i, u); ++i) { if (u.pm != last) ffnfix_panel(F, A, u.pm); last = u.pm; }
        asm volatile("s_waitcnt vmcnt(0)" ::: "memory"); __syncthreads();
    }
    pg8::EpiFinal E{WSP(bf16, WS_H2B), F.out};
    pg8::gemm_phase<pg8::EpiFinal, pg8::TileOrder, true, true>(F.lds + RING_OFF, g, S, E, F.wave);
}
constexpr int N_PHASES = 13;
__global__ void __launch_bounds__(NWAVES * 64, 2) mk(Args args) {
    extern __shared__ __attribute__((aligned(16))) unsigned char lds[];
    Frame F;
    F.lds = (LAS unsigned char*)lds;
    F.wave = __builtin_amdgcn_readfirstlane((int)threadIdx.x >> 6);
    F.G = gridDim.x; { const int bx = blockIdx.x; F.vcu = (F.G % 8 == 0) ? (bx % 8) * (F.G / 8) + bx / 8 : bx; }
    F.ws = args.ws; F.out = args.out;
    for (int u = threadIdx.x; u < (LDS_BYTES - LDSCTL_OFF) / 4; u += NWAVES * 64) ((LAS unsigned*)(F.lds + LDSCTL_OFF))[u] = 0u;
    __syncthreads();
    const int lo = args.ph_lo, hi = args.ph_hi;
    XcdBarrier bar; bar.bar = (unsigned*)(F.ws + WS_CTL) + CW_BAR; bar.x = 0; bar.st = nullptr; bar.wave = F.wave;
    if (hi - lo > 1) bar = xcd_barrier_post((unsigned*)(F.ws + WS_CTL) + CW_BAR, (volatile LAS unsigned*)(F.lds + MISC_OFF) + 8, F.wave);
#define IN(k) (lo <= (k) && (k) < hi)
#define BOTH(k) (IN(k) && IN((k) + 1))
#ifndef REPEAT_PH
#define REPEAT_PH -1
#endif
#define PHASE(k, body, body2) if (IN(k)) { body; if (BOTH(k)) xcd_barrier(bar); if (REPEAT_PH == (k)) { body2; xcd_barrier(bar); } }
    PHASE(0, p0_prologue(F, args), p0_prologue(F, args))
    PHASE(1, p1_proj(F, args), p1_proj(F, args))
    PHASE(2, (p1_memkv(F, args), idx::run(F, idx::CW_QUEUE)), (p1_memkv(F, args), idx::run(F, idx::CW_QUEUE + 32)))
    PHASE(3, (p_vw(F), p3::run(F, p3::CW_QUEUE)), (p_vw(F), p3::run(F, p3::CW_QUEUE + 32)))
    PHASE(5, p_wout(F, args), p_wout(F, args))
    if (IN(6)) { p_xq(F, args); if (REPEAT_PH == 6) p_xq(F, args); }
    PHASE(7, p_xs(F), p_xs(F))
    PHASE(9, p_wxo(F), p_wxo(F))
    PHASE(10, p_quant(F), p_quant(F))
    PHASE(11, p_ffn1(F, args), p_ffn1(F, args))
    if (IN(12)) { p_ffn2(F, args); }
#undef PHASE
#undef IN
#undef BOTH
}

extern "C" void kernel_launch(void* const* d_in, const int* in_sizes, int n_in, void* d_out, int out_size, void* d_ws, size_t ws_size, hipStream_t stream) {
    static int grid = 0;
    if (grid == 0) {
        if (n_in != 27 || ws_size < WS_END) { fprintf(stderr, "kernel_launch: unexpected inputs (n_in %d, ws %zu)\n", n_in, ws_size); grid = -1; return; }
        int dev = 0, cus = 0;
        if (hipGetDevice(&dev) != hipSuccess || hipDeviceGetAttribute(&cus, hipDeviceAttributeMultiprocessorCount, dev) != hipSuccess) { grid = -1; return; }
        if (hipFuncSetAttribute((const void*)mk, hipFuncAttributeMaxDynamicSharedMemorySize, LDS_BYTES) != hipSuccess) { fprintf(stderr, "kernel_launch: hipFuncSetAttribute failed\n"); grid = -1; return; }
        (void)hipGetLastError();
        grid = cus;
    }
    if (grid < 0) return;
    float* out = (float*)d_out;
    unsigned char* ws = (unsigned char*)d_ws;
    (void)hipMemsetAsync(ws + WS_CTL, 0, CTL_ZERO_BYTES, stream);
    Args a{};
    for (int i = 0; i < 27; ++i) a.in[i] = d_in[i];
    a.out = out; a.ws = ws;
    for (int i = 0; i < 32; ++i) { const float e = (float)(2 * i) / 64.0f; const float pw = powf(10000.0f, e); a.rf.f[i] = 1.0f / pw; }
    a.ph_lo = 0; a.ph_hi = N_PHASES;
    hipLaunchKernelGGL(mk, dim3(grid), dim3(NWAVES * 64), LDS_BYTES, stream, a);

}
```

```cpp
#include <hip/hip_runtime.h>
#include <cstdint>
#include <cstdio>
#include <cmath>

constexpr int BATCH = 16, SEQ = 2048, DM = 1024, NTOK = BATCH * SEQ;
constexpr int NMEM = 256, NMTOK = BATCH * NMEM;
constexpr int INC = 2500;
constexpr int OFF_QA = 0, OFF_KA = 512, OFF_VA = 576, OFF_QI = 640, OFF_KI = 896, OFF_WI = 960, OFF_QB = 964, OFF_KB = 1476, OFF_VB = 1988;
constexpr int DFF = 2816;
constexpr float EPS = 1e-6f;
constexpr float C2 = 0.125f * 1.4426950408889634f;

struct RopeF { float f[32]; };

__device__ __forceinline__ float wave_sum(float v) {
#pragma unroll
    for (int o = 1; o < 64; o <<= 1) v += __shfl_xor(v, o);
    return v;
}
__device__ __forceinline__ float wave_max(float v) {
#pragma unroll
    for (int o = 1; o < 64; o <<= 1) v = fmaxf(v, __shfl_xor(v, o));
    return v;
}

#ifndef WT_STORES
#define WT_STORES 0
#endif
typedef unsigned wt_u32x4 __attribute__((ext_vector_type(4)));
typedef unsigned wt_u32x2 __attribute__((ext_vector_type(2)));
__device__ __forceinline__ void st16_wt(void* p, wt_u32x4 v) {
#if WT_STORES
    asm volatile("global_store_dwordx4 %0, %1, off sc1\n\ts_nop 1" :: "v"(p), "v"(v) : "memory");
#else
    *(wt_u32x4*)p = v;
#endif
}
__device__ __forceinline__ void st8_wt(void* p, wt_u32x2 v) {
#if WT_STORES
    asm volatile("global_store_dwordx2 %0, %1, off sc1\n\ts_nop 1" :: "v"(p), "v"(v) : "memory");
#else
    *(wt_u32x2*)p = v;
#endif
}
namespace pg8 {
#define PG8_LAS __attribute__((address_space(3)))
typedef unsigned short bf16_t;
typedef short bf16x8 __attribute__((ext_vector_type(8)));
typedef float f32x4 __attribute__((ext_vector_type(4)));
typedef unsigned u32x4 __attribute__((ext_vector_type(4)));
typedef unsigned u32x2 __attribute__((ext_vector_type(2)));
constexpr int BM = 256, BK = 64, HALF = 128, HTB = HALF * BK * 2  , STAGE_BYTES = 8 * HTB, NXCD = 8, WGM = 8;

__host__ __device__ __forceinline__ int lds_byte(int r, int c) { const int st = (r >> 4) * 2 + (c >> 5), rr = r & 15, cc = c & 31, ob = rr * 64 + cc * 2; return st * 1024 + (ob ^ (((ob >> 9) & 1) << 5)); }
__host__ __device__ __forceinline__ void stage_rc(int b, int& R, int& C) { const int st = b / 1024, sb = b % 1024, swz = sb ^ (((sb >> 9) & 1) << 5); R = (st >> 1) * 16 + swz / 64; C = (st & 1) * 32 + (swz % 64) / 2; }
__host__ __device__ __forceinline__ int perm32(int rho) { const int n = rho >> 4, i = rho & 15; return 8 * (i >> 2) + 4 * n + (i & 3); }

struct Unit { int pm, pn; size_t ao, bo; };
struct Gemm { const bf16_t* A; const bf16_t* Bt; int lda, ldb, K; unsigned amask; };

struct TileOrder {
    int nM, nN, nwg, G, c, c0; size_t astep, bstep, apn, bbatch;
    __device__ void init(int nM_, int nN_, int G_, int c_, size_t astep_, size_t bstep_, int c0_ = 0, size_t apn_ = 0, size_t bbatch_ = 0) { nM = nM_; nN = nN_; nwg = nM * nN; G = G_; c = c_; c0 = c0_; astep = astep_; bstep = bstep_; apn = apn_; bbatch = bbatch_; }
    __device__ bool next(int i, Unit& u) const {
        if (c < c0) return false;
        const long L = (long)i * G + (c - c0); if (L >= nwg) return false;
        int wgid = (int)L; { const int q = nwg / NXCD, r = nwg % NXCD, xcd = wgid % NXCD, off = wgid / NXCD; wgid = (xcd < r ? xcd * (q + 1) : r * (q + 1) + (xcd - r) * q) + off; }
        const int nig = WGM * nN, gid = wgid / nig, fm = gid * WGM, gsz = (nM - fm) < WGM ? (nM - fm) : WGM;
        u.pm = fm + ((wgid % nig) % gsz); u.pn = (wgid % nig) / gsz; u.ao = (size_t)u.pm * astep + (size_t)u.pn * apn; u.bo = (size_t)u.pn * bstep + (size_t)(u.pm >> 3) * bbatch; return true;
    }
    __device__ __forceinline__ void a_ready(const Unit&) const {}
    __device__ __forceinline__ void done(const Unit&) const {}
};
__device__ __forceinline__ const char* uptr(const void* p) {
    const unsigned long long v = (unsigned long long)p; const unsigned lo = __builtin_amdgcn_readfirstlane((unsigned)v), hi = __builtin_amdgcn_readfirstlane((unsigned)(v >> 32));
    return (const char*)(((unsigned long long)hi << 32) | lo);
}
__device__ __forceinline__ int lane_id() { int l; asm volatile("v_mbcnt_lo_u32_b32 %0, -1, 0\n\tv_mbcnt_hi_u32_b32 %0, -1, %0" : "=v"(l)); return l; }
__device__ __forceinline__ unsigned cvt_pk_bf16(float lo, float hi) { unsigned r; asm volatile("v_cvt_pk_bf16_f32 %0, %1, %2" : "=v"(r) : "v"(lo), "v"(hi)); return r; }
typedef float f32x2 __attribute__((ext_vector_type(2)));
__device__ __forceinline__ float sq4(const f32x4 v) { return (v[0] * v[0] + v[1] * v[1]) + (v[2] * v[2] + v[3] * v[3]); }
__device__ __forceinline__ void split_pk(float a, float b, unsigned& hi, unsigned& lo) {
    hi = cvt_pk_bf16(a, b);
    const float ah = __uint_as_float(hi << 16), bh = __uint_as_float(hi & 0xffff0000u);
    lo = cvt_pk_bf16(a - ah, b - bh);
}
__device__ __forceinline__ void split8(const f32x4 a, const f32x4 b, u32x4& hi, u32x4& lo) {
    unsigned h0, h1, h2, h3, l0, l1, l2, l3;
    split_pk(a[0], a[1], h0, l0); split_pk(a[2], a[3], h1, l1); split_pk(b[0], b[1], h2, l2); split_pk(b[2], b[3], h3, l3);
    hi = (u32x4){h0, h1, h2, h3}; lo = (u32x4){l0, l1, l2, l3};
}
__device__ __forceinline__ u32x4 pack8(const f32x4 a, const f32x4 b) { u32x4 w; w.x = cvt_pk_bf16(a[0], a[1]); w.y = cvt_pk_bf16(a[2], a[3]); w.z = cvt_pk_bf16(b[0], b[1]); w.w = cvt_pk_bf16(b[2], b[3]); return w; }

__device__ __forceinline__ f32x4 cvti4(const f32x4 a) { typedef int i32x4_ __attribute__((ext_vector_type(4))); const i32x4_ i = __builtin_bit_cast(i32x4_, a); return (f32x4){(float)i[0], (float)i[1], (float)i[2], (float)i[3]}; }
__device__ __forceinline__ void rope_cs(const float pf, const f32x4 fr, f32x4& c, f32x4& s) {
#pragma unroll
    for (int j = 0; j < 4; ++j) { const float r = __builtin_amdgcn_fractf(pf * fr[j]); c[j] = __builtin_amdgcn_cosf(r); s[j] = __builtin_amdgcn_sinf(r); }
}
struct EpiProj {
    static constexpr bool PERM = true, AFTER_DRAIN = false;
    bf16_t *QA, *QB, *KB, *VB;
    const float *rs, *sb, *rft; const int* pos; const float *g_qa, *g_qb, *g_kb;
    __device__ __forceinline__ void operator()(const f32x4 (&acc)[2][2][4][2], const Unit& u, int wr, int wc, int fr, int fq) const {
        bf16_t* dst = nullptr; int pitch = 0, coff = 0, mode = 0; const float* g = nullptr; float scale = 1.f;
        const int pn = u.pn;
        if (pn < 2)       { dst = QA; pitch = 512; coff = (pn * 4 + wc) * 64; mode = 2; g = g_qa; scale = C2; }
        else if (pn < 4)  { dst = QB; pitch = 512; coff = ((pn - 2) * 4 + wc) * 64; mode = 2; g = g_qb; scale = C2; }
        else if (pn < 6)  { dst = KB; pitch = 512; coff = ((pn - 4) * 4 + wc) * 64; mode = 2; g = g_kb; }
        else              { dst = VB; pitch = 512; coff = ((pn - 6) * 4 + wc) * 64; mode = 1; }
        if (mode == 0) return;
        const int d0 = 8 * fq;
        f32x4 g0a = {1.f, 1.f, 1.f, 1.f}, g0b = g0a, g1a = g0a, g1b = g0a;
        if (mode == 2) { g0a = *(const f32x4*)(g + d0); g0b = *(const f32x4*)(g + d0 + 4); g1a = *(const f32x4*)(g + 32 + d0); g1b = *(const f32x4*)(g + 36 + d0); }
        const float* sbp = sb + pn * 256 + wc * 32 + d0;
        const f32x4 s0a = *(const f32x4*)sbp, s0b = *(const f32x4*)(sbp + 4), s1a = *(const f32x4*)(sbp + 128), s1b = *(const f32x4*)(sbp + 132);
        const f32x4 fr0 = *(const f32x4*)(rft + d0), fr1 = *(const f32x4*)(rft + d0 + 4);
        float pf[2][4], rr[2][4];
#pragma unroll
        for (int ai = 0; ai < 2; ++ai)
#pragma unroll
            for (int m = 0; m < 4; ++m) { const int row_ = u.pm * BM + ai * HALF + wr * 64 + m * 16 + fr; rr[ai][m] = rs[row_]; pf[ai][m] = mode == 2 ? (float)pos[row_] : 0.f; }
#pragma unroll
        for (int ai = 0; ai < 2; ++ai)
#pragma unroll
            for (int m = 0; m < 4; ++m) {
                const int row = u.pm * BM + ai * HALF + wr * 64 + m * 16 + fr;
                const float r = rr[ai][m];
                f32x4 l0 = cvti4(acc[ai][0][m][0]) * r * s0a, l1 = cvti4(acc[ai][0][m][1]) * r * s0b, h0 = cvti4(acc[ai][1][m][0]) * r * s1a, h1 = cvti4(acc[ai][1][m][1]) * r * s1b;
                if (mode == 2) {
                    float ss = (sq4(l0) + sq4(l1)) + (sq4(h0) + sq4(h1));
                    ss += __shfl_xor(ss, 16); ss += __shfl_xor(ss, 32);
                    const float rn = rsqrtf(ss * (1.f / 64.f) + EPS);
                    l0 = l0 * rn * g0a; l1 = l1 * rn * g0b; h0 = h0 * rn * g1a; h1 = h1 * rn * g1b;
                    f32x4 c0, c1, s0, s1; rope_cs(pf[ai][m], fr0, c0, s0); rope_cs(pf[ai][m], fr1, c1, s1);
                    const f32x4 nl0 = l0 * c0 - h0 * s0, nh0 = h0 * c0 + l0 * s0, nl1 = l1 * c1 - h1 * s1, nh1 = h1 * c1 + l1 * s1;
                    l0 = nl0 * scale; l1 = nl1 * scale; h0 = nh0 * scale; h1 = nh1 * scale;
                }
                bf16_t* p = dst + (size_t)row * pitch + coff + d0;
                st16_wt(p, pack8(l0, l1));
                st16_wt((p + 32), pack8(h0, h1));
            }
    }
};
struct EpiIdx {
    static constexpr bool PERM = true, AFTER_DRAIN = false;
    bf16_t *QIH, *QIL, *KIH, *KIL; float* WI; bf16_t *KA, *VA;
    const float *rs, *rft; const int* pos; const float* g_ka;
    __device__ __forceinline__ void operator()(const f32x4 (&acc)[2][2][4][2], const Unit& u, int wr, int wc, int fr, int fq) const {
        const int pn = u.pn;
        const int d0 = 8 * fq;
        float pfi[2][4], rri[2][4];
#pragma unroll
        for (int ai = 0; ai < 2; ++ai)
#pragma unroll
            for (int m = 0; m < 4; ++m) { const int row_ = u.pm * BM + ai * HALF + wr * 64 + m * 16 + fr; rri[ai][m] = rs[row_]; pfi[ai][m] = (float)pos[row_]; }
        const f32x4 fi0 = *(const f32x4*)(rft + d0), fi1 = *(const f32x4*)(rft + d0 + 4);
        const f32x4 gk0 = *(const f32x4*)(g_ka + d0), gk1 = *(const f32x4*)(g_ka + d0 + 4), gk2 = *(const f32x4*)(g_ka + 32 + d0), gk3 = *(const f32x4*)(g_ka + 36 + d0);
#pragma unroll
        for (int ai = 0; ai < 2; ++ai)
#pragma unroll
            for (int m = 0; m < 4; ++m) {
                const int row = u.pm * BM + ai * HALF + wr * 64 + m * 16 + fr;
                const float r = rri[ai][m];
                f32x4 l0 = acc[ai][0][m][0] * r, l1 = acc[ai][0][m][1] * r, h0 = acc[ai][1][m][0] * r, h1 = acc[ai][1][m][1] * r;
                if (pn == 1 && wc == 1) { if (fq == 0) *(f32x4*)(WI + (size_t)row * 4) = l0 * 0.0625f; continue; }
                if (pn == 1 && wc == 3) { bf16_t* p = VA + (size_t)row * 64 + d0; st16_wt(p, pack8(l0, l1)); st16_wt((p + 32), pack8(h0, h1)); continue; }
                if (pn == 1 && wc == 2) {
                    float ss = (sq4(l0) + sq4(l1)) + (sq4(h0) + sq4(h1));
                    ss += __shfl_xor(ss, 16); ss += __shfl_xor(ss, 32);
                    const float rn = rsqrtf(ss * (1.f / 64.f) + EPS);
                    l0 = l0 * rn * gk0; l1 = l1 * rn * gk1; h0 = h0 * rn * gk2; h1 = h1 * rn * gk3;
                }
                f32x4 c0, c1, s0, s1; rope_cs(pfi[ai][m], fi0, c0, s0); rope_cs(pfi[ai][m], fi1, c1, s1);
                const f32x4 nl0 = l0 * c0 - h0 * s0, nh0 = h0 * c0 + l0 * s0, nl1 = l1 * c1 - h1 * s1, nh1 = h1 * c1 + l1 * s1;
                if (pn == 1 && wc == 2) { bf16_t* p = KA + (size_t)row * 64 + d0; st16_wt(p, pack8(nl0, nl1)); st16_wt((p + 32), pack8(nh0, nh1)); continue; }
                bf16_t* ph = pn == 0 ? QIH + (size_t)row * 256 + wc * 64 + d0 : KIH + (size_t)row * 64 + d0;
                st16_wt(ph, pack8(nl0, nl1)); st16_wt((ph + 32), pack8(nh0, nh1));
            }
    }
};
template <bool I8> __device__ __forceinline__ f32x4 mma16(const bf16x8 b, const bf16x8 a, const f32x4 c) {
    if constexpr (I8) { typedef int i32x4_ __attribute__((ext_vector_type(4)));
        return __builtin_bit_cast(f32x4, __builtin_amdgcn_mfma_i32_16x16x64_i8(__builtin_bit_cast(i32x4_, b), __builtin_bit_cast(i32x4_, a), __builtin_bit_cast(i32x4_, c), 0, 0, 0)); }
    else return __builtin_amdgcn_mfma_f32_16x16x32_bf16(b, a, c, 0, 0, 0);
}
typedef int frag32 __attribute__((ext_vector_type(8)));
typedef int frag16 __attribute__((ext_vector_type(4)));
template <class Epi, class Sched, bool ALIGN_EPI = false, bool SP2 = false, int I8 = 0>
__device__ __forceinline__ void gemm_phase(PG8_LAS unsigned char* lds, const Gemm g, const Sched& S, const Epi& E, const int wid) {
    const int lane = lane_id(), tid = wid * 64 + lane, wr = wid >> 2, wc = wid & 3, fr = lane & 15, fq = lane >> 4;
    const int nt = g.K / BK; const unsigned amask = g.amask;
    unsigned voffA[2], voffB[2];
#pragma unroll
    for (int i = 0; i < 2; ++i) { int R, C; stage_rc(tid * 16 + i * 8192, R, C); const int Rb = Epi::PERM ? ((R & ~31) + perm32(R & 31)) : R;
        voffA[i] = (unsigned)(R * g.lda + C) * 2u; voffB[i] = (unsigned)(Rb * g.ldb + C) * 2u; }
    const size_t kstep = (size_t)(BK * 2);
    const size_t hstepA = (size_t)HALF * g.lda * 2, hstepB = (size_t)HALF * g.ldb * 2;
#define PG8_AK(tau) ((size_t)(((unsigned)(tau) * 128u) & amask))
    const unsigned ldsw = (unsigned)wid * 1024u;
    const int aoff = lds_byte(wr * 64 + fr, fq * 8), boff = lds_byte(wc * 32 + fr, fq * 8);
#define PG8_SA(b, h) (((b) * 2 + (h)) * HTB)
#define PG8_SB(b, h) ((4 + (b) * 2 + (h)) * HTB)
#define PG8_STAGE(bufoff, gbase, voff) do { const char* gb_ = uptr(gbase); _Pragma("unroll") for (int _i = 0; _i < 2; ++_i) \
        __builtin_amdgcn_global_load_lds((const unsigned*)(gb_ + (voff)[_i]), (PG8_LAS unsigned*)(lds + (bufoff) + ldsw + _i * 8192), 16, 0, 0); } while (0)
#define PG8_LDA(dst, b, h) do { _Pragma("unroll") for (int m = 0; m < 4; ++m) { dst[m].lo = *(const PG8_LAS frag16*)(lds + PG8_SA(b, h) + aoff + m * 2048); dst[m].hi = *(const PG8_LAS frag16*)(lds + PG8_SA(b, h) + aoff + m * 2048 + 1024); } } while (0)
#define PG8_LDB(dst, b, h) do { _Pragma("unroll") for (int n = 0; n < 2; ++n) { dst[n].lo = *(const PG8_LAS frag16*)(lds + PG8_SB(b, h) + boff + n * 2048); dst[n].hi = *(const PG8_LAS frag16*)(lds + PG8_SB(b, h) + boff + n * 2048 + 1024); } } while (0)
#define PG8_MMA(ai, bj, At, Bt) do { __builtin_amdgcn_s_setprio(1); _Pragma("unroll") for (int m = 0; m < 4; ++m) _Pragma("unroll") for (int n = 0; n < 2; ++n) { \
        if constexpr (I8 == 2) acc[ai][bj][m][n] = __builtin_amdgcn_mfma_scale_f32_16x16x128_f8f6f4(Bt[n], At[m], acc[ai][bj][m][n], 0, 0, 0, 0, 0, 0);        \
        else { acc[ai][bj][m][n] = mma16<I8 == 1>(__builtin_bit_cast(bf16x8, (frag16)Bt[n].lo), __builtin_bit_cast(bf16x8, (frag16)At[m].lo), acc[ai][bj][m][n]); \
               acc[ai][bj][m][n] = mma16<I8 == 1>(__builtin_bit_cast(bf16x8, (frag16)Bt[n].hi), __builtin_bit_cast(bf16x8, (frag16)At[m].hi), acc[ai][bj][m][n]); } } __builtin_amdgcn_s_setprio(0); } while (0)
#define PG8_WAIT_V(n) asm volatile("s_waitcnt vmcnt(" #n ")" ::: "memory")
#define PG8_WAIT_L(n) asm volatile("s_waitcnt lgkmcnt(" #n ")" ::: "memory")
#define PG8_BAR __builtin_amdgcn_s_barrier()
#define PG8_SCHED __builtin_amdgcn_sched_barrier(0)
    Unit cur, nxt; int ui = 0;
    if (!S.next(0, cur)) return;
    f32x4 acc[2][2][4][2];
#pragma unroll
    for (int a = 0; a < 2; ++a)
#pragma unroll
        for (int b = 0; b < 2; ++b)
#pragma unroll
            for (int m = 0; m < 4; ++m)
#pragma unroll
                for (int n = 0; n < 2; ++n) acc[a][b][m][n] = (f32x4){0.f, 0.f, 0.f, 0.f};
    frag32 At[4], B0[2], B1[2];
    const char* cA = (const char*)g.A + cur.ao; const char* cB = (const char*)g.Bt + cur.bo;
    S.a_ready(cur);
    if constexpr (SP2) {
        PG8_STAGE(PG8_SB(0, 0), cB, voffB); PG8_STAGE(PG8_SB(0, 1), cB + hstepB, voffB); PG8_STAGE(PG8_SA(0, 0), cA, voffA); PG8_STAGE(PG8_SA(0, 1), cA + hstepA, voffA);
        if (wr == 1) PG8_BAR;
        PG8_WAIT_V(2); PG8_BAR;
        PG8_STAGE(PG8_SB(1, 0), cB + kstep, voffB); PG8_STAGE(PG8_SA(1, 0), cA + PG8_AK(1), voffA); PG8_STAGE(PG8_SB(1, 1), cB + hstepB + kstep, voffB);
        PG8_WAIT_V(6); PG8_BAR;
    } else {
        PG8_STAGE(PG8_SB(0, 0), cB, voffB); PG8_STAGE(PG8_SA(0, 0), cA, voffA); PG8_STAGE(PG8_SB(0, 1), cB + hstepB, voffB); PG8_STAGE(PG8_SA(0, 1), cA + hstepA, voffA);
        if (wr == 1) PG8_BAR;
        PG8_WAIT_V(4); PG8_BAR;
        PG8_STAGE(PG8_SB(1, 0), cB + kstep, voffB); PG8_STAGE(PG8_SA(1, 0), cA + PG8_AK(1), voffA); PG8_STAGE(PG8_SB(1, 1), cB + hstepB + kstep, voffB);
        PG8_WAIT_V(6); PG8_BAR;
    }
    for (;;) {
        const bool has_next = S.next(ui + 1, nxt);
        const char* nA = has_next ? (const char*)g.A + nxt.ao : cA; const char* nB = has_next ? (const char*)g.Bt + nxt.bo : cB;
        for (int t = 0; t < nt; t += 2) {
            const bool last = (t == nt - 2);
            const char* a1 = cA + PG8_AK(t + 1);
            const char* a2 = last ? nA : cA + PG8_AK(t + 2); const char* b2 = last ? nB : cB + (size_t)(t + 2) * kstep;
            const char* a3 = last ? nA + PG8_AK(1) : cA + PG8_AK(t + 3); const char* b3 = b2 + kstep;
            if (last && has_next) S.a_ready(nxt);
            if constexpr (SP2) {
            PG8_LDB(B0, 0, 0); PG8_LDB(B1, 0, 1); PG8_SCHED; PG8_LDA(At, 0, 0); PG8_STAGE(PG8_SA(1, 1), a1 + hstepA, voffA);
            PG8_WAIT_V(8); PG8_WAIT_L(0); PG8_BAR; PG8_MMA(0, 0, At, B0); PG8_MMA(0, 1, At, B1); PG8_BAR; PG8_SCHED;
            PG8_LDA(At, 0, 1); PG8_STAGE(PG8_SB(0, 0), b2, voffB); PG8_STAGE(PG8_SB(0, 1), b2 + hstepB, voffB); PG8_STAGE(PG8_SA(0, 0), a2, voffA);
            PG8_WAIT_V(8); PG8_WAIT_L(0); PG8_BAR; PG8_MMA(1, 0, At, B0); PG8_MMA(1, 1, At, B1); PG8_BAR; PG8_SCHED;
            PG8_LDB(B0, 1, 0); PG8_LDB(B1, 1, 1); PG8_SCHED; PG8_LDA(At, 1, 0); PG8_STAGE(PG8_SA(0, 1), a2 + hstepA, voffA);
            PG8_WAIT_V(8); PG8_WAIT_L(0); PG8_BAR; PG8_MMA(0, 0, At, B0); PG8_MMA(0, 1, At, B1); PG8_BAR; PG8_SCHED;
            PG8_LDA(At, 1, 1); PG8_STAGE(PG8_SB(1, 0), b3, voffB); PG8_STAGE(PG8_SB(1, 1), b3 + hstepB, voffB); PG8_STAGE(PG8_SA(1, 0), a3, voffA);
            PG8_WAIT_V(8); PG8_WAIT_L(0); PG8_BAR; PG8_MMA(1, 0, At, B0); PG8_MMA(1, 1, At, B1); PG8_BAR; PG8_SCHED;
            } else {
            PG8_LDB(B0, 0, 0); PG8_SCHED; PG8_LDA(At, 0, 0); PG8_STAGE(PG8_SA(1, 1), a1 + hstepA, voffA);
            PG8_WAIT_L(8); PG8_BAR; PG8_WAIT_L(0); PG8_MMA(0, 0, At, B0); PG8_BAR; PG8_SCHED;
            PG8_LDB(B1, 0, 1); PG8_STAGE(PG8_SB(0, 0), b2, voffB);
            PG8_BAR; PG8_WAIT_L(0); PG8_MMA(0, 1, At, B1); PG8_BAR;
            PG8_LDA(At, 0, 1); PG8_STAGE(PG8_SA(0, 0), a2, voffA);
            PG8_BAR; PG8_WAIT_L(0); PG8_MMA(1, 0, At, B0); PG8_BAR; PG8_SCHED;
            PG8_STAGE(PG8_SB(0, 1), b2 + hstepB, voffB);
            PG8_WAIT_V(6); PG8_BAR; PG8_MMA(1, 1, At, B1); PG8_BAR;
            PG8_LDB(B0, 1, 0); PG8_SCHED; PG8_LDA(At, 1, 0); PG8_STAGE(PG8_SA(0, 1), a2 + hstepA, voffA);
            PG8_WAIT_L(8); PG8_BAR; PG8_WAIT_L(0); PG8_MMA(0, 0, At, B0); PG8_BAR; PG8_SCHED;
            PG8_LDB(B1, 1, 1); PG8_STAGE(PG8_SB(1, 0), b3, voffB);
            PG8_BAR; PG8_WAIT_L(0); PG8_MMA(0, 1, At, B1); PG8_BAR;
            PG8_LDA(At, 1, 1); PG8_STAGE(PG8_SA(1, 0), a3, voffA);
            PG8_BAR; PG8_WAIT_L(0); PG8_MMA(1, 0, At, B0); PG8_BAR; PG8_SCHED;
            PG8_STAGE(PG8_SB(1, 1), b3 + hstepB, voffB);
            PG8_WAIT_V(6); PG8_BAR; PG8_MMA(1, 1, At, B1); PG8_BAR;
            }
        }
        if constexpr (ALIGN_EPI) { if (wr == 0) PG8_BAR; }
        if constexpr (!Epi::AFTER_DRAIN) { E(acc, cur, wr, wc, fr, fq); S.done(cur); }
        if (!has_next) break;
#pragma unroll
        for (int a = 0; a < 2; ++a)
#pragma unroll
            for (int b = 0; b < 2; ++b)
#pragma unroll
                for (int m = 0; m < 4; ++m)
#pragma unroll
                    for (int n = 0; n < 2; ++n) acc[a][b][m][n] = (f32x4){0.f, 0.f, 0.f, 0.f};
        cur = nxt; cA = nA; cB = nB; ++ui;
        if constexpr (ALIGN_EPI) { if (wr == 1) PG8_BAR; }
    }
    PG8_WAIT_V(0);
    if constexpr (!ALIGN_EPI) { if (wr == 0) PG8_BAR; }
    PG8_BAR;
    if constexpr (Epi::AFTER_DRAIN) { E.fused(acc, cur, wr, wc, fr, fq, lds, wid, lane); S.done(cur); }
#undef PG8_AK
#undef PG8_SA
#undef PG8_SB
#undef PG8_STAGE
#undef PG8_LDA
#undef PG8_LDB
#undef PG8_MMA
#undef PG8_WAIT_V
#undef PG8_WAIT_L
#undef PG8_BAR
#undef PG8_SCHED
}
}
constexpr int NWAVES = 8;
constexpr size_t MiB = 1u << 20;
constexpr size_t WS_CTL = 0, CTL_ZERO_BYTES = 1 * MiB;
constexpr size_t WS_W1T = 1 * MiB;
constexpr size_t WS_WIT = 6 * MiB;
constexpr size_t WS_WOUT = 9 * MiB;
constexpr size_t WS_WXQ = 11 * MiB;
constexpr size_t WS_WXKV = 13 * MiB;
constexpr size_t WS_WXO = 17 * MiB;
constexpr size_t WS_WF1 = 19 * MiB;
constexpr size_t WS_WF2 = 30 * MiB;
constexpr size_t WS_CT = 36 * MiB, WS_ST = 40 * MiB;
constexpr size_t WS_RFT = 44 * MiB + 200 * 1024;
constexpr size_t WS_RS0 = 44 * MiB;
constexpr size_t WS_RSM = 44 * MiB + 128 * 1024;
constexpr size_t WS_LAM = 44 * MiB + 192 * 1024;
constexpr size_t WS_SS1 = 45 * MiB, WS_SS2 = 47 * MiB;
constexpr size_t WS_MEMB = 49 * MiB;
constexpr size_t WS_KX = 57 * MiB;
constexpr size_t WS_VXT = 65 * MiB;
constexpr size_t WS_MASK = 73 * MiB;
constexpr size_t WS_WI = 81 * MiB;
constexpr size_t WS_KIH = 82 * MiB, WS_KIL = 86 * MiB, WS_KA = 90 * MiB, WS_VA = 94 * MiB;
constexpr size_t WS_QIH = 98 * MiB, WS_QIL = 114 * MiB;
constexpr size_t WS_QA = 130 * MiB, WS_QB = 162 * MiB, WS_KB = 194 * MiB, WS_VB = 226 * MiB;
constexpr size_t WS_A2 = 258 * MiB;
constexpr size_t WS_ATT = 386 * MiB;
constexpr size_t WS_END = 512 * MiB;
constexpr int CW_BAR = 4096;

constexpr int RING_OFF = 0, RING_BYTES = 131072;
constexpr int LDSCTL_OFF = RING_BYTES, MISC_OFF = LDSCTL_OFF + 320, LDSX_OFF = RING_BYTES + 1024;
constexpr int LDS_BYTES = 147456;

#define GAS __attribute__((address_space(1)))
#define LAS __attribute__((address_space(3)))
typedef unsigned short bf16;
typedef unsigned v4u __attribute__((ext_vector_type(4)));
typedef unsigned v2u __attribute__((ext_vector_type(2)));
typedef float f32x4 __attribute__((ext_vector_type(4)));
typedef short bf16x8 __attribute__((ext_vector_type(8)));
#define LDS_WAIT() asm volatile("s_waitcnt lgkmcnt(0)" ::: "memory")
#define VM_WAIT() asm volatile("s_waitcnt vmcnt(0)" ::: "memory")
__device__ __forceinline__ unsigned f2bf(float f) { unsigned u = __builtin_bit_cast(unsigned, f); return (u + 0x7fffu + ((u >> 16) & 1u)) >> 16; }
__device__ __forceinline__ unsigned pk2(float lo, float hi) { return f2bf(lo) | (f2bf(hi) << 16); }
__device__ __forceinline__ int lane_now() { int l; asm volatile("v_mbcnt_lo_u32_b32 %0, -1, 0\n\tv_mbcnt_hi_u32_b32 %0, -1, %0" : "=v"(l)); return l; }
__device__ __forceinline__ float bf2f(bf16 b) { return __uint_as_float((unsigned)b << 16); }
#define XB_TMO      128
#define XB_XCNT(j)  (256  + 64 * (j))
#define XB_XSUB(j)  (1280 + 64 * (j))
#define XB_XGEN(j)  (2304 + 64 * (j))
#define XB_TOP      3328
#define XB_TOPGEN   3392
#define XCD_BAR_WORDS 3456
#define XB_SPIN_CAP (1u << 18)

__device__ __forceinline__ unsigned xb_ld(unsigned* p)              { return __hip_atomic_load(p, __ATOMIC_RELAXED, __HIP_MEMORY_SCOPE_AGENT); }
__device__ __forceinline__ unsigned xb_add(unsigned* p, unsigned v) { return __hip_atomic_fetch_add(p, v, __ATOMIC_RELAXED, __HIP_MEMORY_SCOPE_AGENT); }
__device__ __forceinline__ unsigned xb_xcc_id() { return (unsigned)__builtin_amdgcn_s_getreg((3 << 11) | 20) & 0xFu; }
#define XB_SPIN(cond, bar) do { unsigned _sp = 0; while (cond) { __builtin_amdgcn_s_sleep(1); \
    if ((++_sp & 255u) == 0u) { if (xb_ld(&(bar)[XB_TMO])) break; if (_sp > XB_SPIN_CAP) { atomicAdd(&(bar)[XB_TMO], 1u); break; } } } } while (0)

struct XcdBarrier {
    unsigned* bar; unsigned x; int wave;
    volatile LAS unsigned* st;
};

__device__ __forceinline__ XcdBarrier xcd_barrier_post(unsigned* bar, volatile LAS unsigned* st, int wave) {
    XcdBarrier b; b.bar = bar; b.x = xb_xcc_id(); b.st = st; b.wave = wave;
    if (wave == 0 && lane_now() == 0) st[2] = xb_add(&bar[XB_XCNT(b.x)], 1u);
    return b;
}
__device__ __forceinline__ void xcd_barrier_complete(unsigned* bar, unsigned x, unsigned& nloc, unsigned& nx, unsigned& mode, unsigned& xi) {
    const unsigned G = gridDim.x * gridDim.y * gridDim.z;
    unsigned sum, cnt, mine, sp = 0u, even, below;
    for (;;) {
        sum = 0u; cnt = 0u; mine = 0u; even = 1u; below = 0u;
#pragma unroll
        for (unsigned j = 0; j < 16; ++j) { const unsigned c = xb_ld(&bar[XB_XCNT(j)]); sum += c; cnt += (c > 0u) ? 1u : 0u; mine = (j == x) ? c : mine;
            if (c > 0u && c * 8u != G) even = 0u; if (c > 0u && j < x) ++below; }
        if (sum == G) break;
        __builtin_amdgcn_s_sleep(1);
        if ((++sp & 255u) == 0u) { if (xb_ld(&bar[XB_TMO])) break; if (sp > XB_SPIN_CAP) { atomicAdd(&bar[XB_TMO], 1u); break; } }
    }
    nloc = mine > 0u ? mine : 1u; nx = cnt > 0u ? cnt : 1u;
    mode = (sum == G && cnt == 8u && even) ? 2u : 1u; xi = below;
}

__device__ __forceinline__ void xcd_barrier(const XcdBarrier& b) {
    asm volatile("s_waitcnt vmcnt(0)" ::: "memory");
    __syncthreads();
    if (b.wave == 0 && lane_now() == 0) {
        unsigned* bar = b.bar;
        __builtin_amdgcn_s_waitcnt(0);
        unsigned nloc = b.st[0], nx = b.st[1];
        if (nloc == 0u) { unsigned mode, xi; xcd_barrier_complete(bar, b.x, nloc, nx, mode, xi); b.st[0] = nloc; b.st[1] = nx; b.st[3] = mode; b.st[4] = xi; }
        const unsigned old = xb_add(&bar[XB_XSUB(b.x)], 1u);
        const unsigned gen = old / nloc;
        if (old + 1u == (gen + 1u) * nloc) {
            __builtin_amdgcn_fence(__ATOMIC_RELEASE, "agent");
            asm volatile("s_waitcnt vmcnt(0)" ::: "memory");
            const unsigned og = xb_add(&bar[XB_TOP], 1u);
            const unsigned tg = og / nx;
            if (og + 1u == (tg + 1u) * nx) xb_add(&bar[XB_TOPGEN], 1u);
            else XB_SPIN(xb_ld(&bar[XB_TOPGEN]) == tg, bar);
            __builtin_amdgcn_fence(__ATOMIC_ACQUIRE, "agent");
            xb_add(&bar[XB_XGEN(b.x)], 1u);
            asm volatile("s_waitcnt vmcnt(0)" ::: "memory");
        } else {
            XB_SPIN(xb_ld(&bar[XB_XGEN(b.x)]) == gen, bar);
            __builtin_amdgcn_fence(__ATOMIC_ACQUIRE, "agent");
            asm volatile("s_waitcnt vmcnt(0)" ::: "memory");
        }
    }
    __syncthreads();
}
__device__ __forceinline__ void xcd_barrier_local(const XcdBarrier& b) {
    asm volatile("s_waitcnt vmcnt(0)" ::: "memory");
    __syncthreads();
    if (b.wave == 0 && lane_now() == 0) {
        unsigned* bar = b.bar;
        __builtin_amdgcn_s_waitcnt(0);
        const unsigned nloc = b.st[0];
        const unsigned old = xb_add(&bar[XB_XSUB(b.x)], 1u);
        const unsigned gen = old / nloc;
        if (old + 1u == (gen + 1u) * nloc) xb_add(&bar[XB_XGEN(b.x)], 1u);
        else XB_SPIN(xb_ld(&bar[XB_XGEN(b.x)]) == gen, bar);
        __builtin_amdgcn_fence(__ATOMIC_ACQUIRE, "agent");
        asm volatile("s_waitcnt vmcnt(0)" ::: "memory");
    }
    __syncthreads();
}
struct Args { const void* in[27]; float* out; unsigned char* ws; RopeF rf; int ph_lo, ph_hi; };
struct Frame {
    LAS unsigned char* lds;
    int wave, vcu, G;
    int vb, xl, xrank, xidx;
    unsigned char* ws; float* out;
};
#define WSP(T, off) ((T*)(F.ws + (off)))

__device__ __forceinline__ void sincos_acc(float ang, float& c, float& s) {
    const double a = (double)ang;
    const double k = rint(a * 0.63661977236758134308);
    double r = fma(-k, 1.57079632679489655800e+00, a);
    r = fma(-k, 6.12323399573676603587e-17, r);
    const double r2 = r * r;
    double sp = -1.0 / 1307674368000.0;
    sp = fma(sp, r2, 1.0 / 6227020800.0); sp = fma(sp, r2, -1.0 / 39916800.0); sp = fma(sp, r2, 1.0 / 362880.0); sp = fma(sp, r2, -1.0 / 5040.0);
    sp = fma(sp, r2, 1.0 / 120.0); sp = fma(sp, r2, -1.0 / 6.0); sp = fma(sp, r2, 1.0);
    const double sn = sp * r;
    double cp = 1.0 / 20922789888000.0;
    cp = fma(cp, r2, -1.0 / 87178291200.0); cp = fma(cp, r2, 1.0 / 479001600.0); cp = fma(cp, r2, -1.0 / 3628800.0); cp = fma(cp, r2, 1.0 / 40320.0);
    cp = fma(cp, r2, -1.0 / 720.0); cp = fma(cp, r2, 1.0 / 24.0); cp = fma(cp, r2, -0.5);
    const double cs = fma(cp, r2, 1.0);
    const int q = ((int)k) & 3;
    double cc, ss;
    if (q == 0) { cc = cs; ss = sn; } else if (q == 1) { cc = -sn; ss = cs; } else if (q == 2) { cc = -cs; ss = -sn; } else { cc = sn; ss = -cs; }
    c = (float)cc; s = (float)ss;
}

__device__ __forceinline__ int srcmap(int mat, int r) {
    if (mat == 0 || mat == 1) {
        const int tile = r >> 8, cpos = r & 255, slot = (cpos >> 5) & 3, dim = ((cpos >> 7) << 5) | (cpos & 31);
        if (mat == 0) {
            if (tile < 2) return OFF_QA + (tile * 4 + slot) * 64 + dim;
            if (tile < 4) return OFF_QB + ((tile - 2) * 4 + slot) * 64 + dim;
            if (tile < 6) return OFF_KB + ((tile - 4) * 4 + slot) * 64 + dim;
            return OFF_VB + ((tile - 6) * 4 + slot) * 64 + dim;
        }
        if (tile == 0) return OFF_QI + slot * 64 + dim;
        if (slot == 0) return OFF_KI + dim;
        if (slot == 1) return dim < 4 ? OFF_WI + dim : -1;
        return slot == 2 ? OFF_KA + dim : OFF_VA + dim;
    }
    if (mat == 7) { const int tile = r >> 8, half = (r >> 7) & 1, within = r & 127; return half * DFF + tile * 128 + within; }
    return r;
}
__device__ __forceinline__ void p0_item(const float* W, int ldw, const float* g, bf16* WT, int ldd, int row_off, int mat, bool split, LAS float* scr, int item, int nkb, int lane) {
    const int rb = item / nkb, kb = item % nkb, k0 = 64 * kb, r0 = 32 * rb;
    const int src = srcmap(mat, r0 + (lane & 31));
    float wv[32];
    const float* wp = W + (size_t)(k0 + (lane >> 5)) * ldw + (src >= 0 ? src : 0);
#pragma unroll
    for (int i = 0; i < 32; ++i) wv[i] = __builtin_nontemporal_load(wp + (size_t)(2 * i) * ldw);
    const float gz = src >= 0 ? 1.f : 0.f;
#pragma unroll
    for (int i = 0; i < 32; ++i) { const int kk = 2 * i + (lane >> 5);
        float v = wv[i] * gz; if (g) v *= g[k0 + kk];
        scr[kk * 33 + (lane & 31)] = v; }
    LDS_WAIT(); asm volatile("" ::: "memory");
    const int c = lane & 7;
#pragma unroll
    for (int j = 0; j < 4; ++j) { const int n = (lane >> 3) + 8 * j; const LAS float* s = scr + (8 * c) * 33 + n;
        const float v0 = s[0 * 33], v1 = s[1 * 33], v2 = s[2 * 33], v3 = s[3 * 33], v4 = s[4 * 33], v5 = s[5 * 33], v6 = s[6 * 33], v7 = s[7 * 33];
        v4u o; o.x = pk2(v0, v1); o.y = pk2(v2, v3); o.z = pk2(v4, v5); o.w = pk2(v6, v7);
        bf16* d = WT + (size_t)(row_off + r0 + n) * ldd + k0 + 8 * c;
        *(GAS v4u*)d = o;
        if (split) {
            *(GAS v4u*)(d + 1024) = o;
            v4u l; l.x = pk2(v0 - __uint_as_float(o.x << 16), v1 - __uint_as_float(o.x & 0xffff0000u)); l.y = pk2(v2 - __uint_as_float(o.y << 16), v3 - __uint_as_float(o.y & 0xffff0000u));
            l.z = pk2(v4 - __uint_as_float(o.z << 16), v5 - __uint_as_float(o.z & 0xffff0000u)); l.w = pk2(v6 - __uint_as_float(o.w << 16), v7 - __uint_as_float(o.w & 0xffff0000u));
            *(GAS v4u*)(d + 2048) = l;
        } }
    LDS_WAIT(); asm volatile("" ::: "memory");
}
constexpr size_t WS_X8 = 386 * MiB;
constexpr size_t WS_W1Q = 482 * MiB;
constexpr size_t WS_SBW1 = 484 * MiB;
constexpr size_t WS_RSX8 = 485 * MiB;
constexpr size_t WS_MEM8 = 36 * MiB;
constexpr size_t WS_RSM8 = 40 * MiB;
constexpr size_t WS_WXKV8 = 41 * MiB;
constexpr size_t WS_SBKV = 43 * MiB;
constexpr size_t WS_W8Q = 486 * MiB, WS_SB8Q = 492 * MiB;
constexpr int CW_W1Q = 2048;
__device__ __forceinline__ unsigned q8x4(const f32x4 v, float inv) {
    const unsigned a = __float_as_uint(fmaf(v.x, inv, 12582912.f)), b = __float_as_uint(fmaf(v.y, inv, 12582912.f)), c = __float_as_uint(fmaf(v.z, inv, 12582912.f)), d = __float_as_uint(fmaf(v.w, inv, 12582912.f));
    return __builtin_amdgcn_perm(__builtin_amdgcn_perm(d, c, 0x0c0c0400u), __builtin_amdgcn_perm(b, a, 0x0c0c0400u), 0x05040100u);
}
__device__ __forceinline__ void p0_xrow_store(Frame& F, int m, const f32x4 (&v)[4], float s) {
    s = wave_sum(s);
    float mx = 0.f;
#pragma unroll
    for (int j = 0; j < 4; ++j) mx = fmaxf(mx, fmaxf(fmaxf(fabsf(v[j].x), fabsf(v[j].y)), fmaxf(fabsf(v[j].z), fabsf(v[j].w))));
    mx = wave_max(mx);
    const float rrow = rsqrtf(s * (1.f / DM) + EPS), inv = mx > 0.f ? 127.f / mx : 0.f;
    if (lane_now() == 0) { WSP(float, WS_RS0)[m] = rrow; WSP(float, WS_RSX8)[m] = rrow * (mx * (1.f / 127.f)); }
    {
        GAS unsigned* o4 = (GAS unsigned*)(WSP(unsigned char, WS_X8) + (size_t)m * 1024) + lane_now();
#pragma unroll
        for (int j = 0; j < 4; ++j) o4[64 * j] = q8x4(v[j], inv);
    }
    GAS v2u* o8 = (GAS v2u*)(WSP(bf16, WS_A2) + (size_t)m * 2048) + lane_now();
#pragma unroll
    for (int j = 0; j < 4; ++j) {
        v2u h; h.x = pk2(v[j].x, v[j].y); h.y = pk2(v[j].z, v[j].w);
        o8[64 * j] = h;
    }
}
__device__ __forceinline__ void p0_prologue(Frame& F, const Args& A) {
    const int NH = F.G * NWAVES;
    const int gw = F.vcu * NWAVES + F.wave;
    for (int pass = 0; pass < 2; ++pass) {
    if ((pass ^ (F.wave & 1)) == 0) {
        LAS float* scr = (LAS float*)(F.lds + RING_OFF + F.wave * 16384);
        const float* w_in = (const float*)A.in[4]; const float* g_mix = (const float*)A.in[3];
        constexpr int I0 = 64 * 16, I1 = 16 * 16, I2 = 512, I7 = 176 * 16, I8 = 32 * 44;
        constexpr int NITEMS = I0 + I1 + 5 * I2 + I7 + I8;
        for (int it = gw; it < NITEMS; it += NH) {
            int r = it;
            if (r < I0) { p0_item(w_in, INC, g_mix, WSP(bf16, WS_W1T), 1024, 0, 0, false, scr, r, 16, lane_now()); continue; } r -= I0;
            if (r < I1) { p0_item(w_in, INC, g_mix, WSP(bf16, WS_W1T), 1024, 2048, 1, false, scr, r, 16, lane_now()); continue; } r -= I1;
            if (r < I2) { p0_item((const float*)A.in[13], DM, nullptr, WSP(bf16, WS_WOUT), 1024, 0, 2, false, scr, r, 16, lane_now()); continue; } r -= I2;
            if (r < I2) { p0_item((const float*)A.in[16], DM, (const float*)A.in[14], WSP(bf16, WS_WXQ), 1024, 0, 3, false, scr, r, 16, lane_now()); continue; } r -= I2;
            if (r < I2) { p0_item((const float*)A.in[17], DM, (const float*)A.in[15], WSP(bf16, WS_WXKV), 1024, 0, 4, false, scr, r, 16, lane_now()); continue; } r -= I2;
            if (r < I2) { p0_item((const float*)A.in[18], DM, (const float*)A.in[15], WSP(bf16, WS_WXKV), 1024, 1024, 5, false, scr, r, 16, lane_now()); continue; } r -= I2;
            if (r < I2) { p0_item((const float*)A.in[19], DM, nullptr, WSP(bf16, WS_WXO), 1024, 0, 6, false, scr, r, 16, lane_now()); continue; } r -= I2;
            if (r < I7) { p0_item((const float*)A.in[23], 2 * DFF, (const float*)A.in[22], WSP(bf16, WS_WF1), 1024, 0, 7, false, scr, r, 16, lane_now()); continue; } r -= I7;
            p0_item((const float*)A.in[26], DM, nullptr, WSP(bf16, WS_WF2), DFF, 0, 8, false, scr, r, 44, lane_now());
        }
        if (blockIdx.x == 0 && F.wave == 1 && lane_now() < 32) WSP(float, WS_RFT)[lane_now()] = A.rf.f[lane_now()] * 0.15915494309189535f;
        if (blockIdx.x == 0 && F.wave == 0) {
            const float a = ((const float*)A.in[9])[lane_now()] * ((const float*)A.in[10])[lane_now()], b = ((const float*)A.in[11])[lane_now()] * ((const float*)A.in[12])[lane_now()];
            const float l1 = wave_sum(a), l2 = wave_sum(b);
            if (lane_now() == 0) WSP(float, WS_LAM)[0] = expf(l1) - expf(l2) + 0.2f;
        }
    } else {
        const float* x = (const float*)A.in[0];
        for (int m = gw; m < NTOK; m += 4 * NH) {
            f32x4 v[4][4];
#pragma unroll
            for (int k = 0; k < 4; ++k) { const int mk = m + k * NH < NTOK ? m + k * NH : m; const GAS f32x4* xr = (const GAS f32x4*)(x + (size_t)mk * DM) + lane_now();
#pragma unroll
                for (int j = 0; j < 4; ++j) v[k][j] = __builtin_nontemporal_load(xr + 64 * j); }
#pragma unroll
            for (int k = 0; k < 4; ++k) { if (m + k * NH >= NTOK) break;
                float s = 0.f;
#pragma unroll
                for (int j = 0; j < 4; ++j) s += (v[k][j].x * v[k][j].x + v[k][j].y * v[k][j].y) + (v[k][j].z * v[k][j].z + v[k][j].w * v[k][j].w);
                p0_xrow_store(F, m + k * NH, v[k], s); }
        }
        const float* mem = (const float*)A.in[1];
        for (int m = gw; m < NMTOK; m += NH) {
            const GAS f32x4* xr = (const GAS f32x4*)(mem + (size_t)m * DM) + lane_now();
            f32x4 v[4]; float s = 0.f, mx = 0.f;
#pragma unroll
            for (int j = 0; j < 4; ++j) { v[j] = xr[64 * j]; s += (v[j].x * v[j].x + v[j].y * v[j].y) + (v[j].z * v[j].z + v[j].w * v[j].w);
                mx = fmaxf(mx, fmaxf(fmaxf(fabsf(v[j].x), fabsf(v[j].y)), fmaxf(fabsf(v[j].z), fabsf(v[j].w)))); }
            s = wave_sum(s); mx = wave_max(mx);
            const float inv = mx > 0.f ? 127.f / mx : 0.f;
            if (lane_now() == 0) WSP(float, WS_RSM8)[m] = rsqrtf(s * (1.f / DM) + EPS) * (mx * (1.f / 127.f));
            GAS unsigned* o4 = (GAS unsigned*)(WSP(unsigned char, WS_MEM8) + (size_t)m * 1024) + lane_now();
#pragma unroll
            for (int j = 0; j < 4; ++j) o4[64 * j] = q8x4(v[j], inv);
        }
    }
    }
}

__device__ __forceinline__ float quant_row16(const v4u a, const v4u b, unsigned char* dst, int lane) {
    float v[16];
#pragma unroll
    for (int i = 0; i < 4; ++i) { v[2 * i] = __uint_as_float(a[i] << 16); v[2 * i + 1] = __uint_as_float(a[i] & 0xffff0000u); v[8 + 2 * i] = __uint_as_float(b[i] << 16); v[8 + 2 * i + 1] = __uint_as_float(b[i] & 0xffff0000u); }
    float mx = 0.f;
#pragma unroll
    for (int i = 0; i < 16; ++i) mx = fmaxf(mx, fabsf(v[i]));
    mx = wave_max(mx);
    const float inv = mx > 0.f ? 127.f / mx : 0.f;
    v4u q;
#pragma unroll
    for (int w = 0; w < 4; ++w) q[w] = q8x4((f32x4){v[4 * w], v[4 * w + 1], v[4 * w + 2], v[4 * w + 3]}, inv);
    *(GAS v4u*)(dst + 16 * lane) = q;
    return mx * (1.f / 127.f);
}
__device__ __forceinline__ void p1_proj(Frame& F, const Args& A) {
    const float* rs = WSP(float, WS_RS0); const float* ct = WSP(float, WS_RFT); const int* st = (const int*)A.in[2];
    unsigned* ctr = (unsigned*)(F.ws + WS_CTL) + CW_W1Q;
    {
        for (int r = (int)blockIdx.x * NWAVES + F.wave; r < 4096 + 2 * DFF; r += F.G * NWAVES) {
            const int sel = r >= 4096 ? 2 : (r >= 2048 ? 1 : 0); const int rr = r - 2048 * sel;
            const bf16* src = (sel == 2 ? WSP(bf16, WS_WF1) : sel == 1 ? WSP(bf16, WS_WXKV) : WSP(bf16, WS_W1T)) + (size_t)rr * 1024; const int l = lane_now();
            const float sc = quant_row16(*(const GAS v4u*)(src + 16 * l), *(const GAS v4u*)(src + 16 * l + 8), (sel == 2 ? WSP(unsigned char, WS_W8Q) : sel == 1 ? WSP(unsigned char, WS_WXKV8) : WSP(unsigned char, WS_W1Q)) + (size_t)rr * 1024, l);
            if (l == 0) (sel == 2 ? WSP(float, WS_SB8Q) : sel == 1 ? WSP(float, WS_SBKV) : WSP(float, WS_SBW1))[rr] = sc;
        }
        asm volatile("s_waitcnt vmcnt(0)" ::: "memory");
        __syncthreads();
        if (F.wave == 0 && lane_now() == 0) { __builtin_amdgcn_fence(__ATOMIC_RELEASE, "agent"); asm volatile("s_waitcnt vmcnt(0)" ::: "memory"); (void)xb_add(ctr, 1u); }
    }
    {
        pg8::Gemm g{WSP(bf16, WS_A2), WSP(bf16, WS_W1T) + (size_t)2048 * 1024, 2048, 1024, 1024, 0xffffffffu};
        pg8::TileOrder S; S.init(128, 2, F.G, (int)blockIdx.x, (size_t)256 * 2048 * 2, (size_t)256 * 1024 * 2);
        pg8::EpiIdx E{WSP(bf16, WS_QIH), WSP(bf16, WS_QIL), WSP(bf16, WS_KIH), WSP(bf16, WS_KIL), WSP(float, WS_WI), WSP(bf16, WS_KA), WSP(bf16, WS_VA), rs, ct, st, (const float*)A.in[6]};
        pg8::gemm_phase<pg8::EpiIdx, pg8::TileOrder, true, true>(F.lds + RING_OFF, g, S, E, F.wave);
    }
    {
        if (F.wave == 0 && lane_now() == 0) {
            unsigned sp = 0u;
            while (xb_ld(ctr) < (unsigned)F.G && ++sp < XB_SPIN_CAP) __builtin_amdgcn_s_sleep(1);
            __builtin_amdgcn_fence(__ATOMIC_ACQUIRE, "agent");
            asm volatile("s_waitcnt vmcnt(0)" ::: "memory");
        }
        __syncthreads();
    }
    {
        int kk = 512; asm volatile("" : "+s"(kk));
        pg8::Gemm g{WSP(bf16, WS_X8), WSP(bf16, WS_W1Q), 512, 512, kk, 0xffffffffu};
        pg8::TileOrder S; S.init(128, 8, F.G, (int)blockIdx.x, (size_t)256 * 1024, (size_t)256 * 1024);
        pg8::EpiProj E{WSP(bf16, WS_QA), WSP(bf16, WS_QB), WSP(bf16, WS_KB), WSP(bf16, WS_VB), WSP(float, WS_RSX8), WSP(float, WS_SBW1), ct, st, (const float*)A.in[5], (const float*)A.in[7], (const float*)A.in[8]};
        pg8::gemm_phase<pg8::EpiProj, pg8::TileOrder, true, true, true>(F.lds + RING_OFF, g, S, E, F.wave);
    }
}
namespace attn_body {
using bf16=unsigned short;
using bf16x8=__attribute__((ext_vector_type(8)))short;
using s16x4=__attribute__((ext_vector_type(4)))short;
using f32x16=__attribute__((ext_vector_type(16)))float;
using u32x4=__attribute__((ext_vector_type(4)))unsigned;
constexpr int SEQ=2048,D=64;
constexpr int NW=8,QBLK=32,QB=QBLK*NW,KVBLK=64,NQB=SEQ/QB;
constexpr int ATTN_UNIT_ROWS=QB;
__device__ __forceinline__ constexpr int cr0(int r){return (r&3)+8*(r>>2);}
__device__ __forceinline__ int crow(int r,int hi){return (r&3)+8*(r>>2)+4*hi;}
#define SBAR() __builtin_amdgcn_sched_barrier(0)
__device__ __forceinline__ void cmask(f32x16&p0,f32x16&p1,int jb,int qrel,int hi,int wrow){
  const float NEG=-INFINITY; int kb=64*jb+4*hi;
  if(64*jb+63<=wrow) return;
  if(64*jb>wrow+31){
    #pragma unroll
    for(int r=0;r<16;++r){p0[r]=NEG;p1[r]=NEG;}
    return; }
  #pragma unroll
  for(int r=0;r<16;++r){int kv=kb+(r&3)+8*(r>>2); if(kv>qrel)p0[r]=NEG; if(kv+32>qrel)p1[r]=NEG;}
}

__device__ __forceinline__ void bmask(f32x16&p0,f32x16&p1,unsigned w0,unsigned w1,int hi){
  const unsigned m0=w0>>(4*hi), m1=w1>>(4*hi); const unsigned NEGB=0xff800000u;
  #pragma unroll
  for(int r=0;r<16;++r){
    int t0,t1; asm("v_bfe_i32 %0, %1, %2, 1":"=v"(t0):"v"(m0),"n"(cr0(r))); asm("v_bfe_i32 %0, %1, %2, 1":"=v"(t1):"v"(m1),"n"(cr0(r)));
    asm("v_bfi_b32 %0, %1, %0, %2":"+v"(p0[r]):"v"(t0),"v"(NEGB)); asm("v_bfi_b32 %0, %1, %0, %2":"+v"(p1[r]):"v"(t1),"v"(NEGB)); }
}
constexpr int NSLOT=3, SLOTB=8192;
constexpr int MWAVE=8192;
constexpr int LDS_K=0, LDS_V=NSLOT*SLOTB, LDS_WS=2*NSLOT*SLOTB, LDS_OST=LDS_WS+NW*64*4, LDS_BYTES=LDS_OST+NW*MWAVE;
constexpr float C2=0.125f*1.4426950408889634f;
__device__ __forceinline__ void glds16(const void*gsrc,unsigned lds_dst){unsigned keep;
  asm volatile("s_mov_b32 %0, m0\n\ts_mov_b32 m0, %2\n\ts_nop 0\n\tglobal_load_lds_dwordx4 %1, off\n\ts_mov_b32 m0, %0":"=&s"(keep):"v"(gsrc),"s"(lds_dst):"memory");}
__device__ __forceinline__ float max3f(float a,float b,float c){float r;asm("v_max3_f32 %0, %1, %2, %3":"=v"(r):"v"(a),"v"(b),"v"(c));return r;}
__device__ __forceinline__ float max2f(float a,float b){float r;asm("v_max_f32_e32 %0, %1, %2":"=v"(r):"v"(a),"v"(b));return r;}
__device__ __forceinline__ float fadd_s(float a,float b){float r;asm("v_add_f32_e32 %0, %1, %2":"=v"(r):"v"(a),"v"(b));return r;}
__device__ __forceinline__ float fsub_s(float a,float b){float r;asm("v_sub_f32_e32 %0, %1, %2":"=v"(r):"v"(a),"v"(b));return r;}
typedef float f32x2_t __attribute__((ext_vector_type(2))); typedef __bf16 bf16x2_t __attribute__((ext_vector_type(2)));
__device__ __forceinline__ unsigned cvtpk_s(float lo,float hi){f32x2_t v={lo,hi};bf16x2_t b=__builtin_convertvector(v,bf16x2_t);return __builtin_bit_cast(unsigned,b);}
#define WAIT_BAR(N) asm volatile("s_waitcnt vmcnt(" #N ") lgkmcnt(0)\n\ts_barrier":::"memory")

__device__ __forceinline__ void qkt(f32x16&p0,f32x16&p1,const char*Kslot,const bf16x8*qr,const f32x16&negm,int r32,int hi){
  const char*kb=Kslot+hi*1024+r32*16;
  #pragma unroll
  for(int d0=0;d0<4;++d0){
    const bf16x8 b0=*reinterpret_cast<const bf16x8*>(kb+d0*2048);
    const bf16x8 b1=*reinterpret_cast<const bf16x8*>(kb+d0*2048+512);
    if(d0==0){p0=__builtin_amdgcn_mfma_f32_32x32x16_bf16(b0,qr[0],negm,0,0,0);p1=__builtin_amdgcn_mfma_f32_32x32x16_bf16(b1,qr[0],negm,0,0,0);}
    else{p0=__builtin_amdgcn_mfma_f32_32x32x16_bf16(b0,qr[d0],p0,0,0,0);p1=__builtin_amdgcn_mfma_f32_32x32x16_bf16(b1,qr[d0],p1,0,0,0);}}
}
typedef __attribute__((address_space(3))) const char* lds_cptr;
typedef short v4i16_t __attribute__((ext_vector_type(4)));
__device__ __forceinline__ void kload8(bf16x8*kf,lds_cptr kp){
  kf[0]=*(const __attribute__((address_space(3))) bf16x8*)(kp);      kf[1]=*(const __attribute__((address_space(3))) bf16x8*)(kp+512);
  kf[2]=*(const __attribute__((address_space(3))) bf16x8*)(kp+2048); kf[3]=*(const __attribute__((address_space(3))) bf16x8*)(kp+2560);
  kf[4]=*(const __attribute__((address_space(3))) bf16x8*)(kp+4096); kf[5]=*(const __attribute__((address_space(3))) bf16x8*)(kp+4608);
  kf[6]=*(const __attribute__((address_space(3))) bf16x8*)(kp+6144); kf[7]=*(const __attribute__((address_space(3))) bf16x8*)(kp+6656);
}
__device__ __forceinline__ void kload2(bf16x8*kf,lds_cptr kp,int j){ kf[2*j]=*(const __attribute__((address_space(3))) bf16x8*)(kp+j*2048); kf[2*j+1]=*(const __attribute__((address_space(3))) bf16x8*)(kp+j*2048+512); }
__device__ __forceinline__ s16x4 vtr(lds_cptr p){ return __builtin_bit_cast(s16x4,__builtin_amdgcn_ds_read_tr16_b64_v4i16((__attribute__((address_space(3))) v4i16_t*)p)); }
__device__ __forceinline__ float rowmax(const f32x16&p0,const f32x16&p1){
  float a=max3f(p0[0],p0[1],p1[0]),b=max3f(p0[2],p0[3],p1[1]);a=max3f(a,p1[2],p1[3]);
  #pragma unroll
  for(int r=4;r<16;r+=4){a=max3f(a,p0[r],p0[r+1]);b=max3f(b,p0[r+2],p0[r+3]);a=max3f(a,p1[r],p1[r+1]);b=max3f(b,p1[r+2],p1[r+3]);}
  const float m=max2f(a,b);
  auto rr=__builtin_amdgcn_permlane32_swap(__float_as_uint(m),__float_as_uint(m),false,false);
  return max2f(__uint_as_float(rr[0]),__uint_as_float(rr[1]));
}
__device__ __forceinline__ void pv(f32x16*o,int vb,bf16x8 pa0,bf16x8 pa1,bf16x8 pa2,bf16x8 pa3){
  #pragma unroll
  for(int d0=0;d0<2;++d0){s16x4 lo[4],hi[4];
    #pragma unroll
    for(int ks=0;ks<4;++ks){
      asm volatile("ds_read_b64_tr_b16 %0,%1 offset:%c2":"=&v"(lo[ks]):"v"(vb),"i"(d0*4096+ks*1024):"memory");
      asm volatile("ds_read_b64_tr_b16 %0,%1 offset:%c2":"=&v"(hi[ks]):"v"(vb),"i"(d0*4096+ks*1024+512):"memory");}
    asm volatile("s_waitcnt lgkmcnt(0)":::"memory");SBAR();
    #define PK(k) (bf16x8){lo[k][0],lo[k][1],lo[k][2],lo[k][3],hi[k][0],hi[k][1],hi[k][2],hi[k][3]}
    o[d0]=__builtin_amdgcn_mfma_f32_32x32x16_bf16(pa0,PK(0),o[d0],0,0,0);
    o[d0]=__builtin_amdgcn_mfma_f32_32x32x16_bf16(pa1,PK(1),o[d0],0,0,0);
    o[d0]=__builtin_amdgcn_mfma_f32_32x32x16_bf16(pa2,PK(2),o[d0],0,0,0);
    o[d0]=__builtin_amdgcn_mfma_f32_32x32x16_bf16(pa3,PK(3),o[d0],0,0,0);
    #undef PK
  }
}

#ifndef ATTN_STORE16
#define ATTN_STORE16(p,v) st16_wt((p),(v))
#endif
template<int THRL,bool MASKED> __device__ __forceinline__ void attn_unit(int qb,const bf16*Qb,int QP,const bf16*__restrict__ Kh,int KP,const bf16*__restrict__ Vh,int VP,bf16*Ob,int OP,const unsigned*mwave,char*shm,const int wave_,const int emode=0,const int bsel=0,const float lam=0.f){
  int tidv; asm volatile("v_mbcnt_lo_u32_b32 %0, -1, 0\n\tv_mbcnt_hi_u32_b32 %0, -1, %0":"=v"(tidv)); tidv+=wave_*64;
  const int tid=tidv,lane=tid&63,r32=lane&31,hi=lane>>5; const int wid=__builtin_amdgcn_readfirstlane(tid>>6);
  const int q0=qb*QB;
  const bf16*Qw=Qb+(long)(wid*QBLK)*QP;
  const unsigned lds0=(unsigned)(uintptr_t)shm;
  float*wsf=(float*)(shm+LDS_WS)+wid*64;
  const bf16*ksrc=Kh+(long)lane*KP+wid*8;
  const bf16*vsrc=Vh+(long)(16*(wid&3)+(lane>>2))*VP+(wid>>2)*32+(lane&3)*8;
  const unsigned kdst=lds0+LDS_K+wid*1024, vdst=lds0+LDS_V+wid*1024;
  #define DMA_K(t,slot) glds16(ksrc+(long)(t)*KVBLK*KP,(unsigned)__builtin_amdgcn_readfirstlane(kdst+(slot)))
  #define DMA_V(t,slot) glds16(vsrc+(long)(t)*KVBLK*VP,(unsigned)__builtin_amdgcn_readfirstlane(vdst+(slot)))
  const int vb0=(int)(lds0+LDS_V)+((lane>>4)&1)*32+(lane&3)*8+(4*hi+((lane&15)>>2))*64;
  const char*Kbase=shm+LDS_K; bf16x8 kf[8];
  const lds_cptr shm3=(lds_cptr)shm; const lds_cptr kp0=shm3+LDS_K+hi*1024+r32*16; const lds_cptr vp0=shm3+LDS_V+((lane>>4)&1)*32+(lane&3)*8+(4*hi+((lane&15)>>2))*64;
  const int NT=(q0+QB)/KVBLK;
  const __attribute__((address_space(3))) unsigned* mimg=(const __attribute__((address_space(3))) unsigned*)(shm3+LDS_OST+wid*MWAVE)+r32;
  DMA_K(0,0);DMA_V(0,0);DMA_K(1,SLOTB);
  if constexpr(MASKED){
    __attribute__((address_space(3))) u32x4* mdst=(__attribute__((address_space(3))) u32x4*)(shm3+LDS_OST+wid*MWAVE)+lane;
    for(int i=0;i<=qb;++i){ const u32x4 v=((const u32x4*)mwave)[i*64+lane]; mdst[i*64]=v; }
  }
  bf16x8 qr[4];
  #pragma unroll
  for(int d0=0;d0<4;++d0)qr[d0]=*reinterpret_cast<const bf16x8*>(&Qw[(long)r32*QP+d0*16+hi*8]);
  float mhat=0.f,l_reg=0.f;f32x16 o[2];o[0]=f32x16{};o[1]=f32x16{};f32x16 negm=f32x16{};asm volatile("":"+v"(negm));
  const int qrel=wid*QBLK+r32;
  #define CMASK(P0,P1,t) do{int jb_=(t)-(NT-4); if(jb_>=0)cmask(P0,P1,jb_,qrel,hi,wid*QBLK);}while(0)
  #define XMASK(P0,P1,t) do{ if constexpr(MASKED){ bmask(P0,P1,mimg[(2*(t))*32],mimg[(2*(t)+1)*32],hi); } else { CMASK(P0,P1,t); } }while(0)
  bool resc=false;
  #define START(P0,P1) do{ const float rm=rowmax(P0,P1); resc=false; \
    { const float dl=MASKED?__builtin_fmaxf(rm,-30.f):rm; mhat=fadd_s(mhat,dl); \
      _Pragma("unroll") for(int r=0;r<16;++r){P0[r]=fsub_s(P0[r],dl);P1[r]=fsub_s(P1[r],dl);} \
      _Pragma("unroll") for(int r=0;r<16;++r)negm[r]=-mhat; asm volatile("":"+v"(negm)); } \
    _Pragma("unroll") for(int r=0;r<16;++r)P0[r]=__builtin_amdgcn_exp2f(P0[r]); }while(0)
  #define RESC() do{ if(resc){ asm volatile("s_waitcnt lgkmcnt(0)":::"memory"); \
      _Pragma("unroll") for(int d_=0;d_<2;++d_) _Pragma("unroll") for(int r=0;r<16;++r)o[d_][r]*=wsf[crow(r,hi)]; } }while(0)
  f32x16 pA0,pA1,pB0,pB1;
  int sl_prev=0,sl_cur=0,sl_next=SLOTB;
  #define ROT() do{sl_prev=sl_cur;sl_cur=sl_next;sl_next=(sl_next==(NSLOT-1)*SLOTB)?0:sl_next+SLOTB;}while(0)
  DMA_K(2,2*SLOTB);
  WAIT_BAR(3);
  qkt(pA0,pA1,Kbase,qr,negm,r32,hi);asm volatile("s_nop 15\n\ts_nop 7":"+v"(pA0),"+v"(pA1));XMASK(pA0,pA1,0);
  START(pA0,pA1);
  _Pragma("unroll") for(int r=0;r<16;++r)pA1[r]=__builtin_amdgcn_exp2f(pA1[r]);
  WAIT_BAR(0);
  DMA_K(3,0);DMA_V(1,SLOTB);
  ROT();
  kload8(kf,kp0+sl_cur);
  WAIT_BAR(2);
  s16x4 vlo[8],vhi[8]; u32x4 pw0,pw1,pw2,pw3;
  #define PKW(P,B) cvtpk_s(P[B],P[B+1])
  #define PAF(k) __builtin_bit_cast(bf16x8,pw##k)
  #define VFR(i) (bf16x8){vlo[i][0],vlo[i][1],vlo[i][2],vlo[i][3],vhi[i][0],vhi[i][1],vhi[i][2],vhi[i][3]}
  #define PIN(x) asm volatile("":"+v"(x))
  #define MX3(a,b,c) __builtin_fmaxf(__builtin_fmaxf((a),(b)),(c))
  #define GAPA(MF,A0,A1,A2,A3,W0,W1,PW) do{ MF; sacc+=A0; sacc+=A1; sacc+=A2; sacc+=A3; PIN(sacc); W0; W1; PIN(PW); SBAR(); }while(0)
  #define GAPA2(MF,A0,A1,W0,W1,PW) do{ MF; sacc+=A0; sacc+=A1; PIN(sacc); W0; W1; PIN(PW); SBAR(); }while(0)
  #define EX(v) __builtin_amdgcn_exp2f(v)
  #define GAPB(MF,X,B) do{ MF; X[B]=EX(X[B]); X[B+1]=EX(X[B+1]); X[B+2]=EX(X[B+2]); X[B+3]=EX(X[B+3]); PIN(X); SBAR(); }while(0)
  #define GAPB3(MF,E0,E1,E2,XA,XB) do{ MF; E0=EX(E0); E1=EX(E1); E2=EX(E2); PIN(XA); PIN(XB); SBAR(); }while(0)
  #define VRD(i) do{ vlo[i]=vtr(vp_+(((i)>>2)*4096+((i)&3)*1024)); vhi[i]=vtr(vp_+(((i)>>2)*4096+((i)&3)*1024+512)); }while(0)
  #define KRD(G,j) do{ if(G){ kload2(kf,kp0+sl_next,j); SBAR(); } }while(0)
  #define STEP(C0,C1,P0,P1,t,GK,GV,GL,DM) do{ SBAR(); \
    const lds_cptr vp_=vp0+sl_prev; \
    VRD(0); SBAR(); float sacc=(P0[0]+P0[1]); \
    GAPA(C0=__builtin_amdgcn_mfma_f32_32x32x16_bf16(kf[0],qr[0],negm,0,0,0), P0[2],P0[3],P0[4],P0[5],     pw0[0]=PKW(P0,0), pw0[1]=PKW(P0,2), pw0); \
    VRD(4); SBAR(); GAPA(C1=__builtin_amdgcn_mfma_f32_32x32x16_bf16(kf[1],qr[0],negm,0,0,0), P0[6],P0[7],P0[8],P0[9],     pw0[2]=PKW(P0,4), pw0[3]=PKW(P0,6), pw0); \
    VRD(1); SBAR(); GAPA(C0=__builtin_amdgcn_mfma_f32_32x32x16_bf16(kf[2],qr[1],C0,0,0,0),   P0[10],P0[11],P0[12],P0[13], pw1[0]=PKW(P0,8), pw1[1]=PKW(P0,10), pw1); \
    VRD(5); SBAR(); GAPA(C1=__builtin_amdgcn_mfma_f32_32x32x16_bf16(kf[3],qr[1],C1,0,0,0),   P0[14],P0[15],P1[0],P1[1],   pw1[2]=PKW(P0,12),pw1[3]=PKW(P0,14), pw1); \
    VRD(2); SBAR(); GAPA(C0=__builtin_amdgcn_mfma_f32_32x32x16_bf16(kf[4],qr[2],C0,0,0,0),   P1[2],P1[3],P1[4],P1[5],     pw2[0]=PKW(P1,0), pw2[1]=PKW(P1,2), pw2); \
    VRD(6); SBAR(); GAPA(C1=__builtin_amdgcn_mfma_f32_32x32x16_bf16(kf[5],qr[2],C1,0,0,0),   P1[6],P1[7],P1[8],P1[9],     pw2[2]=PKW(P1,4), pw2[3]=PKW(P1,6), pw2); \
    VRD(3); SBAR(); GAPA(C0=__builtin_amdgcn_mfma_f32_32x32x16_bf16(kf[6],qr[3],C0,0,0,0),   P1[10],P1[11],P1[12],P1[13], pw3[0]=PKW(P1,8), pw3[1]=PKW(P1,10), pw3); \
    VRD(7); SBAR(); GAPA2(C1=__builtin_amdgcn_mfma_f32_32x32x16_bf16(kf[7],qr[3],C1,0,0,0),  P1[14],P1[15],               pw3[2]=PKW(P1,12),pw3[3]=PKW(P1,14), pw3); \
    l_reg+=sacc; \
    if(GK){DMA_K((t)+3,sl_cur);} if(GV){DMA_V((t)+1,sl_next);} \
    XMASK(C0,C1,t); \
    resc=false; \
      \
    if(DM){ float a=MX3(C0[0],C0[1],C1[0]),b=MX3(C0[2],C0[3],C1[1]); a=MX3(a,C1[2],C1[3]); \
      _Pragma("unroll") for(int r=4;r<16;r+=4){a=MX3(a,C0[r],C0[r+1]);b=MX3(b,C0[r+2],C0[r+3]);a=MX3(a,C1[r],C1[r+1]);b=MX3(b,C1[r+2],C1[r+3]);} \
      float rm=__builtin_fmaxf(a,b); { auto rr=__builtin_amdgcn_permlane32_swap(__float_as_uint(rm),__float_as_uint(rm),false,false); rm=max2f(__uint_as_float(rr[0]),__uint_as_float(rr[1])); } \
      if(__builtin_expect(__any(rm>(float)THRL),0)){ const float dl=__builtin_fmaxf(rm,0.f); mhat+=dl; \
        _Pragma("unroll") for(int r=0;r<16;++r){C0[r]-=dl;C1[r]-=dl;} \
        _Pragma("unroll") for(int r=0;r<16;++r)negm[r]=-mhat; asm volatile("":"+v"(negm)); \
        const float f=__builtin_amdgcn_exp2f(-dl); l_reg*=f; if(hi==0)wsf[r32]=f; resc=true; } } \
    _Pragma("unroll") for(int r_=0;r_<8;++r_)C0[r_]=EX(C0[r_]); PIN(C0); \
    SBAR(); \
    GAPB3(o[0]=__builtin_amdgcn_mfma_f32_32x32x16_bf16(PAF(0),VFR(0),o[0],0,0,0), C0[8],C0[9],C0[10],C0,C1); \
    GAPB3(o[1]=__builtin_amdgcn_mfma_f32_32x32x16_bf16(PAF(0),VFR(4),o[1],0,0,0), C0[11],C0[12],C0[13],C0,C1); \
    KRD(GL,0); GAPB3(o[0]=__builtin_amdgcn_mfma_f32_32x32x16_bf16(PAF(1),VFR(1),o[0],0,0,0), C0[14],C0[15],C1[0],C0,C1); \
    KRD(GL,1); GAPB3(o[1]=__builtin_amdgcn_mfma_f32_32x32x16_bf16(PAF(1),VFR(5),o[1],0,0,0), C1[1],C1[2],C1[3],C0,C1); \
    KRD(GL,2); GAPB3(o[0]=__builtin_amdgcn_mfma_f32_32x32x16_bf16(PAF(2),VFR(2),o[0],0,0,0), C1[4],C1[5],C1[6],C0,C1); \
    KRD(GL,3); GAPB3(o[1]=__builtin_amdgcn_mfma_f32_32x32x16_bf16(PAF(2),VFR(6),o[1],0,0,0), C1[7],C1[8],C1[9],C0,C1); \
    GAPB3(o[0]=__builtin_amdgcn_mfma_f32_32x32x16_bf16(PAF(3),VFR(3),o[0],0,0,0), C1[10],C1[11],C1[12],C0,C1); \
    GAPB3(o[1]=__builtin_amdgcn_mfma_f32_32x32x16_bf16(PAF(3),VFR(7),o[1],0,0,0), C1[13],C1[14],C1[15],C0,C1); \
    }while(0)
  int t=1;
  #undef CMASK
  #define CMASK(P0,P1,t) do{}while(0)
  for(;t+5<NT;t+=2){
    STEP(pB0,pB1,pA0,pA1,t,true,true,true,((t&7)==1));     WAIT_BAR(2); RESC(); ROT();
    STEP(pA0,pA1,pB0,pB1,t+1,true,true,true,false);   WAIT_BAR(2); RESC(); ROT();
  }
  #undef CMASK
  #define CMASK(P0,P1,t) do{int jb_=(t)-(NT-4); if(jb_>=0)cmask(P0,P1,jb_,qrel,hi,wid*QBLK);}while(0)
  #define ENDW(tt) do{ if((tt)+3<NT){WAIT_BAR(2);} else if((tt)+2<NT){WAIT_BAR(1);} else {WAIT_BAR(0);} }while(0)
  for(;t+1<NT;t+=2){
    STEP(pB0,pB1,pA0,pA1,t,(t+3<NT),(t+1<NT),(t+1<NT),true);       ENDW(t);   RESC(); ROT();
    STEP(pA0,pA1,pB0,pB1,t+1,(t+4<NT),(t+2<NT),(t+2<NT),false);     ENDW(t+1); RESC(); ROT();
  }
  STEP(pB0,pB1,pA0,pA1,NT-1,false,false,false,true); RESC();
  { float sacc=pB0[0]+pB0[1]; _Pragma("unroll") for(int r=2;r<16;++r)sacc+=pB0[r]; _Pragma("unroll") for(int r=0;r<16;++r)sacc+=pB1[r]; l_reg+=sacc;
    pw0=(u32x4){PKW(pB0,0),PKW(pB0,2),PKW(pB0,4),PKW(pB0,6)};pw1=(u32x4){PKW(pB0,8),PKW(pB0,10),PKW(pB0,12),PKW(pB0,14)};pw2=(u32x4){PKW(pB1,0),PKW(pB1,2),PKW(pB1,4),PKW(pB1,6)};pw3=(u32x4){PKW(pB1,8),PKW(pB1,10),PKW(pB1,12),PKW(pB1,14)};
    SBAR(); pv(o,vb0+sl_cur,PAF(0),PAF(1),PAF(2),PAF(3)); }
  #undef PKW
  #undef PAF
  #undef VFR
  #undef PIN
  #undef MX3
  #undef GAPA
  #undef GAPA2
  #undef GAPB
  #undef GAPB3
  #undef EX
  #undef VRD
  #undef KRD
  #undef STEP
  #undef ENDW
  {auto rr=__builtin_amdgcn_permlane32_swap(__float_as_uint(l_reg),__float_as_uint(l_reg),false,false);l_reg=__uint_as_float(rr[0])+__uint_as_float(rr[1]);}
  if(hi==0)wsf[32+r32]=l_reg;asm volatile("s_waitcnt lgkmcnt(0)":::"memory");
  float rli[16];
  #pragma unroll
  for(int r=0;r<16;++r)rli[r]=__builtin_amdgcn_rcpf(wsf[32+crow(r,hi)]);
  bf16*Ow=Ob+(long)(wid*QBLK)*OP;
  { bf16*stg=(bf16*)(shm+LDS_OST+wid*MWAVE);
    bf16*stl=stg+bsel*2048+hi*256+r32;
    if(emode>=2){
      #pragma unroll
      for(int r=0;r<16;++r){
        #pragma unroll
        for(int d0=0;d0<2;++d0){ const float old=__uint_as_float((unsigned)stl[cr0(r)*64+d0*32]<<16); stl[cr0(r)*64+d0*32]=(bf16)(cvtpk_s(old-lam*(o[d0][r]*rli[r]),0.f)&0xffffu);} }
    } else {
      #pragma unroll
      for(int r=0;r<16;++r){
        #pragma unroll
        for(int d0=0;d0<2;++d0)stl[cr0(r)*64+d0*32]=(bf16)(cvtpk_s(o[d0][r]*rli[r],0.f)&0xffffu);}
    }
    asm volatile("s_waitcnt lgkmcnt(0)":::"memory");
    if(emode==0){
      #pragma unroll
      for(int i=0;i<4;++i){const int row=i*8+(lane>>3),ch=lane&7; const u32x4 v=*(const u32x4*)(stg+row*64+ch*8); ATTN_STORE16(Ow+(long)row*OP+ch*8,v);}
    } else if(emode==3){
      #pragma unroll
      for(int i=0;i<4;++i){const int row=i*8+(lane>>3),ch=lane&7;
        const u32x4 v0=*(const u32x4*)(stg+row*64+ch*8), v1=*(const u32x4*)(stg+2048+row*64+ch*8);
        float f[16]; float ss=0.f;
        #pragma unroll
        for(int j=0;j<4;++j){ f[2*j]=__uint_as_float(v0[j]<<16); f[2*j+1]=__uint_as_float(v0[j]&0xffff0000u); f[8+2*j]=__uint_as_float(v1[j]<<16); f[8+2*j+1]=__uint_as_float(v1[j]&0xffff0000u); }
        #pragma unroll
        for(int j=0;j<16;++j)ss+=f[j]*f[j];
        ss+=__shfl_xor(ss,1); ss+=__shfl_xor(ss,2); ss+=__shfl_xor(ss,4);
        const float rn=__builtin_amdgcn_rsqf(ss*(1.f/128.f)+1e-6f)*0.8f;
        u32x4 w0,w1;
        #pragma unroll
        for(int j=0;j<4;++j){ w0[j]=cvtpk_s(f[2*j]*rn,f[2*j+1]*rn); w1[j]=cvtpk_s(f[8+2*j]*rn,f[8+2*j+1]*rn); }
        ATTN_STORE16(Ow+(long)row*OP+ch*8,w0); ATTN_STORE16(Ow+(long)row*OP+64+ch*8,w1);}
    }
  }
  asm volatile("s_waitcnt lgkmcnt(0)\n\ts_barrier":::"memory");
  #undef DMA_K
  #undef DMA_V
  #undef CMASK
  #undef XMASK
  #undef START
  #undef RESC
  #undef ROT
}
constexpr int ATTN_LDS_BYTES=LDS_BYTES;
#undef SBAR
#undef WAIT_BAR
}
namespace idx {
typedef short bf16x8 __attribute__((ext_vector_type(8)));
typedef float f32x16 __attribute__((ext_vector_type(16)));
constexpr int QROW = 528, IMG_LO = 32 * QROW, TROW = 1025, KBUF_OFF = 36864;
constexpr int CW_QUEUE = 64;
constexpr unsigned T0 = 0x80000000u;
__device__ __forceinline__ constexpr int cr0(int r) { return (r & 3) + 8 * (r >> 2); }
__device__ __forceinline__ unsigned fkey(float f) { const unsigned u = __float_as_uint(f); return (u & 0x80000000u) ? ~u : (u | 0x80000000u); }
__device__ __forceinline__ float kval(unsigned k) { return __uint_as_float((k & 0x80000000u) ? (k & 0x7fffffffu) : ~k); }
__device__ __forceinline__ unsigned dpp_shr(unsigned v, int n) {
    const int iv = (int)v; int r;
    switch (n) { case 1: r = __builtin_amdgcn_update_dpp(0, iv, 0x111, 0xf, 0xf, true); break; case 2: r = __builtin_amdgcn_update_dpp(0, iv, 0x112, 0xf, 0xf, true); break;
                 case 4: r = __builtin_amdgcn_update_dpp(0, iv, 0x114, 0xf, 0xf, true); break; default: r = __builtin_amdgcn_update_dpp(0, iv, 0x118, 0xf, 0xf, true); break; }
    return (unsigned)r;
}
__device__ __forceinline__ unsigned wsum(unsigned v) {
    v += dpp_shr(v, 1); v += dpp_shr(v, 2); v += dpp_shr(v, 4); v += dpp_shr(v, 8);
    v += (unsigned)__builtin_amdgcn_update_dpp(0, (int)v, 0x142, 0xa, 0xf, false);
    v += (unsigned)__builtin_amdgcn_update_dpp(0, (int)v, 0x143, 0xc, 0xf, false);
    return (unsigned)__builtin_amdgcn_readlane((int)v, 63);
}
__device__ __forceinline__ unsigned umax2(unsigned a, unsigned b) { return a > b ? a : b; }
__device__ __forceinline__ unsigned wmaxu(unsigned v) {
    v = umax2(v, dpp_shr(v, 1)); v = umax2(v, dpp_shr(v, 2)); v = umax2(v, dpp_shr(v, 4)); v = umax2(v, dpp_shr(v, 8));
    v = umax2(v, (unsigned)__builtin_amdgcn_update_dpp(0, (int)v, 0x142, 0xa, 0xf, false));
    v = umax2(v, (unsigned)__builtin_amdgcn_update_dpp(0, (int)v, 0x143, 0xc, 0xf, false));
    return (unsigned)__builtin_amdgcn_readlane((int)v, 63);
}
__device__ __forceinline__ unsigned wminu(unsigned v) { return ~wmaxu(~v); }
#define IDX_COUNT_GE(K, T, NR, OUT) do { unsigned w_ = 0xffffffffu; _Pragma("unroll") for (int i_ = 0; i_ < 32; ++i_) if (i_ < (NR)) w_ = __builtin_amdgcn_alignbit(w_, (K)[i_] - (T), 31); (OUT) = 32u - (unsigned)__builtin_popcount(w_); } while (0)

__device__ __forceinline__ void run(Frame& F, int qword) {
    const int wid = F.wave;
    LAS unsigned char* lds = F.lds;
    unsigned* qctr = (unsigned*)(F.ws + WS_CTL) + qword;
    volatile LAS unsigned* uw = (volatile LAS unsigned*)(F.lds + MISC_OFF) + 20;
    const bf16* QIH = WSP(bf16, WS_QIH); const bf16* KIH = WSP(bf16, WS_KIH);
    const float* WI = WSP(float, WS_WI); unsigned* MASK = WSP(unsigned, WS_MASK);
    LAS unsigned* TR = (LAS unsigned*)lds;
    for (;;) {
        __syncthreads();
        if (wid == 0 && lane_now() == 0) *uw = __hip_atomic_fetch_add(qctr, 1u, __ATOMIC_RELAXED, __HIP_MEMORY_SCOPE_AGENT);
        __syncthreads();
        const unsigned un = __builtin_amdgcn_readfirstlane(*uw);
        if (un >= 1024u) break;
        int b, qg;
        if (un < 896u) { qg = 63 - (int)(un >> 4); b = (int)(un & 15u); } else { qg = (int)((un - 896u) >> 4); b = (int)(un & 15u); }
        int lane = lane_now(); asm volatile("" : "+v"(lane));
        const int r32 = lane & 31, hi = lane >> 5;
        const int tid = wid * 64 + lane;
        int widv = wid; asm volatile("" : "+s"(widv));
        const int unit = b * 64 + qg;
        const size_t tok0 = (size_t)b * SEQ + 32 * qg;
        unsigned* mrow = MASK + (size_t)unit * 2048;
        const int ktmax = qg | 7;
        if (qg < 8) {
#pragma unroll
            for (int i = 0; i < 8; ++i) { const int kt = widv + 8 * i; if (kt <= ktmax && hi == 0) mrow[kt * 32 + r32] = kt < qg ? 0xffffffffu : (kt == qg ? ((2u << r32) - 1u) : 0u); }
            continue;
        }
#pragma unroll
        for (int it = 0; it < 2; ++it) { const int rem = tid + 512 * it, row = rem >> 5, ch = rem & 31;
            const v4u v = *(const v4u*)(QIH + (tok0 + row) * 256 + ch * 8);
            *(LAS v4u*)(lds + row * QROW + ch * 16) = v; }
        const f32x4 w4 = *(const f32x4*)(WI + (tok0 + r32) * 4);
        __syncthreads();
        unsigned sc[8][16];
        const bf16* kbh = KIH + ((size_t)b * SEQ + r32) * 64 + hi * 8;
        const LAS unsigned char* kbuf = lds + KBUF_OFF + wid * 8192 + lane * 16;
        const unsigned kdst = (unsigned)(uintptr_t)(lds + KBUF_OFF + wid * 8192);
#define IDX_DMA_K(zo) do { _Pragma("unroll") for (int d0_ = 0; d0_ < 4; ++d0_) attn_body::glds16(kbh + (zo) + d0_ * 16, (unsigned)__builtin_amdgcn_readfirstlane(kdst + d0_ * 1024)); } while (0)
        if (widv <= qg) { int zoff = widv * 2048; asm volatile("" : "+v"(zoff)); IDX_DMA_K(zoff); }
        const int cl = r32 - 4 * hi;
        const LAS unsigned char* qimg = lds + r32 * QROW + hi * 16;
#pragma unroll
        for (int i = 0; i < 8; ++i) {
            const int kt = widv + 8 * i;
            if (kt <= qg) {
                bf16x8 kh[4];
                asm volatile("s_waitcnt vmcnt(0)" ::: "memory");
#pragma unroll
                for (int d0 = 0; d0 < 4; ++d0) kh[d0] = *(const LAS bf16x8*)(kbuf + d0 * 1024);
                asm volatile("s_waitcnt lgkmcnt(0)" ::: "memory");
                if (kt + 8 <= qg) { int zoff = (kt + 8) * 2048; asm volatile("" : "+v"(zoff)); IDX_DMA_K(zoff); }
                float s[16];
#pragma unroll
                for (int h = 0; h < 4; ++h) {
                    f32x16 acc = {};
#pragma unroll
                    for (int d0 = 0; d0 < 4; ++d0) {
                        const bf16x8 qh = *(const LAS bf16x8*)(qimg + (h * 64 + d0 * 16) * 2);
                        acc = __builtin_amdgcn_mfma_f32_32x32x16_bf16(kh[d0], qh, acc, 0, 0, 0);
                    }
                    const float wh = w4[h];
#pragma unroll
                    for (int r = 0; r < 16; ++r) { const float t = wh * (acc[r] > 0.f ? acc[r] : 0.f); s[r] = (h == 0) ? t : s[r] + t; }
                    if (h == 1) { asm volatile("" ::: "memory"); __builtin_amdgcn_sched_barrier(0); }
                }
#pragma unroll
                for (int r = 0; r < 16; ++r) { unsigned k = fkey(s[r]); if (kt == qg && cr0(r) > cl) k = 0u; sc[i][r] = k; }
                asm volatile("" ::: "memory"); __builtin_amdgcn_sched_barrier(0);
            } else {
#pragma unroll
                for (int r = 0; r < 16; ++r) sc[i][r] = 0u;
            }
        }
        unsigned kq[4][32];
        LAS unsigned* twr = TR + r32 * TROW + 4 * hi;
        const LAS unsigned* trd = TR + (4 * wid) * TROW + lane;
        __syncthreads();
#pragma unroll
        for (int i = 0; i < 4; ++i) { const int kt = widv + 8 * i; LAS unsigned* p = twr + kt * 32;
#pragma unroll
            for (int r = 0; r < 16; ++r) p[cr0(r)] = sc[i][r]; }
        __syncthreads();
#pragma unroll
        for (int j = 0; j < 4; ++j)
#pragma unroll
            for (int i = 0; i < 16; ++i) kq[j][i] = trd[j * TROW + 64 * i];
        const bool upper = qg >= 32;
        if (upper) {
            __syncthreads();
#pragma unroll
            for (int i = 4; i < 8; ++i) { const int kt = widv + 8 * (i - 4); LAS unsigned* p = twr + kt * 32;
#pragma unroll
                for (int r = 0; r < 16; ++r) p[cr0(r)] = sc[i][r]; }
            __syncthreads();
#pragma unroll
            for (int j = 0; j < 4; ++j)
#pragma unroll
                for (int i = 0; i < 16; ++i) kq[j][16 + i] = trd[j * TROW + 64 * i];
        } else {
#pragma unroll
            for (int j = 0; j < 4; ++j)
#pragma unroll
                for (int i = 0; i < 16; ++i) kq[j][16 + i] = 0u;
        }
        const int nr = (((32 * qg + 31) / 64 + 1) + 7) & ~7;
        unsigned P[4], nt[4], qa[4], qb[4], qcb[4]; float fa[4], fb[4]; int side[4]; bool act[4];
        {
        {
            unsigned c0[4], c1[4];
#pragma unroll
            for (int j = 0; j < 4; ++j) {
                unsigned w0 = 0u, w1 = 0xffffffffu;
#pragma unroll
                for (int ib = 0; ib < 32; ib += 8) if (ib < nr) {
#pragma unroll
                    for (int i = ib; i < ib + 8; ++i) { w0 = __builtin_amdgcn_alignbit(w0, kq[j][i], 31); w1 = __builtin_amdgcn_alignbit(w1, umax2(kq[j][i], T0) - (T0 + 1u), 31); } }
                c0[j] = (unsigned)__builtin_popcount(w0); c1[j] = 32u - (unsigned)__builtin_popcount(w1);
            }
#pragma unroll
            for (int j = 0; j < 4; ++j) { c0[j] = wsum(c0[j]); c1[j] = wsum(c1[j]); }
#pragma unroll
            for (int j = 0; j < 4; ++j) {
                const int nk = 32 * qg + 4 * wid + j + 1;
                P[j] = 0u; nt[j] = 0u; act[j] = false; qa[j] = 0u; qb[j] = 0u; qcb[j] = 0u; fa[j] = 1.f; fb[j] = -1.f; side[j] = 0;
                if (c1[j] == 256u) { P[j] = T0; }
                else if (c0[j] == 256u) { P[j] = T0 - 1u; }
                else if (c0[j] > 256u && c1[j] < 256u) { P[j] = T0; nt[j] = 256u - c1[j]; }
                else if (c1[j] > 256u) { unsigned m = 0u;
#pragma unroll
                    for (int ib = 0; ib < 32; ib += 8) if (ib < nr) {
#pragma unroll
                        for (int i = ib; i < ib + 8; ++i) { kq[j][i] = umax2(kq[j][i], T0); m = umax2(m, kq[j][i]); } }
                    qa[j] = T0 + 1u; qb[j] = wmaxu(m) + 1u; qcb[j] = 0u; fa[j] = (float)(c1[j] - 256u); fb[j] = -256.f; act[j] = true; }
                else { unsigned m = 0u;
#pragma unroll
                    for (int ib = 0; ib < 32; ib += 8) if (ib < nr) {
#pragma unroll
                        for (int i = ib; i < ib + 8; ++i) { m = umax2(m, ~(kq[j][i] - 1u)); kq[j][i] = kq[j][i] < T0 ? kq[j][i] : T0; } }
                    qa[j] = ~wmaxu(m) + 1u; qb[j] = T0; qcb[j] = c0[j]; fa[j] = (float)((unsigned)nk - 256u); fb[j] = -(float)(256u - c0[j]); act[j] = true; }
            }
        }
        {
#define IDX_SEL4(x) (lane == 0 ? (x)[0] : lane == 1 ? (x)[1] : lane == 2 ? (x)[2] : (x)[3])
            bool actl = lane < 4 && IDX_SEL4(act);
            unsigned al = IDX_SEL4(qa), bl = IDX_SEL4(qb), cbl = IDX_SEL4(qcb), Pl = IDX_SEL4(P), ntl = IDX_SEL4(nt);
            float fal = IDX_SEL4(fa), fbl = IDX_SEL4(fb); int sidel = 0;
            for (int it = 0; it < 80; ++it) {
                if (!__any(actl)) break;
                if (actl && bl - al <= 1u) { Pl = al; ntl = 256u - cbl; actl = false; }
                unsigned tl = 0xffffffffu;
                if (actl) {
                    const float va = kval(al), vb = kval(bl - 1u);
                    unsigned tt = fkey(va + (vb - va) * (fal / (fal - fbl)));
                    if (it >= 40) tt = al + ((bl - al) >> 1);
                    tt = tt <= al ? al + 1u : tt; tt = tt >= bl ? bl - 1u : tt;
                    tl = tt;
                }
                const unsigned t0 = (unsigned)__builtin_amdgcn_readlane((int)tl, 0), t1 = (unsigned)__builtin_amdgcn_readlane((int)tl, 1), t2 = (unsigned)__builtin_amdgcn_readlane((int)tl, 2), t3 = (unsigned)__builtin_amdgcn_readlane((int)tl, 3);
                unsigned w0 = 0xffffffffu, w1 = w0, w2 = w0, w3 = w0;
#define IDX_STEP(i_) do { w0 = __builtin_amdgcn_alignbit(w0, kq[0][i_] - t0, 31); w1 = __builtin_amdgcn_alignbit(w1, kq[1][i_] - t1, 31); \
                          w2 = __builtin_amdgcn_alignbit(w2, kq[2][i_] - t2, 31); w3 = __builtin_amdgcn_alignbit(w3, kq[3][i_] - t3, 31); } while (0)
#pragma unroll
                for (int i = 0; i < 8; ++i) IDX_STEP(i);
                if (nr > 8) {
#pragma unroll
                    for (int i = 8; i < 16; ++i) IDX_STEP(i);
                    if (nr > 16) {
#pragma unroll
                        for (int i = 16; i < 24; ++i) IDX_STEP(i);
                        if (nr > 24) {
#pragma unroll
                            for (int i = 24; i < 32; ++i) IDX_STEP(i);
                        }
                    }
                }
#undef IDX_STEP
                unsigned c[4] = {32u - (unsigned)__builtin_popcount(w0), 32u - (unsigned)__builtin_popcount(w1), 32u - (unsigned)__builtin_popcount(w2), 32u - (unsigned)__builtin_popcount(w3)};
#pragma unroll
                for (int st = 1; st <= 8; st <<= 1) {
#pragma unroll
                    for (int j = 0; j < 4; ++j) c[j] += dpp_shr(c[j], st);
                }
#pragma unroll
                for (int j = 0; j < 4; ++j) c[j] += (unsigned)__builtin_amdgcn_update_dpp(0, (int)c[j], 0x142, 0xa, 0xf, false);
#pragma unroll
                for (int j = 0; j < 4; ++j) c[j] += (unsigned)__builtin_amdgcn_update_dpp(0, (int)c[j], 0x143, 0xc, 0xf, false);
#pragma unroll
                for (int j = 0; j < 4; ++j) c[j] = (unsigned)__builtin_amdgcn_readlane((int)c[j], 63);
                const unsigned cl = IDX_SEL4(c);
                if (actl) {
                    if (cl == 256u) { Pl = tl - 1u; actl = false; }
                    else if (cl > 256u) { al = tl; fal = (float)(cl - 256u); if (sidel == 1) fbl *= 0.5f; sidel = 1; }
                    else { bl = tl; cbl = cl; fbl = -(float)(256u - cl); if (sidel == -1) fal *= 0.5f; sidel = -1; }
                }
            }
#pragma unroll
            for (int j = 0; j < 4; ++j) { P[j] = (unsigned)__builtin_amdgcn_readlane((int)Pl, j); nt[j] = (unsigned)__builtin_amdgcn_readlane((int)ntl, j); }
#undef IDX_SEL4
        }
        asm volatile("" ::: "memory");
        }
#pragma unroll
        for (int j = 0; j < 4; ++j) {
            unsigned wv = 0u; unsigned rem = nt[j]; const unsigned Pj = P[j];
            const int ni = 4 * ((qg >> 3) + 1);
#define IDX_WL(i_, m_) do { const unsigned mlo = __builtin_amdgcn_readfirstlane((unsigned)(m_)), mhi = __builtin_amdgcn_readfirstlane((unsigned)((m_) >> 32)); \
                            asm volatile("s_nop 3\n\tv_writelane_b32 %0, %1, %3\n\tv_writelane_b32 %0, %2, %4" : "+v"(wv) : "s"(mlo), "s"(mhi), "n"(2 * (i_)), "n"(2 * (i_) + 1)); } while (0)
            if (nt[j] == 0u) {
#pragma unroll
                for (int ib = 0; ib < 32; ib += 4) if (ib < ni) {
#pragma unroll
                    for (int i = ib; i < ib + 4; ++i) { const unsigned long long m = __ballot(kq[j][i] > Pj); IDX_WL(i, m); } }
            } else {
#pragma unroll
                for (int ib = 0; ib < 32; ib += 4) if (ib < ni) {
#pragma unroll
                    for (int i = ib; i < ib + 4; ++i) {
                        unsigned long long m = __ballot(kq[j][i] > Pj);
                        const unsigned long long e = __ballot(kq[j][i] == Pj); const unsigned pre = __builtin_amdgcn_mbcnt_hi((unsigned)(e >> 32), __builtin_amdgcn_mbcnt_lo((unsigned)e, 0u));
                        m |= __ballot(kq[j][i] == Pj && pre < rem); const unsigned ne = (unsigned)__popcll(e); rem = rem > ne ? rem - ne : 0u;
                        IDX_WL(i, m); } }
            }
#undef IDX_WL
            if (lane <= ktmax) mrow[lane * 32 + 4 * wid + j] = wv;
        }
    }
}
#undef IDX_COUNT_GE
#undef IDX_DMA_K
}
constexpr size_t WS_OD = WS_A2 + 2048;
namespace p3 {
constexpr int CW_QUEUE = 128;
constexpr int NUNITS = 1024 + 512;
__device__ __forceinline__ void decode(unsigned un, bool& dsa, int& b, int& h, int& qb) {
    if (un < 384u) { dsa = false; qb = 7 - (int)(un >> 6); const unsigned r = un & 63u; b = (int)(r >> 2); h = (int)(r & 3u); return; }
    un -= 384u;
    if (un < 192u) { if (un < 64u) { dsa = false; qb = 1; b = (int)(un >> 2); h = (int)(un & 3u); } else { un -= 64u; dsa = true; qb = 7; b = (int)(un >> 3); h = (int)(un & 7u); } return; }
    un -= 192u;
    if (un < 384u) { dsa = true; qb = 6 - (int)(un >> 7); const unsigned r = un & 127u; b = (int)(r >> 3); h = (int)(r & 7u); return; }
    un -= 384u;
    if (un < 192u) { if (un < 64u) { dsa = false; qb = 0; b = (int)(un >> 2); h = (int)(un & 3u); } else { un -= 64u; dsa = true; qb = 3; b = (int)(un >> 3); h = (int)(un & 7u); } return; }
    un -= 192u;
    dsa = true; qb = 2 - (int)(un >> 7); const unsigned r = un & 127u; b = (int)(r >> 3); h = (int)(r & 7u);
}
__device__ __forceinline__ void run(Frame& F, int qword) {
    unsigned* qctr = (unsigned*)(F.ws + WS_CTL) + qword;
    volatile LAS unsigned* uw = (volatile LAS unsigned*)(F.lds + MISC_OFF) + 16;
    char* shm = (char*)F.lds;
    const bf16* QA = WSP(bf16, WS_QA); const bf16* KA = WSP(bf16, WS_KA); const bf16* VA = WSP(bf16, WS_VA);
    const bf16* QB = WSP(bf16, WS_QB); const bf16* KB = WSP(bf16, WS_KB); const bf16* VB = WSP(bf16, WS_VB);
    bf16* ATT = WSP(bf16, WS_ATT); const unsigned* MASK = WSP(unsigned, WS_MASK);
    const float lam = *WSP(float, WS_LAM);
    const unsigned nstat = (unsigned)F.G < (unsigned)NUNITS ? 1u : 0u;
    for (unsigned it = 0;; ++it) {
        unsigned un;
        if (it < nstat) un = blockIdx.x;
        else {
            __syncthreads();
            if ((F.wave * 64 + lane_now()) == 0) *uw = nstat * (unsigned)F.G + __hip_atomic_fetch_add(qctr, 1u, __ATOMIC_RELAXED, __HIP_MEMORY_SCOPE_AGENT);
            __syncthreads();
            un = __builtin_amdgcn_readfirstlane(*uw);
        }
        if (un >= (unsigned)NUNITS) break;
        bool dsa; int b, h, qb; decode(un, dsa, b, h, qb);
        const size_t r0 = (size_t)b * SEQ, rq = r0 + qb * 256;
        if (dsa) {
            attn_body::attn_unit<8, true>(qb, QA + rq * 512 + h * 64, 512, KA + r0 * 64, 64, VA + r0 * 64, 64, ATT + rq * 1024 + h * 64, 1024,
                                          MASK + (size_t)(b * 64 + qb * 8 + F.wave) * 2048, shm, F.wave);
        } else {
            for (int sp = 0; sp < 4; ++sp) {
                const int c = sp >> 1, vh = sp & 1;
                attn_body::attn_unit<8, false>(qb, QB + rq * 512 + (h * 2 + c) * 64, 512, KB + r0 * 512 + (h * 2 + c) * 64, 512, VB + r0 * 512 + h * 128 + vh * 64, 512,
                                               ATT + rq * 1024 + 512 + h * 128, 1024, nullptr, shm, F.wave, sp < 2 ? 1 : (sp == 2 ? 2 : 3), vh, lam);
            }
        }
    }
}
}
namespace pg8 {
#define PG8_XBAR() do { asm volatile("s_waitcnt lgkmcnt(0)" ::: "memory"); __builtin_amdgcn_s_barrier(); asm volatile("" ::: "memory"); } while (0)
constexpr float XQ_SCALE = 0.0625f * 1.4426950408889634f;
__device__ __forceinline__ float rs16(const float* ss, int row) {
    const f32x4 a = *(const f32x4*)(ss + (size_t)row * 4);
    return rsqrtf(((a[0] + a[1]) + (a[2] + a[3])) * (1.f / 1024.f) + EPS);
}
struct EpiMemKV {
    static constexpr bool PERM = true, AFTER_DRAIN = false;
    unsigned char* KX8; float* SK; bf16_t* VXT; const float* rsm; const float* sb; const float* g_xk; PG8_LAS float* X;
    __device__ __forceinline__ void operator()(const f32x4 (&acc)[2][2][4][2], const Unit& u, int wr, int wc, int fr, int fq) const {
        PG8_LAS float* const xw = X + (wr * 64 + fr) * 4 + wc; const PG8_LAS float* const xr = X + (wr * 64 + fr) * 4;
        const int pn = u.pn, cl0 = wc * 32 + 8 * fq;
        const float* sbp = sb + pn * 256 + cl0;
        f32x4 s00 = *(const f32x4*)sbp, s01 = *(const f32x4*)(sbp + 4), s10 = *(const f32x4*)(sbp + 128), s11 = *(const f32x4*)(sbp + 132);
        float rr[2][4];
#pragma unroll
        for (int ai = 0; ai < 2; ++ai)
#pragma unroll
            for (int m = 0; m < 4; ++m) rr[ai][m] = rsm[u.pm * BM + ai * HALF + wr * 64 + m * 16 + fr];
        if (pn < 4) {
#pragma unroll
            for (int ai = 0; ai < 2; ++ai)
#pragma unroll
                for (int m = 0; m < 4; ++m) {
                    const float r = rr[ai][m];
                    float ss = ((sq4(cvti4(acc[ai][0][m][0]) * s00) + sq4(cvti4(acc[ai][0][m][1]) * s01)) + (sq4(cvti4(acc[ai][1][m][0]) * s10) + sq4(cvti4(acc[ai][1][m][1]) * s11))) * (r * r);
                    ss += __shfl_xor(ss, 16); ss += __shfl_xor(ss, 32);
                    if (fq == 0) xw[(ai * HALF + m * 16) * 4] = ss;
                }
            PG8_XBAR();
            s00 = s00 * *(const f32x4*)(g_xk + cl0); s01 = s01 * *(const f32x4*)(g_xk + cl0 + 4); s10 = s10 * *(const f32x4*)(g_xk + 128 + cl0); s11 = s11 * *(const f32x4*)(g_xk + 128 + cl0 + 4);
#pragma unroll
            for (int ai = 0; ai < 2; ++ai)
#pragma unroll
                for (int m = 0; m < 4; ++m) {
                    const f32x4 p = *(const PG8_LAS f32x4*)(xr + (ai * HALF + m * 16) * 4);
                    const float sc = rr[ai][m] * rsqrtf(((p[0] + p[1]) + (p[2] + p[3])) * (1.f / 256.f) + EPS); rr[ai][m] = sc;
                    const f32x4 a0 = cvti4(acc[ai][0][m][0]) * s00, a1 = cvti4(acc[ai][0][m][1]) * s01, a2 = cvti4(acc[ai][1][m][0]) * s10, a3 = cvti4(acc[ai][1][m][1]) * s11;
                    float mx = fmaxf(fmaxf(fmaxf(fmaxf(fabsf(a0[0]), fabsf(a0[1])), fmaxf(fabsf(a0[2]), fabsf(a0[3]))), fmaxf(fmaxf(fabsf(a1[0]), fabsf(a1[1])), fmaxf(fabsf(a1[2]), fabsf(a1[3])))),
                                     fmaxf(fmaxf(fmaxf(fabsf(a2[0]), fabsf(a2[1])), fmaxf(fabsf(a2[2]), fabsf(a2[3]))), fmaxf(fmaxf(fabsf(a3[0]), fabsf(a3[1])), fmaxf(fabsf(a3[2]), fabsf(a3[3]))))) * sc;
                    mx = fmaxf(mx, __shfl_xor(mx, 16)); mx = fmaxf(mx, __shfl_xor(mx, 32));
                    if (fq == 0) xw[1024 + (ai * HALF + m * 16) * 4] = mx;
                }
            PG8_XBAR();
#pragma unroll
            for (int ai = 0; ai < 2; ++ai)
#pragma unroll
                for (int m = 0; m < 4; ++m) {
                    const int rt = ai * HALF + wr * 64 + m * 16 + fr, row = u.pm * BM + rt;
                    const f32x4 q = *(const PG8_LAS f32x4*)(xr + 1024 + (ai * HALF + m * 16) * 4);
                    const float M = fmaxf(fmaxf(q[0], q[1]), fmaxf(q[2], q[3])), inv = M > 0.f ? 127.f / M : 0.f, sci = rr[ai][m] * inv;
                    unsigned char* d = KX8 + (size_t)row * 1024 + pn * 256 + wc * 64 + fq * 16;
                    st16_wt(d, (u32x4){q8x4(cvti4(acc[ai][0][m][0]) * s00, sci), q8x4(cvti4(acc[ai][0][m][1]) * s01, sci), q8x4(cvti4(acc[ai][1][m][0]) * s10, sci), q8x4(cvti4(acc[ai][1][m][1]) * s11, sci)});
                    if (wc == 0 && fq == 0) SK[((size_t)(row >> 8) * 4 + pn) * 256 + (row & 255)] = M * (1.f / 127.f);
                }
        } else {
#pragma unroll
            for (int ai = 0; ai < 2; ++ai)
#pragma unroll
                for (int m = 0; m < 4; ++m) {
                    const int rt = ai * HALF + wr * 64 + m * 16 + fr, row = u.pm * BM + rt; const float r = rr[ai][m];
                    bf16_t* d = VXT + (size_t)row * 1024 + (pn - 4) * 256 + cl0;
                    st16_wt(d, pack8(cvti4(acc[ai][0][m][0]) * r * s00, cvti4(acc[ai][0][m][1]) * r * s01));
                    st16_wt((d + 128), pack8(cvti4(acc[ai][1][m][0]) * r * s10, cvti4(acc[ai][1][m][1]) * r * s11));
                }
        }
    }
};
__device__ __forceinline__ void unpack8(const u32x4 w, f32x4& a, f32x4& b) {
    a = (f32x4){__uint_as_float(w.x << 16), __uint_as_float(w.x & 0xffff0000u), __uint_as_float(w.y << 16), __uint_as_float(w.y & 0xffff0000u)};
    b = (f32x4){__uint_as_float(w.z << 16), __uint_as_float(w.z & 0xffff0000u), __uint_as_float(w.w << 16), __uint_as_float(w.w & 0xffff0000u)};
}
template <bool BASE_BF16> struct EpiRes {
    static constexpr bool PERM = true, AFTER_DRAIN = false;
    const void* base; int base_ld; bf16_t* hb; int hb_ld; float* ss; PG8_LAS float* X; float ascale;
    __device__ __forceinline__ void operator()(const f32x4 (&acc)[2][2][4][2], const Unit& u, int wr_, int wc_, int fr_, int fq_) const {
        int ln_; asm volatile("v_mbcnt_lo_u32_b32 %0, -1, 0\n\tv_mbcnt_hi_u32_b32 %0, -1, %0" : "=v"(ln_));
        const int fr = ln_ & 15, fq = ln_ >> 4; (void)fr_; (void)fq_;
        int wr = wr_, wc = wc_; asm volatile("" : "+s"(wr), "+s"(wc));
        const int col0 = u.pn * BM + wc * 32 + 8 * fq;
        PG8_LAS float* const xw = X + (wr * 64 + fr) * 4 + wc; const PG8_LAS float* const xr = X + (wr * 64 + fr) * 4;
#pragma unroll
        for (int ai = 0; ai < 2; ++ai)
#pragma unroll
            for (int m = 0; m < 4; ++m) {
                const int row = u.pm * BM + ai * HALF + wr * 64 + m * 16 + fr; const size_t off = (size_t)row * 1024 + col0;
                float s = 0.f;
#pragma unroll
                for (int bj = 0; bj < 2; ++bj) {
                    f32x4 b0, b1;
                    const size_t boff = (size_t)row * base_ld + col0 + bj * HALF;
                    if (BASE_BF16) unpack8(*(const u32x4*)((const bf16_t*)base + boff), b0, b1);
                    else { b0 = *(const f32x4*)((const float*)base + boff); b1 = *(const f32x4*)((const float*)base + boff + 4); }
                    const f32x4 h0 = b0 + acc[ai][bj][m][0] * ascale, h1 = b1 + acc[ai][bj][m][1] * ascale;
                    st16_wt((hb + (size_t)row * hb_ld + col0 + bj * HALF), pack8(h0, h1));
                    s += sq4(h0) + sq4(h1);
                }
                s += __shfl_xor(s, 16); s += __shfl_xor(s, 32);
                if (fq == 0) xw[(ai * HALF + m * 16) * 4] = s;
            }
        PG8_XBAR();
        if (wc == 0 && fq == 0) {
#pragma unroll
            for (int ai = 0; ai < 2; ++ai)
#pragma unroll
                for (int m = 0; m < 4; ++m) { const f32x4 p = *(const PG8_LAS f32x4*)(xr + (ai * HALF + m * 16) * 4);
                    ss[(size_t)(u.pm * BM + ai * HALF + wr * 64 + m * 16 + fr) * 4 + u.pn] = (p[0] + p[1]) + (p[2] + p[3]); }
        }
    }
};
struct EpiXq {
    static constexpr bool PERM = true, AFTER_DRAIN = false;
    unsigned char* QX8; float* SQ; const float* ss1; const float* g_xq; PG8_LAS float* X;
    __device__ __forceinline__ void operator()(const f32x4 (&acc)[2][2][4][2], const Unit& u, int wr, int wc, int fr, int fq) const {
        PG8_LAS float* const xw = X + (wr * 64 + fr) * 4 + wc; const PG8_LAS float* const xr = X + (wr * 64 + fr) * 4;
        const int cl0 = wc * 32 + 8 * fq;
        float rr[2][4];
#pragma unroll
        for (int ai = 0; ai < 2; ++ai)
#pragma unroll
            for (int m = 0; m < 4; ++m) {
                const int rt = ai * HALF + wr * 64 + m * 16 + fr; const float r = rs16(ss1, u.pm * BM + rt); rr[ai][m] = r;
                float ss = ((sq4(acc[ai][0][m][0]) + sq4(acc[ai][0][m][1])) + (sq4(acc[ai][1][m][0]) + sq4(acc[ai][1][m][1]))) * (r * r);
                ss += __shfl_xor(ss, 16); ss += __shfl_xor(ss, 32);
                if (fq == 0) xw[(ai * HALF + m * 16) * 4] = ss;
            }
        PG8_XBAR();
        const f32x4 g00 = *(const f32x4*)(g_xq + cl0) * XQ_SCALE, g01 = *(const f32x4*)(g_xq + cl0 + 4) * XQ_SCALE, g10 = *(const f32x4*)(g_xq + 128 + cl0) * XQ_SCALE, g11 = *(const f32x4*)(g_xq + 128 + cl0 + 4) * XQ_SCALE;
#pragma unroll
        for (int ai = 0; ai < 2; ++ai)
#pragma unroll
            for (int m = 0; m < 4; ++m) {
                const f32x4 p = *(const PG8_LAS f32x4*)(xr + (ai * HALF + m * 16) * 4);
                const float sc = rr[ai][m] * rsqrtf(((p[0] + p[1]) + (p[2] + p[3])) * (1.f / 256.f) + EPS); rr[ai][m] = sc;
                const f32x4 a0 = acc[ai][0][m][0] * g00, a1 = acc[ai][0][m][1] * g01, a2 = acc[ai][1][m][0] * g10, a3 = acc[ai][1][m][1] * g11;
                float mx = fmaxf(fmaxf(fmaxf(fmaxf(fabsf(a0[0]), fabsf(a0[1])), fmaxf(fabsf(a0[2]), fabsf(a0[3]))), fmaxf(fmaxf(fabsf(a1[0]), fabsf(a1[1])), fmaxf(fabsf(a1[2]), fabsf(a1[3])))),
                                 fmaxf(fmaxf(fmaxf(fabsf(a2[0]), fabsf(a2[1])), fmaxf(fabsf(a2[2]), fabsf(a2[3]))), fmaxf(fmaxf(fabsf(a3[0]), fabsf(a3[1])), fmaxf(fabsf(a3[2]), fabsf(a3[3]))))) * sc;
                mx = fmaxf(mx, __shfl_xor(mx, 16)); mx = fmaxf(mx, __shfl_xor(mx, 32));
                if (fq == 0) xw[1024 + (ai * HALF + m * 16) * 4] = mx;
            }
        PG8_XBAR();
#pragma unroll
        for (int ai = 0; ai < 2; ++ai)
#pragma unroll
            for (int m = 0; m < 4; ++m) {
                const int rt = ai * HALF + wr * 64 + m * 16 + fr, row = u.pm * BM + rt;
                const f32x4 q = *(const PG8_LAS f32x4*)(xr + 1024 + (ai * HALF + m * 16) * 4);
                const float M = fmaxf(fmaxf(q[0], q[1]), fmaxf(q[2], q[3])), inv = M > 0.f ? 127.f / M : 0.f, sci = rr[ai][m] * inv;
                unsigned char* d = QX8 + (size_t)row * 1024 + u.pn * 256 + wc * 64 + fq * 16;
                st16_wt(d, (u32x4){q8x4(acc[ai][0][m][0] * g00, sci), q8x4(acc[ai][0][m][1] * g01, sci), q8x4(acc[ai][1][m][0] * g10, sci), q8x4(acc[ai][1][m][1] * g11, sci)});
                if (wc == 0 && fq == 0) SQ[(size_t)row * 4 + u.pn] = M * (1.f / 127.f);
            }
    }
};
template <bool CLAMP> __device__ __forceinline__ u32x2 pack8_fp8(const f32x4 a, const f32x4 b) {
    int w0, w1;
    if constexpr (CLAMP) {
        w0 = __builtin_amdgcn_cvt_pk_fp8_f32(__builtin_amdgcn_fmed3f(a[0], -448.f, 448.f), __builtin_amdgcn_fmed3f(a[1], -448.f, 448.f), 0, false);
        w0 = __builtin_amdgcn_cvt_pk_fp8_f32(__builtin_amdgcn_fmed3f(a[2], -448.f, 448.f), __builtin_amdgcn_fmed3f(a[3], -448.f, 448.f), w0, true);
        w1 = __builtin_amdgcn_cvt_pk_fp8_f32(__builtin_amdgcn_fmed3f(b[0], -448.f, 448.f), __builtin_amdgcn_fmed3f(b[1], -448.f, 448.f), 0, false);
        w1 = __builtin_amdgcn_cvt_pk_fp8_f32(__builtin_amdgcn_fmed3f(b[2], -448.f, 448.f), __builtin_amdgcn_fmed3f(b[3], -448.f, 448.f), w1, true);
    } else {
        w0 = __builtin_amdgcn_cvt_pk_fp8_f32(a[0], a[1], 0, false); w0 = __builtin_amdgcn_cvt_pk_fp8_f32(a[2], a[3], w0, true);
        w1 = __builtin_amdgcn_cvt_pk_fp8_f32(b[0], b[1], 0, false); w1 = __builtin_amdgcn_cvt_pk_fp8_f32(b[2], b[3], w1, true);
    }
    return (u32x2){(unsigned)w0, (unsigned)w1};
}
constexpr float VW_FP8_SCALE = 16.f, P_FP8_SCALE = 256.f;
struct EpiSoftmax {
    static constexpr bool PERM = true, AFTER_DRAIN = false;
    bf16_t* P; const float* SQ; const float* SK; PG8_LAS float* X;
    __device__ __forceinline__ void operator()(const f32x4 (&acc_)[2][2][4][2], const Unit& u, int wr, int wc, int fr, int fq) const {
        f32x4 (&acc)[2][2][4][2] = const_cast<f32x4 (&)[2][2][4][2]>(acc_);
        PG8_LAS float* const xw = X + (wr * 64 + fr) * 4 + wc; const PG8_LAS float* const xr = X + (wr * 64 + fr) * 4;
        const int cl0 = wc * 32 + 8 * fq;
        {
            const float* skp = SK + ((size_t)(u.pm >> 3) * 4 + u.pn) * 256 + cl0;
            const f32x4 k00 = *(const f32x4*)skp, k01 = *(const f32x4*)(skp + 4), k10 = *(const f32x4*)(skp + 128), k11 = *(const f32x4*)(skp + 132);
            float sq[2][4];
#pragma unroll
            for (int ai = 0; ai < 2; ++ai)
#pragma unroll
                for (int m = 0; m < 4; ++m) sq[ai][m] = SQ[(size_t)(u.pm * BM + ai * HALF + wr * 64 + m * 16 + fr) * 4 + u.pn];
#pragma unroll
            for (int ai = 0; ai < 2; ++ai)
#pragma unroll
                for (int m = 0; m < 4; ++m) {
                    acc[ai][0][m][0] = cvti4(acc[ai][0][m][0]) * sq[ai][m] * k00; acc[ai][0][m][1] = cvti4(acc[ai][0][m][1]) * sq[ai][m] * k01;
                    acc[ai][1][m][0] = cvti4(acc[ai][1][m][0]) * sq[ai][m] * k10; acc[ai][1][m][1] = cvti4(acc[ai][1][m][1]) * sq[ai][m] * k11;
                }
        }
#pragma unroll
        for (int ai = 0; ai < 2; ++ai)
#pragma unroll
            for (int m = 0; m < 4; ++m) {
                const int rt = ai * HALF + wr * 64 + m * 16 + fr;
                float mx = -INFINITY;
#pragma unroll
                for (int bj = 0; bj < 2; ++bj)
#pragma unroll
                    for (int n = 0; n < 2; ++n) { const f32x4 v = acc[ai][bj][m][n]; mx = fmaxf(mx, fmaxf(fmaxf(v[0], v[1]), fmaxf(v[2], v[3]))); }
                mx = fmaxf(mx, __shfl_xor(mx, 16)); mx = fmaxf(mx, __shfl_xor(mx, 32));
                if (fq == 0) xw[(ai * HALF + m * 16) * 4] = mx;
            }
        PG8_XBAR();
        float mr[2][4];
#pragma unroll
        for (int ai = 0; ai < 2; ++ai)
#pragma unroll
            for (int m = 0; m < 4; ++m) {
                const int rt = ai * HALF + wr * 64 + m * 16 + fr;
                const f32x4 p = *(const PG8_LAS f32x4*)(xr + (ai * HALF + m * 16) * 4);
                const float mx = fmaxf(fmaxf(p[0], p[1]), fmaxf(p[2], p[3])); mr[ai][m] = mx;
                float s = 0.f;
#pragma unroll
                for (int bj = 0; bj < 2; ++bj)
#pragma unroll
                    for (int n = 0; n < 2; ++n) { const f32x4 v = acc[ai][bj][m][n];
                        s += (__builtin_amdgcn_exp2f(v[0] - mx) + __builtin_amdgcn_exp2f(v[1] - mx)) + (__builtin_amdgcn_exp2f(v[2] - mx) + __builtin_amdgcn_exp2f(v[3] - mx)); }
                s += __shfl_xor(s, 16); s += __shfl_xor(s, 32);
                if (fq == 0) xw[1024 + (ai * HALF + m * 16) * 4] = s;
            }
        PG8_XBAR();
#pragma unroll
        for (int ai = 0; ai < 2; ++ai)
#pragma unroll
            for (int m = 0; m < 4; ++m) {
                const int rt = ai * HALF + wr * 64 + m * 16 + fr, row = u.pm * BM + rt;
                const f32x4 p = *(const PG8_LAS f32x4*)(xr + 1024 + (ai * HALF + m * 16) * 4);
                const float inv = P_FP8_SCALE / ((p[0] + p[1]) + (p[2] + p[3])), mx = mr[ai][m];
                unsigned char* d = (unsigned char*)P + (size_t)row * 1024 + u.pn * 256 + wc * 64 + fq * 16;
                u32x2 w[2];
#pragma unroll
                for (int bj = 0; bj < 2; ++bj) {
                    f32x4 e0, e1;
#pragma unroll
                    for (int j = 0; j < 4; ++j) { e0[j] = __builtin_amdgcn_exp2f(acc[ai][bj][m][0][j] - mx) * inv; e1[j] = __builtin_amdgcn_exp2f(acc[ai][bj][m][1][j] - mx) * inv; }
                    w[bj] = pack8_fp8<false>(e0, e1);
                }
                st16_wt(d, (u32x4){w[0].x, w[0].y, w[1].x, w[1].y});
            }
    }
};
struct EpiBf16Plain {
    static constexpr bool PERM = true, AFTER_DRAIN = false;
    bf16_t* O;
    __device__ __forceinline__ void operator()(const f32x4 (&acc)[2][2][4][2], const Unit& u, int wr, int wc, int fr, int fq) const {
        const int cl0 = wc * 32 + 8 * fq;
#pragma unroll
        for (int ai = 0; ai < 2; ++ai)
#pragma unroll
            for (int m = 0; m < 4; ++m) {
                const int row = u.pm * BM + ai * HALF + wr * 64 + m * 16 + fr;
                unsigned char* d = (unsigned char*)O + (size_t)row * 1024 + u.pn * 256 + wc * 64 + fq * 16;
                const u32x2 w0 = pack8_fp8<true>(acc[ai][0][m][0] * VW_FP8_SCALE, acc[ai][0][m][1] * VW_FP8_SCALE), w1 = pack8_fp8<true>(acc[ai][1][m][0] * VW_FP8_SCALE, acc[ai][1][m][1] * VW_FP8_SCALE);
                st16_wt(d, (u32x4){w0.x, w0.y, w1.x, w1.y});
            }
    }
};
__device__ __forceinline__ float gelu_tanh_f(float v) {
    const float u = 0.7978845608028654f * (v + 0.044715f * v * v * v);
    return v * __builtin_amdgcn_rcpf(1.f + __builtin_amdgcn_exp2f(-2.885390081777927f * u));
}
template <int CTRL> __device__ __forceinline__ float rorf(float src) {
    return __builtin_bit_cast(float, __builtin_amdgcn_mov_dpp(__builtin_bit_cast(int, src), CTRL, 0xf, 0xf, true));
}
template <int CTRL> __device__ __forceinline__ float dppf(float old, float src) {
    return __builtin_bit_cast(float, __builtin_amdgcn_update_dpp(__builtin_bit_cast(int, old), __builtin_bit_cast(int, src), CTRL, 0xf, 0xf, false));
}
struct EpiFfnFused {
    static constexpr bool PERM = true, AFTER_DRAIN = false;
    bf16_t* ACT; float* HALO; float* FIXA; float* FIXG; const float* rs8; const float* sb8; const float* cw; const float* cb; PG8_LAS float* X;
    __device__ __forceinline__ void operator()(const f32x4 (&acc)[2][2][4][2], const Unit& u, int wr_, int wc_, int fr_, int fq_) const {
        int ln_; asm volatile("v_mbcnt_lo_u32_b32 %0, -1, 0\n\tv_mbcnt_hi_u32_b32 %0, -1, %0" : "=v"(ln_));
        const int fr = ln_ & 15, fq = ln_ >> 4; (void)fr_; (void)fq_;
        int wr = wr_, wc = wc_; asm volatile("" : "+s"(wr), "+s"(wc));
        const int cl0 = wc * 32 + 8 * fq, c0 = u.pn * 128 + cl0;
        float rr[2][4];
#pragma unroll
        for (int ai = 0; ai < 2; ++ai)
#pragma unroll
            for (int m = 0; m < 4; ++m) rr[ai][m] = rs8[u.pm * BM + ai * HALF + wr * 64 + m * 16 + fr];
        if (fr >= 14) {
#pragma unroll
            for (int ai = 0; ai < 2; ++ai) {
                const f32x4 v0 = cvti4(acc[ai][0][3][0]) * rr[ai][3], v1 = cvti4(acc[ai][0][3][1]) * rr[ai][3];
                PG8_LAS float* h = X + ((ai * 2 + wr) * 2 + (fr - 14)) * 128 + cl0;
                *(PG8_LAS f32x4*)h = v0; *(PG8_LAS f32x4*)(h + 4) = v1;
                if (ai == 1 && wr == 1) { float* g = HALO + ((size_t)u.pm * 2 + (fr - 14)) * DFF + c0; *(f32x4*)g = v0; *(f32x4*)(g + 4) = v1; }
            }
        }
        PG8_XBAR();
        const bool is15 = fr == 15, ge14 = fr >= 14;
        float GK1 = -2.885390081777927f * 0.7978845608028654f, GK2 = GK1 * 0.044715f; asm volatile("" : "+v"(GK1), "+v"(GK2));
        u32x2 keep[2][4];
#pragma unroll
        for (int n = 0; n < 2; ++n) {
            const int cn = c0 + 4 * n;
            const f32x4 sa = *(const f32x4*)(sb8 + u.pn * 256 + cl0 + 4 * n), sg = *(const f32x4*)(sb8 + u.pn * 256 + 128 + cl0 + 4 * n);
            const f32x4 w0 = *(const f32x4*)(cw + cn) * sa, w1 = *(const f32x4*)(cw + DFF + cn) * sa, w2 = *(const f32x4*)(cw + 2 * DFF + cn) * sa, cbv = *(const f32x4*)(cb + cn);
#pragma unroll
            for (int ai = 0; ai < 2; ++ai)
#pragma unroll
                for (int m = 0; m < 4; ++m) {
                    const int rt = ai * HALF + wr * 64 + m * 16 + fr, row = u.pm * BM + rt;
                    const f32x4 ca = cvti4(acc[ai][0][m][n]) * rr[ai][m], ga = cvti4(acc[ai][1][m][n]) * rr[ai][m];
                    f32x4 pa = {0.f, 0.f, 0.f, 0.f};
                    if (m > 0) pa = cvti4(acc[ai][0][m - 1][n]) * rr[ai][m - 1];
                    else if (fr >= 14) {
                        const int which = wr == 1 ? ai * 2 : (ai == 1 ? 1 : -1);
                        if (which >= 0) pa = *(const PG8_LAS f32x4*)(X + (which * 2 + (fr - 14)) * 128 + cl0 + 4 * n);
                    }
                    const f32x4 z1 = is15 ? pa : ca, z2 = ge14 ? pa : ca;
                    f32x4 a1, a2, ex, rc;
#pragma unroll
                    for (int j = 0; j < 4; ++j) { a1[j] = rorf<0x121>(z1[j]); a2[j] = rorf<0x122>(z2[j]); }
                    const f32x4 cv = cbv + w2 * ca + w1 * a1 + w0 * a2;
                    const f32x4 ev = (cv * cv * GK2 + GK1) * cv;
#pragma unroll
                    for (int j = 0; j < 4; ++j) ex[j] = __builtin_amdgcn_exp2f(ev[j]);
                    ex = ex + 1.f;
#pragma unroll
                    for (int j = 0; j < 4; ++j) rc[j] = __builtin_amdgcn_rcpf(ex[j]);
                    const f32x4 oa = (cv * rc) * (ga * sg);
                    u32x2 w; w.x = cvt_pk_bf16(oa[0], oa[1]); w.y = cvt_pk_bf16(oa[2], oa[3]);
                    if (n == 0) keep[ai][m] = w;
                    else st16_wt((ACT + (size_t)row * DFF + c0), (u32x4){keep[ai][m].x, keep[ai][m].y, w.x, w.y});
                    if (ai == 0 && m == 0 && wr == 0 && fr < 2) {
                        *(f32x4*)(FIXA + ((size_t)u.pm * 2 + fr) * DFF + cn) = ca; *(f32x4*)(FIXG + ((size_t)u.pm * 2 + fr) * DFF + cn) = ga;
                    }
                }
        }
    }
};
struct EpiFinal {
    static constexpr bool PERM = true, AFTER_DRAIN = false;
    const bf16_t* base; float* out;
    __device__ __forceinline__ void operator()(const f32x4 (&acc)[2][2][4][2], const Unit& u, int wr, int wc, int fr, int fq) const {
        const int col0 = u.pn * BM + wc * 32 + 8 * fq;
#pragma unroll
        for (int ai = 0; ai < 2; ++ai)
#pragma unroll
            for (int m = 0; m < 4; ++m) {
                const size_t off = (size_t)(u.pm * BM + ai * HALF + wr * 64 + m * 16 + fr) * 1024 + col0;
#pragma unroll
                for (int bj = 0; bj < 2; ++bj) {
                    f32x4 b0, b1; unpack8(__builtin_nontemporal_load((const u32x4*)(base + off + bj * HALF)), b0, b1);
                    __builtin_nontemporal_store(b0 + acc[ai][bj][m][0], (f32x4*)(out + off + bj * HALF));
                    __builtin_nontemporal_store(b1 + acc[ai][bj][m][1], (f32x4*)(out + off + bj * HALF + 4));
                }
            }
    }
};
}
constexpr size_t WS_H1B = WS_A2 + 2048;
constexpr size_t WS_SKX = 61 * MiB;
constexpr size_t WS_SQX = 494 * MiB;
constexpr size_t WS_QX = 210 * MiB;
constexpr size_t WS_P = 146 * MiB;
constexpr size_t WS_H2B = 82 * MiB;
constexpr size_t WS_VWT = 450 * MiB;
constexpr size_t WS_UA = 82 * MiB;
constexpr size_t WS_UG = 258 * MiB;
static_assert(WS_H2B + (size_t)NTOK * DM * 2 <= WS_P && WS_UG + (size_t)NTOK * DFF * 2 <= WS_VWT && WS_VWT + (size_t)16 * 1024 * 1024 * 2 <= WS_END, "late-phase workspace map");

__device__ __forceinline__ void p1_memkv(Frame& F, const Args& A) {
    int kk = 512; asm volatile("" : "+s"(kk));
    pg8::Gemm g{WSP(bf16, WS_MEM8), WSP(bf16, WS_WXKV8), 512, 512, kk, 0xffffffffu};
    pg8::TileOrder S; S.init(16, 8, F.G, (int)blockIdx.x, (size_t)256 * 1024, (size_t)256 * 1024, F.G >= 256 ? 128 : 0);
    pg8::EpiMemKV E{WSP(unsigned char, WS_KX), WSP(float, WS_SKX), WSP(bf16, WS_VXT), WSP(float, WS_RSM8), WSP(float, WS_SBKV), (const float*)A.in[21], (PG8_LAS float*)(F.lds + LDSX_OFF)};
    pg8::gemm_phase<pg8::EpiMemKV, pg8::TileOrder, true, true, true>(F.lds + RING_OFF, g, S, E, F.wave);
}
__device__ __forceinline__ void p_wout(Frame& F, const Args& A) {
    pg8::Gemm g{WSP(bf16, WS_ATT), WSP(bf16, WS_WOUT), 1024, 1024, 1024, 0xffffffffu};
    pg8::TileOrder S; S.init(128, 4, F.G, F.vb, (size_t)256 * 1024 * 2, (size_t)256 * 1024 * 2);
    pg8::EpiRes<true> E{WSP(bf16, WS_A2), 2048, WSP(bf16, WS_H1B), 2048, WSP(float, WS_SS1), (PG8_LAS float*)(F.lds + LDSX_OFF), 1.f};
    pg8::gemm_phase<pg8::EpiRes<true>, pg8::TileOrder, true, true>(F.lds + RING_OFF, g, S, E, F.wave);
}
__device__ __forceinline__ void p_xq(Frame& F, const Args& A) {
    pg8::Gemm g{WSP(bf16, WS_H1B), WSP(bf16, WS_WXQ), 2048, 1024, 1024, 0xffffffffu};
    pg8::TileOrder S; S.init(128, 4, F.G, F.vb, (size_t)256 * 2048 * 2, (size_t)256 * 1024 * 2);
    pg8::EpiXq E{WSP(unsigned char, WS_QX), WSP(float, WS_SQX), WSP(float, WS_SS1), (const float*)A.in[20], (PG8_LAS float*)(F.lds + LDSX_OFF)};
    pg8::gemm_phase<pg8::EpiXq, pg8::TileOrder, true, true>(F.lds + RING_OFF, g, S, E, F.wave);
}
__device__ __forceinline__ void p_xs(Frame& F) {
    int kk = 128; asm volatile("" : "+s"(kk));
    pg8::Gemm g{WSP(bf16, WS_QX), WSP(bf16, WS_KX), 512, 512, kk, 0xffffffffu};
    pg8::TileOrder S; S.init(128, 4, F.G, F.vb, (size_t)256 * 1024, (size_t)256, 0, (size_t)256, (size_t)256 * 1024);
    pg8::EpiSoftmax E{WSP(bf16, WS_P), WSP(float, WS_SQX), WSP(float, WS_SKX), (PG8_LAS float*)(F.lds + LDSX_OFF)};
    pg8::gemm_phase<pg8::EpiSoftmax, pg8::TileOrder, true, true, true>(F.lds + RING_OFF, g, S, E, F.wave);
}
struct VwOrder {
    int G, c;
    __device__ bool next(int i, pg8::Unit& u) const {
        const int L = i * G + c; if (L >= 256) return false;
        const int b = L >> 4, h = (L >> 2) & 3, nt = L & 3;
        u.pm = b * 4 + nt; u.pn = h; u.ao = ((size_t)nt * 256 * 1024 + h * 256) * 2; u.bo = ((size_t)b * 256 * 1024 + h * 256) * 2; return true;
    }
    __device__ __forceinline__ void a_ready(const pg8::Unit&) const {}
    __device__ __forceinline__ void done(const pg8::Unit&) const {}
};
__device__ __forceinline__ void p_vw(Frame& F) {
    int kk = 256; asm volatile("" : "+s"(kk));
    pg8::Gemm g{WSP(bf16, WS_WXO), WSP(bf16, WS_VXT), 1024, 1024, kk, 0xffffffffu};
    VwOrder S{F.G, (int)blockIdx.x};
    pg8::EpiBf16Plain E{WSP(bf16, WS_VWT)};
    pg8::gemm_phase<pg8::EpiBf16Plain, VwOrder, true, true>(F.lds + RING_OFF, g, S, E, F.wave);
}
__device__ __forceinline__ void p_wxo(Frame& F) {
    int kk = 512; asm volatile("" : "+s"(kk));
    pg8::Gemm g{WSP(bf16, WS_P), WSP(bf16, WS_VWT), 512, 512, kk, 0xffffffffu};
    pg8::TileOrder S; S.init(128, 4, F.G, F.vb, (size_t)256 * 1024, (size_t)256 * 1024, 0, 0, (size_t)1024 * 1024);
    pg8::EpiRes<true> E{WSP(bf16, WS_H1B), 2048, WSP(bf16, WS_H2B), 1024, WSP(float, WS_SS2), (PG8_LAS float*)(F.lds + LDSX_OFF), 1.f / (pg8::VW_FP8_SCALE * pg8::P_FP8_SCALE)};
    pg8::gemm_phase<pg8::EpiRes<true>, pg8::TileOrder, true, true, 2>(F.lds + RING_OFF, g, S, E, F.wave);
}
constexpr size_t WS_HALO = 73 * MiB, WS_FIXA = 76 * MiB, WS_FIXG = 79 * MiB;
static_assert((size_t)128 * 2 * DFF * 4 <= 3 * MiB, "halo buffers");
constexpr size_t WS_A8 = WS_QX;
constexpr size_t WS_W8 = 486 * MiB;
constexpr size_t WS_SB8 = 492 * MiB;
constexpr size_t WS_RS8 = 493 * MiB;
static_assert(WS_QX >= WS_P + (size_t)NTOK * DM * 2 && WS_QX + (size_t)NTOK * DM <= WS_UG && WS_W8 + (size_t)2 * DFF * DM <= WS_SB8 && WS_SB8 + (size_t)2 * DFF * 4 <= WS_RS8 && WS_RS8 + (size_t)NTOK * 4 <= WS_SQX && WS_SQX + (size_t)NTOK * 16 <= WS_END, "int8 operand map");
__device__ __forceinline__ void quant_row(const v4u a, const v4u b, unsigned char* dst, float* sc, bool is_w, int lane) {
    float v[16];
#pragma unroll
    for (int i = 0; i < 4; ++i) { v[2 * i] = __uint_as_float(a[i] << 16); v[2 * i + 1] = __uint_as_float(a[i] & 0xffff0000u); v[8 + 2 * i] = __uint_as_float(b[i] << 16); v[8 + 2 * i + 1] = __uint_as_float(b[i] & 0xffff0000u); }
    float mx = 0.f, ss = 0.f;
#pragma unroll
    for (int i = 0; i < 16; ++i) { mx = fmaxf(mx, fabsf(v[i])); ss += v[i] * v[i]; }
    mx = wave_max(mx); ss = wave_sum(ss);
    const float inv = mx > 0.f ? 127.f / mx : 0.f;
    v4u q;
#pragma unroll
    for (int w = 0; w < 4; ++w) q[w] = q8x4((f32x4){v[4 * w], v[4 * w + 1], v[4 * w + 2], v[4 * w + 3]}, inv);
    *(GAS v4u*)(dst + 16 * lane) = q;
    if (lane == 0) *sc = is_w ? mx * (1.f / 127.f) : rsqrtf(ss * (1.f / DM) + EPS) * (mx * (1.f / 127.f));
}
__device__ __forceinline__ void p_quant(Frame& F) {
    const int l = lane_now();
    const int first = F.xl ? F.xidx * 4096 + F.xrank * NWAVES + F.wave : (int)blockIdx.x * NWAVES + F.wave;
    const int step = F.xl ? (F.G >> 3) * NWAVES : F.G * NWAVES, last = F.xl ? F.xidx * 4096 + 4096 : NTOK;
    for (int r = first; r < last; r += 4 * step) {
        v4u a[4], b[4];
#pragma unroll
        for (int k = 0; k < 4; ++k) {
            const int rk = r + k * step < last ? r + k * step : r;
            const bf16* sp = WSP(bf16, WS_H2B) + (size_t)rk * 1024;
            a[k] = *(const GAS v4u*)(sp + 16 * l); b[k] = *(const GAS v4u*)(sp + 16 * l + 8);
        }
#pragma unroll
        for (int k = 0; k < 4; ++k) {
            const int rk = r + k * step; if (rk >= last) break;
            quant_row(a[k], b[k], WSP(unsigned char, WS_A8) + (size_t)rk * 1024, WSP(float, WS_RS8) + rk, false, l);
        }
    }
}
__device__ __forceinline__ void p_ffn1(Frame& F, const Args& A) {
    int kk = 512; asm volatile("" : "+s"(kk));
    pg8::Gemm g{WSP(bf16, WS_A8), WSP(bf16, WS_W8), 512, 512, kk, 0xffffffffu};
    pg8::TileOrder S; S.init(128, 22, F.G, F.vb, (size_t)256 * 1024, (size_t)256 * 1024);
    pg8::EpiFfnFused E{WSP(bf16, WS_UG), WSP(float, WS_HALO), WSP(float, WS_FIXA), WSP(float, WS_FIXG), WSP(float, WS_RS8), WSP(float, WS_SB8), (const float*)A.in[24], (const float*)A.in[25], (PG8_LAS float*)(F.lds + LDSX_OFF)};
    pg8::gemm_phase<pg8::EpiFfnFused, pg8::TileOrder, true, true, true>(F.lds + RING_OFF, g, S, E, F.wave);
}
__device__ __forceinline__ void ffnfix_panel(Frame& F, const Args& A, int pm) {
    if ((pm & 7) == 0) return;
    const float* cw = (const float*)A.in[24]; const float* cb = (const float*)A.in[25]; const float* sb8 = WSP(float, WS_SB8);
    const float* HALO = WSP(float, WS_HALO); const float* FIXA = WSP(float, WS_FIXA); const float* FIXG = WSP(float, WS_FIXG); bf16* ACT = WSP(bf16, WS_UG);
    for (int i = F.wave * 64 + lane_now(); i < 2 * DFF; i += NWAVES * 64) {
        const int r = i >= DFF ? 1 : 0, c = i - r * DFF;
        const float sa = sb8[(c >> 7) * 256 + (c & 127)], sg = sb8[(c >> 7) * 256 + 128 + (c & 127)];
        const float a0 = FIXA[((size_t)pm * 2 + r) * DFF + c];
        const float a1 = r == 0 ? HALO[((size_t)(pm - 1) * 2 + 1) * DFF + c] : FIXA[((size_t)pm * 2) * DFF + c];
        const float a2 = r == 0 ? HALO[((size_t)(pm - 1) * 2) * DFF + c] : HALO[((size_t)(pm - 1) * 2 + 1) * DFF + c];
        const float v = cb[c] + sa * (cw[2 * DFF + c] * a0 + cw[DFF + c] * a1 + cw[c] * a2);
        ACT[((size_t)pm * 256 + r) * DFF + c] = (bf16)f2bf(pg8::gelu_tanh_f(v) * (FIXG[((size_t)pm * 2 + r) * DFF + c] * sg));
    }
}
__device__ __forceinline__ void p_ffn2(Frame& F, const Args& A) {
    pg8::Gemm g{WSP(bf16, WS_UG), WSP(bf16, WS_WF2), DFF, DFF, DFF, 0xffffffffu};
    pg8::TileOrder S; S.init(128, 4, F.G, F.vb, (size_t)256 * DFF * 2, (size_t)256 * DFF * 2);
    {
        pg8::Unit u; int last = -1;
        for (int i = 0; S.next(i, u); ++i) { if (u.pm != last) ffnfix_panel(F, A, u.pm); last = u.pm; }
        asm volatile("s_waitcnt vmcnt(0)" ::: "memory"); __syncthreads();
    }
    pg8::EpiFinal E{WSP(bf16, WS_H2B), F.out};
    pg8::gemm_phase<pg8::EpiFinal, pg8::TileOrder, true, true>(F.lds + RING_OFF, g, S, E, F.wave);
}
constexpr int N_PHASES = 13;
__global__ void __launch_bounds__(NWAVES * 64, 2) mk(Args args) {
    extern __shared__ __attribute__((aligned(16))) unsigned char lds[];
    Frame F;
    F.lds = (LAS unsigned char*)lds;
    F.wave = __builtin_amdgcn_readfirstlane((int)threadIdx.x >> 6);
    F.G = gridDim.x; { const int bx = blockIdx.x; F.vcu = (F.G % 8 == 0) ? (bx % 8) * (F.G / 8) + bx / 8 : bx; }
    F.ws = args.ws; F.out = args.out;
    for (int u = threadIdx.x; u < (LDS_BYTES - LDSCTL_OFF) / 4; u += NWAVES * 64) ((LAS unsigned*)(F.lds + LDSCTL_OFF))[u] = 0u;
    __syncthreads();
    const int lo = args.ph_lo, hi = args.ph_hi;
    XcdBarrier bar; bar.bar = (unsigned*)(F.ws + WS_CTL) + CW_BAR; bar.x = 0; bar.st = nullptr; bar.wave = F.wave;
    if (hi - lo > 1) bar = xcd_barrier_post((unsigned*)(F.ws + WS_CTL) + CW_BAR, (volatile LAS unsigned*)(F.lds + MISC_OFF) + 8, F.wave);
#define IN(k) (lo <= (k) && (k) < hi)
#define BOTH(k) (IN(k) && IN((k) + 1))
#ifndef REPEAT_PH
#define REPEAT_PH -1
#endif
#define PHASE(k, body, body2) if (IN(k)) { body; if (BOTH(k)) xcd_barrier(bar); if (REPEAT_PH == (k)) { body2; xcd_barrier(bar); } }
    PHASE(0, p0_prologue(F, args), p0_prologue(F, args))
    F.vb = (int)blockIdx.x; F.xl = 0; F.xrank = 0; F.xidx = 0;
    if (BOTH(0)) {
        const unsigned mode = __builtin_amdgcn_readfirstlane(bar.st[3]), xi = __builtin_amdgcn_readfirstlane(bar.st[4]), rank = __builtin_amdgcn_readfirstlane(bar.st[2]);
        if (mode == 2u && (F.G & 7) == 0 && rank < (unsigned)(F.G >> 3)) { F.vb = (int)(xi + 8u * rank); F.xl = 1; F.xrank = (int)rank; F.xidx = (int)xi; }
    }
#define PHASEL(k, body, body2) if (IN(k)) { body; if (BOTH(k)) { if (F.xl) xcd_barrier_local(bar); else xcd_barrier(bar); } if (REPEAT_PH == (k)) { body2; xcd_barrier(bar); } }
    PHASE(1, p1_proj(F, args), p1_proj(F, args))
    PHASE(2, (p1_memkv(F, args), idx::run(F, idx::CW_QUEUE)), (p1_memkv(F, args), idx::run(F, idx::CW_QUEUE + 32)))
    PHASE(3, (p_vw(F), p3::run(F, p3::CW_QUEUE)), (p_vw(F), p3::run(F, p3::CW_QUEUE + 32)))
    PHASEL(5, p_wout(F, args), p_wout(F, args))
    if (IN(6)) { p_xq(F, args); if (REPEAT_PH == 6) p_xq(F, args); }
    PHASEL(7, p_xs(F), p_xs(F))
    PHASEL(9, p_wxo(F), p_wxo(F))
    PHASE(10, p_quant(F), p_quant(F))
    PHASEL(11, p_ffn1(F, args), p_ffn1(F, args))
    if (IN(12)) { p_ffn2(F, args); }
#undef PHASE
#undef PHASEL
#undef IN
#undef BOTH
}

extern "C" void kernel_launch(void* const* d_in, const int* in_sizes, int n_in, void* d_out, int out_size, void* d_ws, size_t ws_size, hipStream_t stream) {
    static int grid = 0;
    if (grid == 0) {
        if (n_in != 27 || ws_size < WS_END) { fprintf(stderr, "kernel_launch: unexpected inputs (n_in %d, ws %zu)\n", n_in, ws_size); grid = -1; return; }
        int dev = 0, cus = 0;
        if (hipGetDevice(&dev) != hipSuccess || hipDeviceGetAttribute(&cus, hipDeviceAttributeMultiprocessorCount, dev) != hipSuccess) { grid = -1; return; }
        if (hipFuncSetAttribute((const void*)mk, hipFuncAttributeMaxDynamicSharedMemorySize, LDS_BYTES) != hipSuccess) { fprintf(stderr, "kernel_launch: hipFuncSetAttribute failed\n"); grid = -1; return; }
        (void)hipGetLastError();
        grid = cus;
    }
    if (grid < 0) return;
    float* out = (float*)d_out;
    unsigned char* ws = (unsigned char*)d_ws;
    (void)hipMemsetAsync(ws + WS_CTL, 0, CTL_ZERO_BYTES, stream);
    Args a{};
    for (int i = 0; i < 27; ++i) a.in[i] = d_in[i];
    a.out = out; a.ws = ws;
    for (int i = 0; i < 32; ++i) { const float e = (float)(2 * i) / 64.0f; const float pw = powf(10000.0f, e); a.rf.f[i] = 1.0f / pw; }
    a.ph_lo = 0; a.ph_hi = N_PHASES;
    hipLaunchKernelGGL(mk, dim3(grid), dim3(NWAVES * 64), LDS_BYTES, stream, a);

}
```
